# Optimizing an MI355X kernel written in HIP

```python
import math
import jax, jax.numpy as jnp
from jax import lax
import numpy as np

D_MODEL = 1024
BATCH = 8
SEQ = 4096
DEPTH = 4

CHUNK = 64
Q_BLOCK = 128
N_EVEN = (DEPTH + 1) // 2
N_ODD = DEPTH // 2
EPS = 1e-6

RET_HEADS = 4
RET_DK = 64
RET_DV = 128
ROPE_BASE = 10000.0

SSD_HEADS = 8
SSD_HEAD_DIM = 64
SSD_INNER = SSD_HEADS * SSD_HEAD_DIM
SSD_GROUPS = 2
SSD_STATE = 64
SSD_CONV = 4
SSD_CONV_DIM = SSD_INNER + 2 * SSD_GROUPS * SSD_STATE
SSD_NORM_GROUP = SSD_INNER // SSD_GROUPS

HG_HEADS = 4
HG_DK = 128
HG_DV = 128

FOX_HEADS = 4
FOX_DIM = 128

FFN_HIDDEN = -(-8 * D_MODEL // (3 * 256)) * 256

AB_SIZES = (RET_HEADS * RET_DK, RET_HEADS * RET_DK, RET_HEADS * RET_DV, RET_HEADS * RET_DV,
            SSD_INNER, SSD_CONV_DIM, SSD_HEADS)
AB_IN = sum(AB_SIZES)
AB_OUT = RET_HEADS * RET_DV + SSD_INNER
CD_SIZES = (HG_HEADS * HG_DK, HG_HEADS * HG_DK, HG_HEADS * HG_DV, HG_HEADS * HG_DV,
            FOX_HEADS * FOX_DIM, FOX_HEADS * FOX_DIM, FOX_HEADS * FOX_DIM, FOX_HEADS)
CD_IN = sum(CD_SIZES)
CD_OUT = HG_HEADS * HG_DV + FOX_HEADS * FOX_DIM

kernel_name = "hybrid_retention_ssd_hgrn2_fox_trunk"


def rmsnorm(x, w):
    xf = x.astype(jnp.float32)
    y = xf * lax.rsqrt(jnp.mean(xf * xf, axis=-1, keepdims=True) + EPS)
    return (y * w.astype(jnp.float32)).astype(x.dtype)


def split_cols(h, sizes):
    offs, acc = [], 0
    for s in sizes[:-1]:
        acc += s
        offs.append(acc)
    return jnp.split(h, offs, axis=-1)


def to_heads(t, n):
    b, t_len, _ = t.shape
    return t.reshape(b, t_len, n, -1).transpose(0, 2, 1, 3)


def merge_heads(t):
    b, n, t_len, d = t.shape
    return t.transpose(0, 2, 1, 3).reshape(b, t_len, n * d)


def rotary_every_two(x):
    t_len, d = x.shape[2], x.shape[3]
    half = d // 2
    freqs = ROPE_BASE ** (-jnp.linspace(0.0, 1.0, half, dtype=jnp.float32))
    ang = jnp.arange(t_len, dtype=jnp.float32)[:, None] * freqs[None, :]
    cos, sin = jnp.cos(ang), jnp.sin(ang)
    xf = x.astype(jnp.float32).reshape(x.shape[:-1] + (half, 2))
    x1, x2 = xf[..., 0], xf[..., 1]
    out = jnp.stack([x1 * cos - x2 * sin, x1 * sin + x2 * cos], axis=-1)
    return out.reshape(x.shape).astype(x.dtype)


def chunk_recurrence(q, k, v, log_a):
    b_, h_, t_len, dk = q.shape
    dv = v.shape[-1]
    n_chunks = t_len // CHUNK
    per_channel = log_a.ndim == 4

    def to_chunks(a):
        return jnp.moveaxis(a.reshape(a.shape[:2] + (n_chunks, CHUNK) + a.shape[3:]), 2, 0)

    causal = jnp.tril(jnp.ones((CHUNK, CHUNK), dtype=bool))

    def step(state, inp):
        qi, ki, vi, li = inp
        cum = jnp.cumsum(li.astype(jnp.float32), axis=2)
        if per_channel:
            diff = cum[:, :, :, None, :] - cum[:, :, None, :, :]
            decay = jnp.exp(jnp.where(causal[:, :, None], diff, -jnp.inf))
            scores = jnp.einsum('bhid,bhjd,bhijd->bhij', qi, ki, decay)
            q_in = qi * jnp.exp(cum)
            k_out = ki * jnp.exp(cum[:, :, -1:] - cum)
            a_last = jnp.exp(cum[:, :, -1])[..., None]
        else:
            diff = cum[:, :, :, None] - cum[:, :, None, :]
            decay = jnp.exp(jnp.where(causal, diff, -jnp.inf))
            scores = jnp.einsum('bhid,bhjd->bhij', qi, ki) * decay
            q_in = qi * jnp.exp(cum)[..., None]
            k_out = ki * jnp.exp(cum[:, :, -1:] - cum)[..., None]
            a_last = jnp.exp(cum[:, :, -1])[..., None, None]
        out = (jnp.einsum('bhij,bhjv->bhiv', scores, vi)
               + jnp.einsum('bhid,bhdv->bhiv', q_in, state))
        state = a_last * state + jnp.einsum('bhjd,bhjv->bhdv', k_out, vi)
        return state, out

    state0 = jnp.zeros((b_, h_, dk, dv), jnp.float32)
    _, out = lax.scan(step, state0, (to_chunks(q), to_chunks(k), to_chunks(v), to_chunks(log_a)))
    return jnp.moveaxis(out, 0, 2).reshape(b_, h_, t_len, dv).astype(v.dtype)


def retention_mixer(rq, rk, rv, rg, gn_w):
    q = rotary_every_two(to_heads(rq, RET_HEADS))
    k = rotary_every_two(to_heads(rk, RET_HEADS)) * (RET_DK ** -0.5)
    v = to_heads(rv, RET_HEADS)
    log_gamma = jnp.log1p(-jnp.exp2(-5.0 - jnp.arange(RET_HEADS, dtype=jnp.float32)))
    log_a = jnp.broadcast_to(log_gamma[None, :, None], q.shape[:3])
    o = chunk_recurrence(q, k, v, log_a).astype(jnp.float32)
    mu = jnp.mean(o, axis=-1, keepdims=True)
    var = jnp.mean(jnp.square(o - mu), axis=-1, keepdims=True)
    o = (o - mu) * lax.rsqrt(var + EPS) * gn_w[:, None, :].astype(jnp.float32)
    return merge_heads(o).astype(rg.dtype) * jax.nn.silu(rg)


def ssd_mixer(z, xbc, dt_raw, conv_w, conv_b, dt_bias, a_log, d_skip, norm_w):
    xbc = lax.conv_general_dilated(xbc, conv_w[:, None, :], window_strides=(1,),
                                   padding=[(SSD_CONV - 1, 0)],
                                   dimension_numbers=('NWC', 'WIO', 'NWC'),
                                   feature_group_count=SSD_CONV_DIM)
    xbc = jax.nn.silu(xbc + conv_b)
    xs, bm, cm = split_cols(xbc, (SSD_INNER, SSD_GROUPS * SSD_STATE, SSD_GROUPS * SSD_STATE))
    v = to_heads(xs, SSD_HEADS)
    rep = SSD_HEADS // SSD_GROUPS
    bm = jnp.repeat(to_heads(bm, SSD_GROUPS), rep, axis=1)
    cm = jnp.repeat(to_heads(cm, SSD_GROUPS), rep, axis=1)
    dt = jax.nn.softplus(dt_raw.astype(jnp.float32) + dt_bias.astype(jnp.float32))
    dt = dt.transpose(0, 2, 1)
    log_a = dt * (-jnp.exp(a_log.astype(jnp.float32)))[None, :, None]
    y = chunk_recurrence(cm, bm * dt[..., None], v, log_a) + d_skip[None, :, None, None] * v
    y = merge_heads(y) * jax.nn.silu(z)
    b_, t_len, _ = y.shape
    yg = y.reshape(b_, t_len, SSD_GROUPS, SSD_NORM_GROUP)
    yg = rmsnorm(yg, jnp.ones((SSD_NORM_GROUP,), y.dtype)).reshape(b_, t_len, SSD_INNER)
    return yg * norm_w


def hgrn2_mixer(hq, hf, hi, hg, lower_bound, norm_w):
    q = to_heads(hq, HG_HEADS)
    zf = to_heads(hf, HG_HEADS).astype(jnp.float32)
    lb = lower_bound.reshape(HG_HEADS, 1, HG_DK)
    f = lb + (1.0 - lb) * jax.nn.sigmoid(zf)
    k = (1.0 - lb) * jax.nn.sigmoid(-zf)
    o = chunk_recurrence(q, k, to_heads(hi, HG_HEADS), jnp.log(f))
    o = rmsnorm(o, norm_w)
    return merge_heads(o) * jax.nn.silu(hg)


def fox_mixer(fq, fk, fv, f_raw, f_bias, qn_w, kn_w):
    q = rmsnorm(to_heads(fq, FOX_HEADS), qn_w)
    k = rmsnorm(to_heads(fk, FOX_HEADS), kn_w)
    v = to_heads(fv, FOX_HEADS)
    log_f = jax.nn.log_sigmoid(f_raw.astype(jnp.float32) + f_bias.astype(jnp.float32))
    cum_f = jnp.cumsum(log_f.transpose(0, 2, 1), axis=-1)
    scale = FOX_DIM ** -0.5
    t_len = q.shape[2]
    outs = []
    for start in range(0, t_len, Q_BLOCK):
        end = start + Q_BLOCK
        s = jnp.einsum('bhqd,bhkd->bhqk', q[:, :, start:end], k[:, :, :end]).astype(jnp.float32)
        s = s * scale + cum_f[:, :, start:end, None] - cum_f[:, :, None, :end]
        mask = (start + jnp.arange(Q_BLOCK))[:, None] >= jnp.arange(end)[None, :]
        p = jax.nn.softmax(jnp.where(mask, s, -jnp.inf), axis=-1)
        outs.append(jnp.einsum('bhqk,bhkd->bhqd', p.astype(v.dtype), v[:, :, :end]))
    return merge_heads(jnp.concatenate(outs, axis=2))


def swiglu(u, w_gate, w_up, w_down):
    return (jax.nn.silu(u @ w_gate) * (u @ w_up)) @ w_down


def setup_inputs(seed: int = 0) -> dict:
    key = jax.random.key(seed)
    ks = jax.random.split(key, 24)
    f32 = jnp.float32

    def nrm(k, shape, scale):
        return jax.random.normal(k, shape, f32) * scale

    def gain(k, shape):
        return 1.0 + 0.1 * jax.random.normal(k, shape, f32)

    dt0 = jnp.exp(jax.random.uniform(ks[12], (N_EVEN, SSD_HEADS), f32,
                                     math.log(1e-3), math.log(1e-1)))
    return {
        "x": nrm(ks[0], (BATCH, SEQ, D_MODEL), 1.0),
        "norm_mix": gain(ks[1], (DEPTH, D_MODEL)),
        "norm_ffn": gain(ks[2], (DEPTH, D_MODEL)),
        "ffn_w_gate": nrm(ks[3], (DEPTH, D_MODEL, FFN_HIDDEN), D_MODEL ** -0.5),
        "ffn_w_up": nrm(ks[4], (DEPTH, D_MODEL, FFN_HIDDEN), D_MODEL ** -0.5),
        "ffn_w_down": nrm(ks[5], (DEPTH, FFN_HIDDEN, D_MODEL), FFN_HIDDEN ** -0.5),
        "ab_w_in": nrm(ks[6], (N_EVEN, D_MODEL, AB_IN), D_MODEL ** -0.5),
        "ab_w_out": nrm(ks[7], (N_EVEN, AB_OUT, D_MODEL), AB_OUT ** -0.5),
        "ret_gn_w": gain(ks[8], (N_EVEN, RET_HEADS, RET_DV)),
        "ssd_conv_w": nrm(ks[9], (N_EVEN, SSD_CONV, SSD_CONV_DIM), SSD_CONV ** -0.5),
        "ssd_conv_b": nrm(ks[10], (N_EVEN, SSD_CONV_DIM), 0.02),
        "ssd_dt_bias": dt0 + jnp.log(-jnp.expm1(-dt0)),
        "ssd_a_log": jnp.log(jax.random.uniform(ks[11], (N_EVEN, SSD_HEADS), f32, 1.0, 16.0)),
        "ssd_d": gain(ks[13], (N_EVEN, SSD_HEADS)),
        "ssd_norm_w": gain(ks[14], (N_EVEN, SSD_INNER)),
        "cd_w_in": nrm(ks[15], (N_ODD, D_MODEL, CD_IN), D_MODEL ** -0.5),
        "cd_w_out": nrm(ks[16], (N_ODD, CD_OUT, D_MODEL), CD_OUT ** -0.5),
        "hg_lb_logits": nrm(ks[17], (N_ODD, HG_HEADS * HG_DK), 0.1),
        "hg_norm_w": gain(ks[18], (N_ODD, HG_DV)),
        "fox_f_bias": jax.random.uniform(ks[19], (N_ODD, FOX_HEADS), f32, 1.0, 5.0),
        "fox_q_norm_w": gain(ks[20], (N_ODD, FOX_DIM)),
        "fox_k_norm_w": gain(ks[21], (N_ODD, FOX_DIM)),
    }


def reference(x, norm_mix, norm_ffn, ffn_w_gate, ffn_w_up, ffn_w_down,
              ab_w_in, ab_w_out, ret_gn_w, ssd_conv_w, ssd_conv_b, ssd_dt_bias,
              ssd_a_log, ssd_d, ssd_norm_w, cd_w_in, cd_w_out, hg_lb_logits,
              hg_norm_w, fox_f_bias, fox_q_norm_w, fox_k_norm_w):
    lb_cum = jnp.cumsum(jax.nn.softmax(hg_lb_logits.astype(jnp.float32), axis=0), axis=0)
    lower_bounds = lb_cum - lb_cum[:1]

    h = x
    for layer in range(DEPTH):
        j = layer // 2
        u = rmsnorm(h, norm_mix[layer])
        if layer % 2 == 0:
            rq, rk, rv, rg, z, xbc, dt_raw = split_cols(u @ ab_w_in[j], AB_SIZES)
            y_ret = retention_mixer(rq, rk, rv, rg, ret_gn_w[j])
            y_ssd = ssd_mixer(z, xbc, dt_raw, ssd_conv_w[j], ssd_conv_b[j], ssd_dt_bias[j],
                              ssd_a_log[j], ssd_d[j], ssd_norm_w[j])
            h = h + jnp.concatenate([y_ret, y_ssd], axis=-1) @ ab_w_out[j]
        else:
            hq, hf, hi, hg, fq, fk, fv, f_raw = split_cols(u @ cd_w_in[j], CD_SIZES)
            y_hg = hgrn2_mixer(hq, hf, hi, hg, lower_bounds[j], hg_norm_w[j])
            y_fox = fox_mixer(fq, fk, fv, f_raw, fox_f_bias[j], fox_q_norm_w[j], fox_k_norm_w[j])
            h = h + jnp.concatenate([y_hg, y_fox], axis=-1) @ cd_w_out[j]
        u = rmsnorm(h, norm_ffn[layer])
        h = h + swiglu(u, ffn_w_gate[layer], ffn_w_up[layer], ffn_w_down[layer])
    return h
```

```cpp
#include <hip/hip_runtime.h>
#include <hip/hip_cooperative_groups.h>
#include <cstdio>
#include <cstdint>
#include <cmath>
namespace cg = cooperative_groups;
#ifndef RU_STAGE
#define RU_STAGE 1
#endif
#ifndef RU_G
#define RU_G 1
#endif
#ifndef RU_O
#define RU_O 1
#endif
#ifndef RU_FIN
#define RU_FIN 1
#endif
__device__ __forceinline__ int tid_fresh() { int t = threadIdx.x; asm volatile("" : "+v"(t)); return t; }
__device__ __forceinline__ int bid_fresh() { int t = blockIdx.x; asm volatile("" : "+s"(t)); return t; }
__device__ __forceinline__ int gdim_fresh() { int t = gridDim.x; asm volatile("" : "+s"(t)); return t; }
namespace pg8 {
#define PG8_LAS __attribute__((address_space(3)))
typedef unsigned short bf16_t;
typedef short bf16x8 __attribute__((ext_vector_type(8)));
typedef float f32x4 __attribute__((ext_vector_type(4)));
typedef unsigned u32x4 __attribute__((ext_vector_type(4)));
constexpr int BM = 256, BK = 64, HALF = 128, HTB = HALF * BK * 2  , STAGE_BYTES = 8 * HTB, NXCD = 8, WGM = 8;

__host__ __device__ __forceinline__ int lds_byte(int r, int c) { const int st = (r >> 4) * 2 + (c >> 5), rr = r & 15, cc = c & 31, ob = rr * 64 + cc * 2; return st * 1024 + (ob ^ (((ob >> 9) & 1) << 5)); }
__host__ __device__ __forceinline__ void stage_rc(int b, int& R, int& C) { const int st = b / 1024, sb = b % 1024, swz = sb ^ (((sb >> 9) & 1) << 5); R = (st >> 1) * 16 + swz / 64; C = (st & 1) * 32 + (swz % 64) / 2; }
__host__ __device__ __forceinline__ int perm32(int rho) { const int n = rho >> 4, i = rho & 15; return 8 * (i >> 2) + 4 * n + (i & 3); }

struct Unit { int pm, pn; };
struct Gemm { const bf16_t* A; const bf16_t* Bt; int M, N, K; };

struct StaticOrder {
    int nM, nN, nwg, G, c;
    __host__ __device__ void init(int M, int N, int G_, int c_) { nM = M / BM; nN = N / BM; nwg = nM * nN; G = G_; c = c_; }
    __host__ __device__ bool next(int i, Unit& u) const {
        const long L = (long)i * G + c; if (L >= nwg) return false;
        int wgid = (int)L; { const int q = nwg / NXCD, r = nwg % NXCD, xcd = wgid % NXCD, off = wgid / NXCD; wgid = (xcd < r ? xcd * (q + 1) : r * (q + 1) + (xcd - r) * q) + off; }
        const int nig = WGM * nN, gid = wgid / nig, fm = gid * WGM, gsz = (nM - fm) < WGM ? (nM - fm) : WGM;
        u.pm = fm + ((wgid % nig) % gsz); u.pn = (wgid % nig) / gsz; return true;
    }
    __device__ __forceinline__ void a_ready(const Unit&) const {}
    __device__ __forceinline__ void done(const Unit&) const {}
};

__device__ __forceinline__ unsigned cvt_pk_bf16(float lo, float hi) { unsigned r; asm volatile("v_cvt_pk_bf16_f32 %0, %1, %2" : "=v"(r) : "v"(lo), "v"(hi)); return r; }
typedef float f32x2 __attribute__((ext_vector_type(2)));
__device__ __forceinline__ f32x2 gelu_pk(f32x2 v) {
    const f32x2 av = __builtin_elementwise_abs(v), d = av * 0.2316418882f + 1.0f;
    f32x2 t; t.x = __builtin_amdgcn_rcpf(d.x); t.y = __builtin_amdgcn_rcpf(d.y);
    f32x2 q = t * 0.5307027145f + (-0.7265760135f); q = q * t + 0.7107068705f; q = q * t + (-0.142248368f); q = q * t + 0.127414796f; q = q * t;
    const f32x2 s = (v * v) * (-0.72134752044f);
    f32x2 e; e.x = __builtin_amdgcn_exp2f(s.x); e.y = __builtin_amdgcn_exp2f(s.y);
    const f32x2 m = v * (q * e), r = v - m;
    f32x2 o; o.x = v.x < 0.f ? m.x : r.x; o.y = v.y < 0.f ? m.y : r.y; return o;
}

template <int ACT  > struct EpiBf16 {
    static constexpr bool PERM = true, AFTER_DRAIN = false; static_assert(ACT == 0 || ACT == 1, "EpiBf16: ACT is 0 (none) or 1 (gelu_pk)");
    bf16_t* O; int ldc; const float* bias; int split_cols; size_t split_stride; float scale0;
    __device__ __forceinline__ void operator()(const f32x4 (&acc)[2][2][4][2], const Unit& u, int wr, int wc, int fr, int fq) const {
        const int row0 = u.pm * BM + wr * 64 + fr; int colt = u.pn * BM; bf16_t* base = O;
        float sc = 1.f; if (split_cols) { const int t = colt / split_cols; base += (size_t)t * split_stride; colt -= t * split_cols; if (t == 0) sc = scale0; }
        const int col0 = colt + wc * 32 + 8 * fq, bcol0 = u.pn * BM + wc * 32 + 8 * fq;
        f32x4 bv[2][2];
#pragma unroll
        for (int bj = 0; bj < 2; ++bj)
#pragma unroll
            for (int n = 0; n < 2; ++n) bv[bj][n] = bias ? *(const f32x4*)(bias + bcol0 + bj * HALF + 4 * n) : (f32x4){0.f, 0.f, 0.f, 0.f};
#pragma unroll
        for (int ai = 0; ai < 2; ++ai)
#pragma unroll
            for (int m = 0; m < 4; ++m) { bf16_t* rowp = base + (size_t)(row0 + ai * HALF + m * 16) * ldc + col0;
#pragma unroll
                for (int bj = 0; bj < 2; ++bj) { f32x4 v0 = acc[ai][bj][m][0] + bv[bj][0], v1 = acc[ai][bj][m][1] + bv[bj][1];
                    if (ACT == 1) { f32x2 a = gelu_pk((f32x2){v0[0], v0[1]}), b = gelu_pk((f32x2){v0[2], v0[3]}), c = gelu_pk((f32x2){v1[0], v1[1]}), d = gelu_pk((f32x2){v1[2], v1[3]});
                        v0 = (f32x4){a.x, a.y, b.x, b.y}; v1 = (f32x4){c.x, c.y, d.x, d.y}; }
                    v0 = v0 * sc; v1 = v1 * sc; u32x4 w; w.x = cvt_pk_bf16(v0[0], v0[1]); w.y = cvt_pk_bf16(v0[2], v0[3]); w.z = cvt_pk_bf16(v1[0], v1[1]); w.w = cvt_pk_bf16(v1[2], v1[3]);
                    *(u32x4*)(rowp + bj * HALF) = w; } }
    }
};

template <class Epi, class Sched, bool ALIGN_EPI = false, bool SP2 = false>
__device__ __forceinline__ void gemm_phase(PG8_LAS unsigned char* lds, const Gemm g, const Sched& S, const Epi& E) {
    const int tid = tid_fresh(), wid = __builtin_amdgcn_readfirstlane(tid >> 6), lane = tid & 63, wr = wid >> 2, wc = wid & 3, fr = lane & 15, fq = lane >> 4;
    const int K = g.K, nt = K / BK;
    unsigned voffA[2], voffB[2];
#pragma unroll
    for (int i = 0; i < 2; ++i) { int R, C; stage_rc(tid * 16 + i * 8192, R, C); const int Rb = Epi::PERM ? ((R & ~31) + perm32(R & 31)) : R;
        voffA[i] = (unsigned)(R * K + C) * 2u; voffB[i] = (unsigned)(Rb * K + C) * 2u; }
    const size_t kstep = (size_t)(BK * 2);
    const size_t hstep = (size_t)HALF * K * 2;
    const size_t tstep = 2 * hstep;
    const unsigned ldsw = (unsigned)wid * 1024u;
    const int aoff = lds_byte(wr * 64 + fr, fq * 8), boff = lds_byte(wc * 32 + fr, fq * 8);
#define PG8_SA(b, h) (((b) * 2 + (h)) * HTB)
#define PG8_SB(b, h) ((4 + (b) * 2 + (h)) * HTB)
#define PG8_STAGE(bufoff, gbase, voff) do { _Pragma("unroll") for (int _i = 0; _i < 2; ++_i) \
        __builtin_amdgcn_global_load_lds((const unsigned*)((const char*)(gbase) + (voff)[_i]), (PG8_LAS unsigned*)(lds + (bufoff) + ldsw + _i * 8192), 16, 0, 0); } while (0)
#define PG8_LDA(dst, b, h) do { _Pragma("unroll") for (int m = 0; m < 4; ++m) _Pragma("unroll") for (int k = 0; k < 2; ++k) dst[m][k] = *(const PG8_LAS bf16x8*)(lds + PG8_SA(b, h) + aoff + m * 2048 + k * 1024); } while (0)
#define PG8_LDB(dst, b, h) do { _Pragma("unroll") for (int n = 0; n < 2; ++n) _Pragma("unroll") for (int k = 0; k < 2; ++k) dst[n][k] = *(const PG8_LAS bf16x8*)(lds + PG8_SB(b, h) + boff + n * 2048 + k * 1024); } while (0)
#define PG8_MMA(ai, bj, At, Bt) do { __builtin_amdgcn_s_setprio(1); _Pragma("unroll") for (int m = 0; m < 4; ++m) _Pragma("unroll") for (int n = 0; n < 2; ++n) _Pragma("unroll") for (int k = 0; k < 2; ++k) \
        acc[ai][bj][m][n] = __builtin_amdgcn_mfma_f32_16x16x32_bf16(Bt[n][k], At[m][k], acc[ai][bj][m][n], 0, 0, 0); __builtin_amdgcn_s_setprio(0); } while (0)
#define PG8_WAIT_V(n) asm volatile("s_waitcnt vmcnt(" #n ")" ::: "memory")
#define PG8_WAIT_L(n) asm volatile("s_waitcnt lgkmcnt(" #n ")" ::: "memory")
#define PG8_BAR __builtin_amdgcn_s_barrier()
#define PG8_SCHED __builtin_amdgcn_sched_barrier(0)
    Unit cur, nxt; int ui = 0;
    if (!S.next(0, cur)) return;
    f32x4 acc[2][2][4][2];
#pragma unroll
    for (int a = 0; a < 2; ++a)
#pragma unroll
        for (int b = 0; b < 2; ++b)
#pragma unroll
            for (int m = 0; m < 4; ++m)
#pragma unroll
                for (int n = 0; n < 2; ++n) acc[a][b][m][n] = (f32x4){0.f, 0.f, 0.f, 0.f};
    bf16x8 At[4][2], B0[2][2], B1[2][2];
    const char* cA = (const char*)g.A + (size_t)cur.pm * tstep; const char* cB = (const char*)g.Bt + (size_t)cur.pn * tstep;
    S.a_ready(cur);
    if constexpr (SP2) {
        PG8_STAGE(PG8_SB(0, 0), cB, voffB); PG8_STAGE(PG8_SB(0, 1), cB + hstep, voffB); PG8_STAGE(PG8_SA(0, 0), cA, voffA); PG8_STAGE(PG8_SA(0, 1), cA + hstep, voffA);
        if (wr == 1) PG8_BAR;
        PG8_WAIT_V(2); PG8_BAR;
        PG8_STAGE(PG8_SB(1, 0), cB + kstep, voffB); PG8_STAGE(PG8_SA(1, 0), cA + kstep, voffA); PG8_STAGE(PG8_SB(1, 1), cB + hstep + kstep, voffB);
        PG8_WAIT_V(6); PG8_BAR;
    } else {
        PG8_STAGE(PG8_SB(0, 0), cB, voffB); PG8_STAGE(PG8_SA(0, 0), cA, voffA); PG8_STAGE(PG8_SB(0, 1), cB + hstep, voffB); PG8_STAGE(PG8_SA(0, 1), cA + hstep, voffA);
        if (wr == 1) PG8_BAR;
        PG8_WAIT_V(4); PG8_BAR;
        PG8_STAGE(PG8_SB(1, 0), cB + kstep, voffB); PG8_STAGE(PG8_SA(1, 0), cA + kstep, voffA); PG8_STAGE(PG8_SB(1, 1), cB + hstep + kstep, voffB);
        PG8_WAIT_V(6); PG8_BAR;
    }
    for (;;) {
        const bool has_next = S.next(ui + 1, nxt);
        const char* nA = has_next ? (const char*)g.A + (size_t)nxt.pm * tstep : cA; const char* nB = has_next ? (const char*)g.Bt + (size_t)nxt.pn * tstep : cB;
        for (int t = 0; t < nt; t += 2) {
            const bool last = (t == nt - 2);
            const char* a1 = cA + (size_t)(t + 1) * kstep;
            const char* a2 = last ? nA : cA + (size_t)(t + 2) * kstep; const char* b2 = last ? nB : cB + (size_t)(t + 2) * kstep;
            const char* a3 = a2 + kstep; const char* b3 = b2 + kstep;
            if (last && has_next) S.a_ready(nxt);
            if constexpr (SP2) {
            PG8_LDB(B0, 0, 0); PG8_LDB(B1, 0, 1); PG8_SCHED; PG8_LDA(At, 0, 0); PG8_STAGE(PG8_SA(1, 1), a1 + hstep, voffA);
            PG8_WAIT_V(8); PG8_WAIT_L(0); PG8_BAR; PG8_MMA(0, 0, At, B0); PG8_MMA(0, 1, At, B1); PG8_BAR; PG8_SCHED;
            PG8_LDA(At, 0, 1); PG8_STAGE(PG8_SB(0, 0), b2, voffB); PG8_STAGE(PG8_SB(0, 1), b2 + hstep, voffB); PG8_STAGE(PG8_SA(0, 0), a2, voffA);
            PG8_WAIT_V(8); PG8_WAIT_L(0); PG8_BAR; PG8_MMA(1, 0, At, B0); PG8_MMA(1, 1, At, B1); PG8_BAR; PG8_SCHED;
            PG8_LDB(B0, 1, 0); PG8_LDB(B1, 1, 1); PG8_SCHED; PG8_LDA(At, 1, 0); PG8_STAGE(PG8_SA(0, 1), a2 + hstep, voffA);
            PG8_WAIT_V(8); PG8_WAIT_L(0); PG8_BAR; PG8_MMA(0, 0, At, B0); PG8_MMA(0, 1, At, B1); PG8_BAR; PG8_SCHED;
            PG8_LDA(At, 1, 1); PG8_STAGE(PG8_SB(1, 0), b3, voffB); PG8_STAGE(PG8_SB(1, 1), b3 + hstep, voffB); PG8_STAGE(PG8_SA(1, 0), a3, voffA);
            PG8_WAIT_V(8); PG8_WAIT_L(0); PG8_BAR; PG8_MMA(1, 0, At, B0); PG8_MMA(1, 1, At, B1); PG8_BAR; PG8_SCHED;
            } else {
            PG8_LDB(B0, 0, 0); PG8_SCHED; PG8_LDA(At, 0, 0); PG8_STAGE(PG8_SA(1, 1), a1 + hstep, voffA);
            PG8_WAIT_L(8); PG8_BAR; PG8_WAIT_L(0); PG8_MMA(0, 0, At, B0); PG8_BAR; PG8_SCHED;
            PG8_LDB(B1, 0, 1); PG8_STAGE(PG8_SB(0, 0), b2, voffB);
            PG8_BAR; PG8_WAIT_L(0); PG8_MMA(0, 1, At, B1); PG8_BAR;
            PG8_LDA(At, 0, 1); PG8_STAGE(PG8_SA(0, 0), a2, voffA);
            PG8_BAR; PG8_WAIT_L(0); PG8_MMA(1, 0, At, B0); PG8_BAR; PG8_SCHED;
            PG8_STAGE(PG8_SB(0, 1), b2 + hstep, voffB);
            PG8_WAIT_V(6); PG8_BAR; PG8_MMA(1, 1, At, B1); PG8_BAR;
            PG8_LDB(B0, 1, 0); PG8_SCHED; PG8_LDA(At, 1, 0); PG8_STAGE(PG8_SA(0, 1), a2 + hstep, voffA);
            PG8_WAIT_L(8); PG8_BAR; PG8_WAIT_L(0); PG8_MMA(0, 0, At, B0); PG8_BAR; PG8_SCHED;
            PG8_LDB(B1, 1, 1); PG8_STAGE(PG8_SB(1, 0), b3, voffB);
            PG8_BAR; PG8_WAIT_L(0); PG8_MMA(0, 1, At, B1); PG8_BAR;
            PG8_LDA(At, 1, 1); PG8_STAGE(PG8_SA(1, 0), a3, voffA);
            PG8_BAR; PG8_WAIT_L(0); PG8_MMA(1, 0, At, B0); PG8_BAR; PG8_SCHED;
            PG8_STAGE(PG8_SB(1, 1), b3 + hstep, voffB);
            PG8_WAIT_V(6); PG8_BAR; PG8_MMA(1, 1, At, B1); PG8_BAR;
            }
        }
        if constexpr (ALIGN_EPI) { if (wr == 0) PG8_BAR; }
        if constexpr (!Epi::AFTER_DRAIN) { E(acc, cur, wr, wc, fr, fq); S.done(cur); }
        if (!has_next) break;
#pragma unroll
        for (int a = 0; a < 2; ++a)
#pragma unroll
            for (int b = 0; b < 2; ++b)
#pragma unroll
                for (int m = 0; m < 4; ++m)
#pragma unroll
                    for (int n = 0; n < 2; ++n) acc[a][b][m][n] = (f32x4){0.f, 0.f, 0.f, 0.f};
        cur = nxt; cA = nA; cB = nB; ++ui;
        if constexpr (ALIGN_EPI) { if (wr == 1) PG8_BAR; }
    }
    PG8_WAIT_V(0);
    if constexpr (!ALIGN_EPI) { if (wr == 0) PG8_BAR; }
    PG8_BAR;
    if constexpr (Epi::AFTER_DRAIN) { E.fused(acc, cur, wr, wc, fr, fq, lds, wid, lane); S.done(cur); }
#undef PG8_SA
#undef PG8_SB
#undef PG8_STAGE
#undef PG8_LDA
#undef PG8_LDB
#undef PG8_MMA
#undef PG8_WAIT_V
#undef PG8_WAIT_L
#undef PG8_BAR
#undef PG8_SCHED
}
}

namespace pg8 {
__device__ __forceinline__ float silu_f(float x) { return x * __builtin_amdgcn_rcpf(1.0f + __builtin_amdgcn_exp2f(-1.4426950408889634f * x)); }
struct EpiSwiglu {
    static constexpr bool PERM = true, AFTER_DRAIN = false;
    bf16_t* O; int ldc;
    __device__ __forceinline__ void operator()(const f32x4 (&acc)[2][2][4][2], const Unit& u, int wr, int wc, int fr, int fq) const {
        const int row0 = u.pm * BM + wr * 64 + fr; const int col0 = u.pn * HALF + wc * 32 + 8 * fq;
#pragma unroll
        for (int ai = 0; ai < 2; ++ai)
#pragma unroll
            for (int m = 0; m < 4; ++m) { bf16_t* rowp = O + (size_t)(row0 + ai * HALF + m * 16) * ldc + col0;
                const f32x4 g0 = acc[ai][0][m][0], g1 = acc[ai][0][m][1], u0 = acc[ai][1][m][0], u1 = acc[ai][1][m][1];
                f32x4 v0, v1;
#pragma unroll
                for (int i = 0; i < 4; ++i) { v0[i] = silu_f(g0[i]) * u0[i]; v1[i] = silu_f(g1[i]) * u1[i]; }
                u32x4 w; w.x = cvt_pk_bf16(v0[0], v0[1]); w.y = cvt_pk_bf16(v0[2], v0[3]); w.z = cvt_pk_bf16(v1[0], v1[1]); w.w = cvt_pk_bf16(v1[2], v1[3]);
                *(u32x4*)rowp = w; }
    }
};
struct EpiSwigluR {
    static constexpr bool PERM = true, AFTER_DRAIN = false;
    bf16_t* O; int ldc; const float* rstd;
    __device__ __forceinline__ void operator()(const f32x4 (&acc)[2][2][4][2], const Unit& u, int wr, int wc, int fr, int fq) const {
        const int row0 = u.pm * BM + wr * 64 + fr; const int col0 = u.pn * HALF + wc * 32 + 8 * fq;
        float rs[2][4];
        { const f32x4 r0 = *(const f32x4*)(rstd + u.pm * BM + (wr * 16 + fr) * 8), r1 = *(const f32x4*)(rstd + u.pm * BM + (wr * 16 + fr) * 8 + 4);
#pragma unroll
          for (int m = 0; m < 4; ++m) { rs[0][m] = r0[m]; rs[1][m] = r1[m]; } }
#pragma unroll
        for (int ai = 0; ai < 2; ++ai)
#pragma unroll
            for (int m = 0; m < 4; ++m) { bf16_t* rowp = O + (size_t)(row0 + ai * HALF + m * 16) * ldc + col0; const float r = rs[ai][m];
                const f32x4 g0 = acc[ai][0][m][0] * r, g1 = acc[ai][0][m][1] * r, u0 = acc[ai][1][m][0] * r, u1 = acc[ai][1][m][1] * r;
                f32x4 v0, v1;
#pragma unroll
                for (int i = 0; i < 4; ++i) { v0[i] = silu_f(g0[i]) * u0[i]; v1[i] = silu_f(g1[i]) * u1[i]; }
                u32x4 w; w.x = cvt_pk_bf16(v0[0], v0[1]); w.y = cvt_pk_bf16(v0[2], v0[3]); w.z = cvt_pk_bf16(v1[0], v1[1]); w.w = cvt_pk_bf16(v1[2], v1[3]);
                __builtin_nontemporal_store(w, (u32x4*)rowp); }
    }
};
struct EpiBf16BlkR {
    static constexpr bool PERM = true, AFTER_DRAIN = false;
    bf16_t* O; int Mrows; const float* rstd;
    __device__ __forceinline__ void operator()(const f32x4 (&acc)[2][2][4][2], const Unit& u, int wr, int wc, int fr, int fq) const {
        const int row0 = u.pm * BM + wr * 64 + fr; const int col0 = wc * 32 + 8 * fq;
        float rs[2][4];
        { const f32x4 r0 = *(const f32x4*)(rstd + u.pm * BM + (wr * 16 + fr) * 8), r1 = *(const f32x4*)(rstd + u.pm * BM + (wr * 16 + fr) * 8 + 4);
#pragma unroll
          for (int m = 0; m < 4; ++m) { rs[0][m] = r0[m]; rs[1][m] = r1[m]; } }
#pragma unroll
        for (int ai = 0; ai < 2; ++ai)
#pragma unroll
            for (int m = 0; m < 4; ++m) { const int row = row0 + ai * HALF + m * 16; const float r = rs[ai][m];
#pragma unroll
                for (int bj = 0; bj < 2; ++bj) { const f32x4 v0 = acc[ai][bj][m][0] * r, v1 = acc[ai][bj][m][1] * r;
                    u32x4 w; w.x = cvt_pk_bf16(v0[0], v0[1]); w.y = cvt_pk_bf16(v0[2], v0[3]); w.z = cvt_pk_bf16(v1[0], v1[1]); w.w = cvt_pk_bf16(v1[2], v1[3]);
                    *(u32x4*)(O + ((size_t)u.pn * Mrows + row) * 256 + bj * HALF + col0) = w; } }
    }
};
template <bool BIN, bool BOUT> struct EpiResidT {
    static constexpr bool PERM = true, AFTER_DRAIN = false;
    const void* base; void* out; int ldc; float* rsp;
    __device__ __forceinline__ void operator()(const f32x4 (&acc)[2][2][4][2], const Unit& u, int wr, int wc, int fr, int fq) const {
        const int row0 = u.pm * BM + wr * 64 + fr; const int col0 = u.pn * BM + wc * 32 + 8 * fq;
#pragma unroll
        for (int ai = 0; ai < 2; ++ai) {
            f32x4 bs[4][2][2];
#pragma unroll
            for (int m = 0; m < 4; ++m) { const size_t off = (size_t)(row0 + ai * HALF + m * 16) * ldc + col0;
#pragma unroll
                for (int bj = 0; bj < 2; ++bj) {
                    if (BIN) { const u32x4 w = *(const u32x4*)((const bf16_t*)base + off + bj * HALF);
                        bs[m][bj][0] = (f32x4){__uint_as_float(w.x << 16), __uint_as_float(w.x & 0xffff0000u), __uint_as_float(w.y << 16), __uint_as_float(w.y & 0xffff0000u)};
                        bs[m][bj][1] = (f32x4){__uint_as_float(w.z << 16), __uint_as_float(w.z & 0xffff0000u), __uint_as_float(w.w << 16), __uint_as_float(w.w & 0xffff0000u)}; }
                    else { bs[m][bj][0] = *(const f32x4*)((const float*)base + off + bj * HALF); bs[m][bj][1] = *(const f32x4*)((const float*)base + off + bj * HALF + 4); } } }
#pragma unroll
            for (int m = 0; m < 4; ++m) { const size_t off = (size_t)(row0 + ai * HALF + m * 16) * ldc + col0; float ss = 0.f;
#pragma unroll
                for (int bj = 0; bj < 2; ++bj) { const f32x4 o0 = bs[m][bj][0] + acc[ai][bj][m][0], o1 = bs[m][bj][1] + acc[ai][bj][m][1];
                    ss += ((o0[0] * o0[0] + o0[1] * o0[1]) + (o0[2] * o0[2] + o0[3] * o0[3])) + ((o1[0] * o1[0] + o1[1] * o1[1]) + (o1[2] * o1[2] + o1[3] * o1[3]));
                    if (BOUT) { u32x4 w; w.x = cvt_pk_bf16(o0[0], o0[1]); w.y = cvt_pk_bf16(o0[2], o0[3]); w.z = cvt_pk_bf16(o1[0], o1[1]); w.w = cvt_pk_bf16(o1[2], o1[3]); *(u32x4*)((bf16_t*)out + off + bj * HALF) = w; }
                    else { *(f32x4*)((float*)out + off + bj * HALF) = o0; *(f32x4*)((float*)out + off + bj * HALF + 4) = o1; } }
                if (rsp) { ss += __shfl_xor(ss, 16); ss += __shfl_xor(ss, 32); if (fq == 0) rsp[(size_t)(row0 + ai * HALF + m * 16) * 16 + u.pn * 4 + wc] = ss; } }
            asm volatile("" ::: "memory");
        }
    }
};
}

#define LAS __attribute__((address_space(3)))
typedef unsigned short bf16;
typedef unsigned u32x4 __attribute__((ext_vector_type(4)));
typedef unsigned u32x2 __attribute__((ext_vector_type(2)));
typedef float f32x4 __attribute__((ext_vector_type(4)));
typedef float f32x2_t __attribute__((ext_vector_type(2)));

constexpr int M_ = 32768, D_ = 1024, T_ = 4096, FF_ = 2816;
constexpr int AB_N = 2816, AB_LD = 2824, CD_N = 3584, CD_LD = 3588;
constexpr float EPS_ = 1e-6f;
constexpr size_t MiB = 1u << 20;
constexpr size_t WS_CTL = 0, WS_ROPE = 1 * MiB, WS_GATE = 2 * MiB, WS_CUMF = 3 * MiB,
    WS_WABIN = 4 * MiB, WS_WABOUT = 15 * MiB, WS_WCDIN = 19 * MiB, WS_WCDOUT = 33 * MiB, WS_WGU = 37 * MiB, WS_WDN = 81 * MiB,
    WS_UY = 104 * MiB, WS_BIG = 168 * MiB, WS_ST = 392 * MiB, WS_END = 512 * MiB;
#define BIGX(row, col) ((((size_t)((col) >> 8)) * M_ + (size_t)(row)) * 256 + ((col) & 255))
constexpr size_t WS_RSTD1 = WS_CUMF + 512 * 1024;
constexpr size_t WS_RSP = WS_ST + 100 * MiB, WS_RSTD = WS_ST + 103 * MiB;
constexpr int LDS_BYTES = 147456;

struct Args { const float* in[22]; float* out; unsigned char* ws; };
typedef const Args __attribute__((address_space(4)))* ArgsP;
__device__ __forceinline__ ArgsP fresh_args() { auto p = __builtin_amdgcn_kernarg_segment_ptr(); asm volatile("" : "+s"(p)); return (ArgsP)p; }

typedef __bf16 bf16x2_hw __attribute__((ext_vector_type(2)));
__device__ __forceinline__ unsigned pk2(float lo, float hi) { f32x2_t v = {lo, hi}; bf16x2_hw b = __builtin_convertvector(v, bf16x2_hw); return __builtin_bit_cast(unsigned, b); }
__device__ __forceinline__ unsigned f2bf(float f) { return pk2(f, 0.f) & 0xffffu; }
__device__ __forceinline__ float bflo(unsigned u) { return __uint_as_float(u << 16); }
__device__ __forceinline__ float bfhi(unsigned u) { return __uint_as_float(u & 0xffff0000u); }
__device__ __forceinline__ float bf2f(bf16 v) { return __uint_as_float(((unsigned)v) << 16); }
__device__ __forceinline__ float siluf(float x) { return x * __builtin_amdgcn_rcpf(1.f + __builtin_amdgcn_exp2f(-1.4426950408889634f * x)); }
__device__ __forceinline__ float sigmf(float x) { return __builtin_amdgcn_rcpf(1.f + __builtin_amdgcn_exp2f(-1.4426950408889634f * x)); }
__device__ __forceinline__ float softplusf(float x) { return x > 20.f ? x : log1pf(expf(x)); }
__device__ __forceinline__ float logsigf(float x) { return fminf(x, 0.f) - log1pf(expf(-fabsf(x))); }
__device__ __forceinline__ float wave_sum(float v) {
#pragma unroll
    for (int o = 1; o < 64; o <<= 1) v += __shfl_xor(v, o);
    return v;
}
#define LDS_WAIT() asm volatile("s_waitcnt lgkmcnt(0)" ::: "memory")
#define LBAR() do { asm volatile("s_waitcnt lgkmcnt(0)" ::: "memory"); __builtin_amdgcn_s_barrier(); asm volatile("" ::: "memory"); } while (0)

#define XB_TMO      128
#define XB_XCNT(j)  (256  + 64 * (j))
#define XB_XSUB(j)  (1280 + 64 * (j))
#define XB_XGEN(j)  (2304 + 64 * (j))
#define XB_TOP      3328
#define XB_TOPGEN   3392
#define XCD_BAR_WORDS 3456
#define XB_SPIN_CAP (1u << 18)

__device__ __forceinline__ unsigned xb_ld(unsigned* p)              { return __hip_atomic_load(p, __ATOMIC_RELAXED, __HIP_MEMORY_SCOPE_AGENT); }
__device__ __forceinline__ unsigned xb_add(unsigned* p, unsigned v) { return __hip_atomic_fetch_add(p, v, __ATOMIC_RELAXED, __HIP_MEMORY_SCOPE_AGENT); }
__device__ __forceinline__ unsigned xb_xcc_id() { return (unsigned)__builtin_amdgcn_s_getreg((3 << 11) | 20) & 0xFu; }
#define XB_SPIN(cond, bar) do { unsigned _sp = 0; while (cond) { __builtin_amdgcn_s_sleep(1); \
    if ((++_sp & 255u) == 0u) { if (xb_ld(&(bar)[XB_TMO])) break; if (_sp > XB_SPIN_CAP) { atomicAdd(&(bar)[XB_TMO], 1u); break; } } } } while (0)

struct XcdBarrier {
    unsigned* bar; unsigned x;
    volatile LAS unsigned* st;
};

__device__ __forceinline__ XcdBarrier xcd_barrier_post(unsigned* bar, volatile LAS unsigned* st) {
    XcdBarrier b; b.bar = bar; b.x = xb_xcc_id(); b.st = st;
    if (threadIdx.x == 0) (void)xb_add(&bar[XB_XCNT(b.x)], 1u);
    return b;
}
__device__ __forceinline__ void xcd_barrier_complete(unsigned* bar, unsigned x, unsigned& nloc, unsigned& nx) {
    const unsigned G = gridDim.x * gridDim.y * gridDim.z;
    unsigned sum, cnt, mine, sp = 0u;
    for (;;) {
        sum = 0u; cnt = 0u; mine = 0u;
#pragma unroll
        for (unsigned j = 0; j < 16; ++j) { const unsigned c = xb_ld(&bar[XB_XCNT(j)]); sum += c; cnt += (c > 0u) ? 1u : 0u; mine = (j == x) ? c : mine; }
        if (sum == G) break;
        __builtin_amdgcn_s_sleep(1);
        if ((++sp & 255u) == 0u) { if (xb_ld(&bar[XB_TMO])) break; if (sp > XB_SPIN_CAP) { atomicAdd(&bar[XB_TMO], 1u); break; } }
    }
    nloc = mine > 0u ? mine : 1u; nx = cnt > 0u ? cnt : 1u;
}

__device__ __forceinline__ void xcd_barrier(const XcdBarrier& b) {
    asm volatile("s_waitcnt vmcnt(0)" ::: "memory");
    __syncthreads();
    if (threadIdx.x == 0) {
        unsigned* bar = b.bar;
        __builtin_amdgcn_s_waitcnt(0);
        unsigned nloc = b.st[0], nx = b.st[1];
        if (nloc == 0u) { xcd_barrier_complete(bar, b.x, nloc, nx); b.st[0] = nloc; b.st[1] = nx; }
        const unsigned old = xb_add(&bar[XB_XSUB(b.x)], 1u);
        const unsigned gen = old / nloc;
        if (old + 1u == (gen + 1u) * nloc) {
            __builtin_amdgcn_fence(__ATOMIC_RELEASE, "agent");
            asm volatile("s_waitcnt vmcnt(0)" ::: "memory");
            const unsigned og = xb_add(&bar[XB_TOP], 1u);
            const unsigned tg = og / nx;
            if (og + 1u == (tg + 1u) * nx) xb_add(&bar[XB_TOPGEN], 1u);
            else XB_SPIN(xb_ld(&bar[XB_TOPGEN]) == tg, bar);
            __builtin_amdgcn_fence(__ATOMIC_ACQUIRE, "agent");
            xb_add(&bar[XB_XGEN(b.x)], 1u);
            asm volatile("s_waitcnt vmcnt(0)" ::: "memory");
        } else {
            XB_SPIN(xb_ld(&bar[XB_XGEN(b.x)]) == gen, bar);
            __builtin_amdgcn_fence(__ATOMIC_ACQUIRE, "agent");
            asm volatile("s_waitcnt vmcnt(0)" ::: "memory");
        }
    }
    __syncthreads();
}

__device__ __forceinline__ void tr_matrix(const float* W, int ldw, int K, int N, bf16* WT, int mode, const float* kscale, float* scr, int gw, int NGW, int lane) {
    const int nblk = N / 32, nitems = (K / 64) * nblk;
    float nx[32];
    if (gw < nitems) { const int kb = gw / nblk, nb = gw % nblk;
#pragma unroll
        for (int i = 0; i < 32; ++i) { const int kk = 2 * i + (lane >> 5); nx[i] = W[(size_t)(64 * kb + kk) * ldw + 32 * nb + (lane & 31)]; } }
    for (int it = gw; it < nitems; it += NGW) {
        const int kb = it / nblk, nb = it % nblk, k0 = 64 * kb, n0 = 32 * nb;
#pragma unroll
        for (int i = 0; i < 32; ++i) { const int kk = 2 * i + (lane >> 5); scr[kk * 33 + (lane & 31)] = kscale ? nx[i] * kscale[k0 + kk] : nx[i]; }
        if (it + NGW < nitems) { const int kb2 = (it + NGW) / nblk, nb2 = (it + NGW) % nblk;
#pragma unroll
            for (int i = 0; i < 32; ++i) { const int kk = 2 * i + (lane >> 5); nx[i] = W[(size_t)(64 * kb2 + kk) * ldw + 32 * nb2 + (lane & 31)]; } }
        LDS_WAIT();
        const int c = lane & 7;
#pragma unroll
        for (int j = 0; j < 4; ++j) { const int nn = (lane >> 3) + 8 * j; const float* s = scr + (8 * c) * 33 + nn;
            u32x4 o; o.x = pk2(s[0 * 33], s[1 * 33]); o.y = pk2(s[2 * 33], s[3 * 33]); o.z = pk2(s[4 * 33], s[5 * 33]); o.w = pk2(s[6 * 33], s[7 * 33]);
            const int n = n0 + nn; const int r = (mode == 0) ? n : ((n >> 7) * 256 + (n & 127) + (mode == 2 ? 128 : 0));
            *(u32x4*)(WT + (size_t)r * K + k0 + 8 * c) = o; }
        LDS_WAIT();
    }
}

__device__ __forceinline__ void prologue(ArgsP a, unsigned char* lds) {
    const int tid = tid_fresh(), lane = tid & 63, wave = tid >> 6;
    const int gw = bid_fresh() * 8 + wave, NGW = gdim_fresh() * 8;
    float* scr = (float*)(lds + wave * 16384);
    unsigned char* ws = a->ws;
#pragma unroll 1
    for (int mi = 0; mi < 20; ++mi) {
        const float* W; int ldw, K, N, mode; bf16* WT; const float* ksc = nullptr;
        if (mi < 8) { const int jj = mi >> 2, t = mi & 3;
            if (t == 0)      { W = a->in[6] + (size_t)jj * D_ * AB_LD; ldw = AB_LD; K = D_; N = AB_N; WT = (bf16*)(ws + WS_WABIN) + (size_t)jj * AB_N * D_; ksc = a->in[1] + (2 * jj) * D_; }
            else if (t == 1) { W = a->in[7] + (size_t)jj * D_ * D_; ldw = D_; K = D_; N = D_; WT = (bf16*)(ws + WS_WABOUT) + (size_t)jj * D_ * D_; }
            else if (t == 2) { W = a->in[15] + (size_t)jj * D_ * CD_LD; ldw = CD_LD; K = D_; N = CD_N; WT = (bf16*)(ws + WS_WCDIN) + (size_t)jj * CD_N * D_; ksc = a->in[1] + (2 * jj + 1) * D_; }
            else             { W = a->in[16] + (size_t)jj * D_ * D_; ldw = D_; K = D_; N = D_; WT = (bf16*)(ws + WS_WCDOUT) + (size_t)jj * D_ * D_; }
            mode = 0;
        } else { const int L = (mi - 8) / 3, t = (mi - 8) % 3; bf16* gu = (bf16*)(ws + WS_WGU) + (size_t)L * 2 * FF_ * D_;
            if (t == 0)      { W = a->in[3] + (size_t)L * D_ * FF_; ldw = FF_; K = D_; N = FF_; WT = gu; mode = 1; ksc = a->in[2] + L * D_; }
            else if (t == 1) { W = a->in[4] + (size_t)L * D_ * FF_; ldw = FF_; K = D_; N = FF_; WT = gu; mode = 2; ksc = a->in[2] + L * D_; }
            else             { W = a->in[5] + (size_t)L * FF_ * D_; ldw = D_; K = FF_; N = D_; WT = (bf16*)(ws + WS_WDN) + (size_t)L * D_ * FF_; mode = 0; }
        }
        tr_matrix(W, ldw, K, N, WT, mode, ksc, scr, gw, NGW, lane);
    }
    float* rope = (float*)(ws + WS_ROPE);
    for (int idx = bid_fresh() * 512 + tid; idx < T_ * 32; idx += gdim_fresh() * 512) {
        const int t = idx >> 5, i = idx & 31;
        const float freq = powf(10000.0f, -(float)i / 31.0f);
        const float ang = (float)t * freq;
        rope[idx] = cosf(ang); rope[T_ * 32 + idx] = sinf(ang);
    }
}

__device__ __forceinline__ int rstd_slot(int row) { const int rr = row & 255; return (row & ~255) + ((((rr >> 6) & 1) * 16 + (rr & 15)) * 8 + (rr >> 7) * 4 + ((rr >> 4) & 3)); }
template <bool BIN, bool WRITE_U> __device__ __forceinline__ void norm_phase(const void* hin_, const float* gain, bf16* U, const float* Wg, int ldw, int goff, int ng, float* GATE, float* RSTD, unsigned char* lds) {
    const int tid = tid_fresh(), lane = tid & 63, wave = tid >> 6;
    float* wl = (float*)lds;
    if (ng > 0) {
        for (int idx = tid; idx < 1024 * 8; idx += 512) { const int k = idx >> 3, g = idx & 7; wl[idx] = (g < ng) ? Wg[(size_t)k * ldw + goff + g] * gain[k] : 0.f; }
    }
    __syncthreads();
    const int gw = bid_fresh() * 8 + wave, NGW = gdim_fresh() * 8;
    f32x4 gn[4];
#pragma unroll
    for (int j = 0; j < 4; ++j) gn[j] = ((const f32x4*)gain)[lane + 64 * j];
    f32x4 nxt[4], nx2[4];
#define NP_LOADROW(dst, r) do { if (BIN) { const u32x2* xr = (const u32x2*)((const bf16*)hin_ + (size_t)(r) * D_) + lane; \
            _Pragma("unroll") for (int j = 0; j < 4; ++j) { const u32x2 w = xr[64 * j]; dst[j] = (f32x4){bflo(w.x), bfhi(w.x), bflo(w.y), bfhi(w.y)}; } } \
        else { const f32x4* xr = (const f32x4*)((const float*)hin_ + (size_t)(r) * D_) + lane; _Pragma("unroll") for (int j = 0; j < 4; ++j) dst[j] = xr[64 * j]; } } while (0)
    if (gw < M_) NP_LOADROW(nxt, gw);
    if (gw + NGW < M_) NP_LOADROW(nx2, gw + NGW);
#pragma unroll 2
    for (int row = gw; row < M_; row += NGW) {
        f32x4 v[4]; float ss = 0.f;
#pragma unroll
        for (int j = 0; j < 4; ++j) { v[j] = nxt[j]; nxt[j] = nx2[j]; ss += (v[j].x * v[j].x + v[j].y * v[j].y) + (v[j].z * v[j].z + v[j].w * v[j].w); }
        if (row + 2 * NGW < M_) NP_LOADROW(nx2, row + 2 * NGW);
        const float rstd = rsqrtf(wave_sum(ss) * (1.f / D_) + EPS_);
        if (lane == 0) RSTD[rstd_slot(row)] = rstd;
        if (WRITE_U) { unsigned long long* o8 = (unsigned long long*)(U + (size_t)row * D_) + lane;
#pragma unroll
            for (int j = 0; j < 4; ++j) o8[64 * j] = (unsigned long long)pk2(v[j].x, v[j].y) | ((unsigned long long)pk2(v[j].z, v[j].w) << 32); }
        if (ng > 0) {
            float acc[8];
#pragma unroll
            for (int g = 0; g < 8; ++g) acc[g] = 0.f;
#pragma unroll
            for (int j = 0; j < 4; ++j)
#pragma unroll
                for (int e = 0; e < 4; ++e) { const int k = 4 * (lane + 64 * j) + e; const f32x4 w0 = *(const f32x4*)(wl + k * 8), w1 = *(const f32x4*)(wl + k * 8 + 4); const float x = v[j][e];
                    acc[0] += x * w0.x; acc[1] += x * w0.y; acc[2] += x * w0.z; acc[3] += x * w0.w; acc[4] += x * w1.x; acc[5] += x * w1.y; acc[6] += x * w1.z; acc[7] += x * w1.w; }
            float mine = 0.f;
#pragma unroll
            for (int g = 0; g < 8; ++g) { const float s = wave_sum(acc[g]) * rstd; if (lane == g) mine = s; }
            if (lane < 8) GATE[(size_t)row * 8 + lane] = mine;
        }
    }
}

__device__ __forceinline__ void rstd_phase(ArgsP a) {
    const float* rsp = (const float*)(a->ws + WS_RSP); float* rstd = (float*)(a->ws + WS_RSTD);
    for (int row = bid_fresh() * 512 + tid_fresh(); row < M_; row += gdim_fresh() * 512) {
        const f32x4 s0 = *(const f32x4*)(rsp + (size_t)row * 16), s1 = *(const f32x4*)(rsp + (size_t)row * 16 + 4), s2 = *(const f32x4*)(rsp + (size_t)row * 16 + 8), s3 = *(const f32x4*)(rsp + (size_t)row * 16 + 12);
        const float t = (((s0[0] + s0[1]) + (s0[2] + s0[3])) + ((s1[0] + s1[1]) + (s1[2] + s1[3]))) + (((s2[0] + s2[1]) + (s2[2] + s2[3])) + ((s3[0] + s3[1]) + (s3[2] + s3[3])));
        rstd[rstd_slot(row)] = rsqrtf(t * (1.f / D_) + EPS_); }
}

__device__ __forceinline__ void cumf_seq(ArgsP a, int j, int bh, unsigned char* lds) {
    const int tid = tid_fresh(), lane = tid & 63, wave = tid >> 6, b = bh >> 2, h = bh & 3;
    const float* GATE = (const float*)(a->ws + WS_GATE); float* CUMF = (float*)(a->ws + WS_CUMF);
    const float fb = a->in[19][j * 4 + h];
    float* tot = (float*)(lds + 140 * 1024);
    float loc[8]; float run = 0.f;
#pragma unroll
    for (int i = 0; i < 8; ++i) { run += logsigf(GATE[((size_t)b * T_ + tid * 8 + i) * 8 + h] + fb); loc[i] = run; }
    float inc = run;
#pragma unroll
    for (int o = 1; o < 64; o <<= 1) { const float n = __shfl_up(inc, o); if (lane >= o) inc += n; }
    if (lane == 63) tot[wave] = inc;
    __syncthreads();
    float off = inc - run;
    for (int w = 0; w < wave; ++w) off += tot[w];
#pragma unroll
    for (int i = 0; i < 8; ++i) CUMF[(size_t)bh * T_ + tid * 8 + i] = off + loc[i];
    __syncthreads();
}

__device__ __forceinline__ void ret_naive(ArgsP a, int j, int bh, unsigned char* lds) {
    const int b = bh >> 2, h = bh & 3, tid = tid_fresh(), lane = tid & 63, wave = tid >> 6;
    const bf16* BIG = (const bf16*)(a->ws + WS_BIG); const float* rope = (const float*)(a->ws + WS_ROPE); bf16* Y = (bf16*)(a->ws + WS_UY);
    float* qs = (float*)lds; float* ks = qs + 32 * 64; float* vs = ks + 32 * 64; float* op = vs + 32 * 128;
    const int v = tid & 127, dg = tid >> 7;
    float S[16];
#pragma unroll
    for (int d = 0; d < 16; ++d) S[d] = 0.f;
    const float gamma = 1.f - exp2f(-5.f - (float)h);
    const float* gnw = a->in[8] + (j * 4 + h) * 128;
    for (int blk = 0; blk < T_ / 32; ++blk) {
        const int t0 = blk * 32;
        __syncthreads();
#pragma unroll
        for (int r = 0; r < 2; ++r) { const int idx = tid + 512 * r, t = idx >> 5, i = idx & 31; const size_t row = (size_t)b * T_ + t0 + t;
            const unsigned qq = *(const unsigned*)(BIG + row * AB_N + h * 64 + 2 * i), kk = *(const unsigned*)(BIG + row * AB_N + 256 + h * 64 + 2 * i);
            const float c = rope[(t0 + t) * 32 + i], s = rope[T_ * 32 + (t0 + t) * 32 + i];
            const float q1 = bflo(qq), q2 = bfhi(qq), k1 = bflo(kk) * 0.125f, k2 = bfhi(kk) * 0.125f;
            qs[t * 64 + 2 * i] = q1 * c - q2 * s; qs[t * 64 + 2 * i + 1] = q1 * s + q2 * c;
            ks[t * 64 + 2 * i] = k1 * c - k2 * s; ks[t * 64 + 2 * i + 1] = k1 * s + k2 * c; }
#pragma unroll
        for (int r = 0; r < 8; ++r) { const int idx = tid + 512 * r, t = idx >> 7, c = idx & 127; vs[idx] = bf2f(BIG[((size_t)b * T_ + t0 + t) * AB_N + 512 + h * 128 + c]); }
        __syncthreads();
        for (int t = 0; t < 32; ++t) { const float vt = vs[t * 128 + v]; float o = 0.f;
#pragma unroll
            for (int d = 0; d < 16; ++d) { S[d] = S[d] * gamma + ks[t * 64 + dg * 16 + d] * vt; o += qs[t * 64 + dg * 16 + d] * S[d]; }
            op[(dg * 32 + t) * 128 + v] = o; }
        __syncthreads();
#pragma unroll
        for (int tt = 0; tt < 4; ++tt) { const int t = wave * 4 + tt; const size_t row = (size_t)b * T_ + t0 + t;
            float o0 = 0.f, o1 = 0.f;
#pragma unroll
            for (int g = 0; g < 4; ++g) { o0 += op[(g * 32 + t) * 128 + lane]; o1 += op[(g * 32 + t) * 128 + lane + 64]; }
            const float mean = wave_sum(o0 + o1) * (1.f / 128.f); const float d0 = o0 - mean, d1 = o1 - mean;
            const float rs = rsqrtf(wave_sum(d0 * d0 + d1 * d1) * (1.f / 128.f) + EPS_);
            const float g0 = bf2f(BIG[row * AB_N + 1024 + h * 128 + lane]), g1 = bf2f(BIG[row * AB_N + 1024 + h * 128 + lane + 64]);
            Y[row * D_ + h * 128 + lane] = (bf16)f2bf(d0 * rs * gnw[lane] * siluf(g0));
            Y[row * D_ + h * 128 + lane + 64] = (bf16)f2bf(d1 * rs * gnw[lane + 64] * siluf(g1)); }
    }
}

__device__ __forceinline__ void ssd_naive(ArgsP a, int j, int bh, unsigned char* lds) {
    const int b = bh >> 3, h = bh & 7, g = h >> 2, tid = tid_fresh();
    const bf16* BIG = (const bf16*)(a->ws + WS_BIG); const float* GATE = (const float*)(a->ws + WS_GATE); float* TMP = (float*)(a->ws + WS_ST);
    float* xs = (float*)lds; float* Bs = xs + 2048; float* Cs = Bs + 2048; float* dts = Cs + 2048; float* yp = dts + 64;
    const int p = tid & 63, ng = tid >> 6;
    float S[8];
#pragma unroll
    for (int i = 0; i < 8; ++i) S[i] = 0.f;
    const float* cw = a->in[9] + j * 4 * 768; const float* cb = a->in[10] + j * 768;
    const float dtb = a->in[11][j * 8 + h], A = -expf(a->in[12][j * 8 + h]), Dh = a->in[13][j * 8 + h];
    for (int blk = 0; blk < T_ / 32; ++blk) {
        const int t0 = blk * 32;
        __syncthreads();
        for (int r = 0; r < 12; ++r) { const int idx = tid + 512 * r, t = idx / 192, e = idx % 192, which = e >> 6, cc = e & 63;
            const int col = (which == 0) ? (h * 64 + cc) : (which == 1 ? 512 + g * 64 + cc : 640 + g * 64 + cc);
            float acc = cb[col];
#pragma unroll
            for (int w = 0; w < 4; ++w) { const int tt = t0 + t - 3 + w; if (tt >= 0) acc += cw[w * 768 + col] * bf2f(BIG[((size_t)b * T_ + tt) * AB_N + 2048 + col]); }
            const float val = siluf(acc);
            float* dst = (which == 0) ? xs : (which == 1 ? Bs : Cs); dst[t * 64 + cc] = val; }
        if (tid < 32) { const float dtv = softplusf(GATE[((size_t)b * T_ + t0 + tid) * 8 + h] + dtb); dts[tid] = dtv; dts[32 + tid] = expf(dtv * A); }
        __syncthreads();
        for (int t = 0; t < 32; ++t) { const float dtx = dts[t] * xs[t * 64 + p], at = dts[32 + t]; float y = 0.f;
#pragma unroll
            for (int i = 0; i < 8; ++i) { S[i] = at * S[i] + Bs[t * 64 + ng * 8 + i] * dtx; y += Cs[t * 64 + ng * 8 + i] * S[i]; }
            yp[(ng * 32 + t) * 64 + p] = y; }
        __syncthreads();
#pragma unroll
        for (int r = 0; r < 4; ++r) { const int idx = tid + 512 * r, t = idx >> 6, pp = idx & 63; const size_t row = (size_t)b * T_ + t0 + t;
            float y = Dh * xs[t * 64 + pp];
#pragma unroll
            for (int q = 0; q < 8; ++q) y += yp[(q * 32 + t) * 64 + pp];
            const float z = bf2f(BIG[row * AB_N + 1536 + h * 64 + pp]);
            TMP[row * 512 + h * 64 + pp] = y * siluf(z); }
    }
}

__device__ __forceinline__ void ssd_norm_phase(ArgsP a, int j) {
    const int tid = tid_fresh(), lane = tid & 63, wave = tid >> 6;
    const bf16* TMP = (const bf16*)(a->ws + WS_ST); bf16* Y = (bf16*)(a->ws + WS_UY);
    const float* nw = a->in[14] + j * 512;
    const int gw = bid_fresh() * 8 + wave, NGW = gdim_fresh() * 8;
#pragma unroll 4
    for (int it = gw; it < M_ * 2; it += NGW) { const int tok = it >> 1, grp = it & 1;
        const u32x2 t2 = *(const u32x2*)(TMP + (size_t)tok * 512 + grp * 256 + lane * 4);
        const f32x4 v = (f32x4){bflo(t2.x), bfhi(t2.x), bflo(t2.y), bfhi(t2.y)};
        const float rs = rsqrtf(wave_sum((v.x * v.x + v.y * v.y) + (v.z * v.z + v.w * v.w)) * (1.f / 256.f) + EPS_);
        const f32x4 w = *(const f32x4*)(nw + grp * 256 + lane * 4);
        u32x2 o; o.x = pk2(v.x * rs * w.x, v.y * rs * w.y); o.y = pk2(v.z * rs * w.z, v.w * rs * w.w);
        *(u32x2*)(Y + (size_t)tok * D_ + 512 + grp * 256 + lane * 4) = o; }
}

__device__ __forceinline__ void hg_naive(ArgsP a, int j, int bh, unsigned char* lds) {
    const int b = bh >> 2, h = bh & 3, tid = tid_fresh(), lane = tid & 63, wave = tid >> 6;
    const bf16* BIG = (const bf16*)(a->ws + WS_BIG); bf16* Y = (bf16*)(a->ws + WS_UY);
    float* qs = (float*)lds; float* fs = qs + 2048; float* ks = fs + 2048; float* is = ks + 2048; float* op = is + 2048;
    const int v = tid & 127, dg = tid >> 7;
    float S[32];
#pragma unroll
    for (int i = 0; i < 32; ++i) S[i] = 0.f;
    const float* nw = a->in[18] + j * 128;
    for (int blk = 0; blk < T_ / 16; ++blk) {
        const int t0 = blk * 16;
        __syncthreads();
#pragma unroll
        for (int r = 0; r < 4; ++r) { const int idx = tid + 512 * r, t = idx >> 7, c = idx & 127; const size_t row = (size_t)b * T_ + t0 + t;
            const float zf = bf2f(BIG[row * CD_N + 512 + h * 128 + c]);
            float lbv = 0.f; if (j == 1) { const float l0 = a->in[17][h * 128 + c], l1 = a->in[17][512 + h * 128 + c]; lbv = 1.f / (1.f + expf(l0 - l1)); }
            fs[idx] = lbv + (1.f - lbv) * sigmf(zf); ks[idx] = (1.f - lbv) * sigmf(-zf);
            qs[idx] = bf2f(BIG[row * CD_N + h * 128 + c]); is[idx] = bf2f(BIG[row * CD_N + 1024 + h * 128 + c]); }
        __syncthreads();
        for (int t = 0; t < 16; ++t) { const float iv = is[t * 128 + v]; float o = 0.f;
#pragma unroll
            for (int i = 0; i < 32; ++i) { const int d = dg * 32 + i; S[i] = fs[t * 128 + d] * S[i] + ks[t * 128 + d] * iv; o += qs[t * 128 + d] * S[i]; }
            op[(dg * 16 + t) * 128 + v] = o; }
        __syncthreads();
#pragma unroll
        for (int tt = 0; tt < 2; ++tt) { const int t = wave * 2 + tt; const size_t row = (size_t)b * T_ + t0 + t;
            float o0 = 0.f, o1 = 0.f;
#pragma unroll
            for (int g = 0; g < 4; ++g) { o0 += op[(g * 16 + t) * 128 + lane]; o1 += op[(g * 16 + t) * 128 + lane + 64]; }
            const float rs = rsqrtf(wave_sum(o0 * o0 + o1 * o1) * (1.f / 128.f) + EPS_);
            const float g0 = bf2f(BIG[row * CD_N + 1536 + h * 128 + lane]), g1 = bf2f(BIG[row * CD_N + 1536 + h * 128 + lane + 64]);
            Y[row * D_ + h * 128 + lane] = (bf16)f2bf(o0 * rs * nw[lane] * siluf(g0));
            Y[row * D_ + h * 128 + lane + 64] = (bf16)f2bf(o1 * rs * nw[lane + 64] * siluf(g1)); }
    }
}

__device__ __forceinline__ void fox_naive(ArgsP a, int j, int bh, int qb, unsigned char* lds) {
    const int b = bh >> 2, h = bh & 3, tid = tid_fresh();
    const bf16* BIG = (const bf16*)(a->ws + WS_BIG); bf16* Y = (bf16*)(a->ws + WS_UY); const float* CUMF = (const float*)(a->ws + WS_CUMF) + (size_t)bh * T_;
    float* Ks = (float*)lds; float* Vs = Ks + 64 * 128; float* Fs = Vs + 64 * 128;
    const float* qnw = a->in[20] + j * 128; const float* knw = a->in[21] + j * 128;
    const int qi = tid >> 2, part = tid & 3, tq = qb * 128 + qi;
    const size_t rowq = (size_t)b * T_ + tq;
    float q[32], o[32];
    { const u32x4* qp = (const u32x4*)(BIG + rowq * CD_N + 2048 + h * 128 + part * 32); float ss = 0.f;
#pragma unroll
      for (int i = 0; i < 4; ++i) { const u32x4 w = qp[i];
#pragma unroll
          for (int e = 0; e < 4; ++e) { q[i * 8 + 2 * e] = bflo(w[e]); q[i * 8 + 2 * e + 1] = bfhi(w[e]); } }
#pragma unroll
      for (int i = 0; i < 32; ++i) ss += q[i] * q[i];
      ss += __shfl_xor(ss, 1); ss += __shfl_xor(ss, 2);
      const float rs = rsqrtf(ss * (1.f / 128.f) + EPS_) * 0.08838834764831845f;
#pragma unroll
      for (int i = 0; i < 32; ++i) { q[i] *= rs * qnw[part * 32 + i]; o[i] = 0.f; } }
    const float Fq = CUMF[tq];
    float m = -INFINITY, l = 0.f;
    const int ntiles = 2 * qb + 2;
    for (int kt = 0; kt < ntiles; ++kt) {
        __syncthreads();
        { const int r = tid >> 3, seg = tid & 7; const size_t krow = (size_t)b * T_ + kt * 64 + r;
          const u32x4* kp = (const u32x4*)(BIG + krow * CD_N + 2560 + h * 128 + seg * 16); const u32x4* vp = (const u32x4*)(BIG + krow * CD_N + 3072 + h * 128 + seg * 16);
          float kv[16], vv[16]; float ss = 0.f;
#pragma unroll
          for (int i = 0; i < 2; ++i) { const u32x4 w = kp[i], x = vp[i];
#pragma unroll
              for (int e = 0; e < 4; ++e) { kv[i * 8 + 2 * e] = bflo(w[e]); kv[i * 8 + 2 * e + 1] = bfhi(w[e]); vv[i * 8 + 2 * e] = bflo(x[e]); vv[i * 8 + 2 * e + 1] = bfhi(x[e]); } }
#pragma unroll
          for (int i = 0; i < 16; ++i) ss += kv[i] * kv[i];
          ss += __shfl_xor(ss, 1); ss += __shfl_xor(ss, 2); ss += __shfl_xor(ss, 4);
          const float rs = rsqrtf(ss * (1.f / 128.f) + EPS_);
#pragma unroll
          for (int i = 0; i < 16; ++i) { Ks[r * 128 + seg * 16 + i] = kv[i] * rs * knw[seg * 16 + i]; Vs[r * 128 + seg * 16 + i] = vv[i]; }
          if (seg == 0) Fs[r] = CUMF[kt * 64 + r]; }
        __syncthreads();
        for (int s = 0; s < 64; ++s) {
            const int ksi = kt * 64 + s;
            const f32x4* kr = (const f32x4*)(Ks + s * 128 + part * 32); float dot = 0.f;
#pragma unroll
            for (int i = 0; i < 8; ++i) { const f32x4 w = kr[i]; dot += q[4 * i] * w.x + q[4 * i + 1] * w.y + q[4 * i + 2] * w.z + q[4 * i + 3] * w.w; }
            dot += __shfl_xor(dot, 1); dot += __shfl_xor(dot, 2);
            float logit = dot + (Fq - Fs[s]);
            if (ksi > tq) logit = -INFINITY;
            const float mn = fmaxf(m, logit); const float p = __expf(logit - mn), c = __expf(m - mn);
            m = mn; l = l * c + p;
            const f32x4* vr = (const f32x4*)(Vs + s * 128 + part * 32);
#pragma unroll
            for (int i = 0; i < 8; ++i) { const f32x4 w = vr[i]; o[4 * i] = o[4 * i] * c + p * w.x; o[4 * i + 1] = o[4 * i + 1] * c + p * w.y; o[4 * i + 2] = o[4 * i + 2] * c + p * w.z; o[4 * i + 3] = o[4 * i + 3] * c + p * w.w; }
        }
    }
    const float il = 1.f / l;
    u32x4* yp = (u32x4*)(Y + rowq * D_ + 512 + h * 128 + part * 32);
#pragma unroll
    for (int i = 0; i < 4; ++i) { u32x4 w; w.x = pk2(o[8 * i] * il, o[8 * i + 1] * il); w.y = pk2(o[8 * i + 2] * il, o[8 * i + 3] * il); w.z = pk2(o[8 * i + 4] * il, o[8 * i + 5] * il); w.w = pk2(o[8 * i + 6] * il, o[8 * i + 7] * il); yp[i] = w; }
}

constexpr size_t WS_VT = WS_ST;
__device__ __forceinline__ void fox_prep(ArgsP a, int j, unsigned char* lds) {
    const int tid = tid_fresh();
    bf16* BIG = (bf16*)(a->ws + WS_BIG); bf16* VT = (bf16*)(a->ws + WS_VT);
    const float* qnw = a->in[20] + j * 128; const float* knw = a->in[21] + j * 128;
    for (int tile = bid_fresh(); tile < 512; tile += gdim_fresh()) {
        const int b = tile >> 6, tb = tile & 63; const size_t r0 = (size_t)b * T_ + tb * 64;
        __syncthreads();
#pragma unroll
        for (int k = 0; k < 8; ++k) { const int id = tid + 512 * k, r = id >> 6, c = id & 63;
            const u32x4 w = *(const u32x4*)(BIG + BIGX(r0 + r, 3072 + c * 8));
            unsigned* dst = (unsigned*)(lds + r * 1028 + c * 16); dst[0] = w.x; dst[1] = w.y; dst[2] = w.z; dst[3] = w.w; }
#pragma unroll 2
        for (int p = 0; p < 16; ++p) { const int grp = p * 32 + (tid >> 4), sub = tid & 15; const int r = grp >> 3, which = (grp >> 2) & 1, h = grp & 3;
            bf16* ptr = BIG + BIGX(r0 + r, 2048 + which * 512 + h * 128 + sub * 8);
            const u32x4 w = *(const u32x4*)ptr; float v[8];
#pragma unroll
            for (int e = 0; e < 4; ++e) { v[2 * e] = bflo(w[e]); v[2 * e + 1] = bfhi(w[e]); }
            float ss = 0.f;
#pragma unroll
            for (int e = 0; e < 8; ++e) ss += v[e] * v[e];
            ss += __shfl_xor(ss, 1); ss += __shfl_xor(ss, 2); ss += __shfl_xor(ss, 4); ss += __shfl_xor(ss, 8);
            const float rs = rsqrtf(ss * (1.f / 128.f) + EPS_) * (which == 0 ? 0.12751743f : 1.f);
            const float* nw = (which == 0 ? qnw : knw) + sub * 8;
            u32x4 o;
#pragma unroll
            for (int e = 0; e < 4; ++e) o[e] = pk2(v[2 * e] * rs * nw[2 * e], v[2 * e + 1] * rs * nw[2 * e + 1]);
            *(u32x4*)ptr = o; }
        __syncthreads();
#pragma unroll 2
        for (int k = 0; k < 8; ++k) { const int id = tid + 512 * k, c8 = id & 7, d = (id >> 3) & 127, h = id >> 10;
            const bf16* src = (const bf16*)(lds + (8 * c8) * 1028) + h * 128 + d;
            u32x4 o;
#pragma unroll
            for (int e = 0; e < 4; ++e) { const int i0 = 2 * e, i1 = 2 * e + 1;
                const int r0 = 16 * (c8 >> 1) + 4 * (c8 & 1) + (i0 & 3) + 8 * (i0 >> 2) - 8 * c8, r1 = 16 * (c8 >> 1) + 4 * (c8 & 1) + (i1 & 3) + 8 * (i1 >> 2) - 8 * c8;
                o[e] = (unsigned)src[r0 * 514] | ((unsigned)src[r1 * 514] << 16); }
            *(u32x4*)(VT + ((size_t)(b * 4 + h) * 128 + d) * T_ + tb * 64 + c8 * 8) = o; }
    }
}

typedef short bf16x8_t __attribute__((ext_vector_type(8)));
typedef float f32x16 __attribute__((ext_vector_type(16)));
typedef short s16x4_t __attribute__((ext_vector_type(4)));
constexpr int FX_KROW = 272, FX_VROW = 144, FX_KBYTES = 64 * FX_KROW, FX_VBYTES = 128 * FX_VROW, FX_BUF = FX_KBYTES + FX_VBYTES + 256;
__device__ __forceinline__ int crow16(int r, int hi) { return (r & 3) + 8 * (r >> 2) + 4 * hi; }

__device__ __forceinline__ void fox_unit(ArgsP a, int bh, int qb, unsigned char* lds) {
    const int tid = tid_fresh(), lane = tid & 63, wave = tid >> 6, l31 = lane & 31, hi = lane >> 5;
    const int b = bh >> 2, h = bh & 3;
    const bf16* BIG = (const bf16*)(a->ws + WS_BIG); bf16* Y = (bf16*)(a->ws + WS_UY);
    const bf16* VT = (const bf16*)(a->ws + WS_VT) + (size_t)bh * 128 * T_;
    const float* CUMF = (const float*)(a->ws + WS_CUMF) + (size_t)bh * T_;
    const int tq = qb * 256 + wave * 32 + l31; const size_t rowq = (size_t)b * T_ + tq;
    const float Fref = CUMF[qb * 256];
    bf16x8_t qf[8];
#pragma unroll
    for (int ks = 0; ks < 8; ++ks) qf[ks] = *(const bf16x8_t*)(BIG + rowq * CD_N + 2048 + h * 128 + 16 * ks + 8 * hi);
    f32x16 oT[4];
#pragma unroll
    for (int d = 0; d < 4; ++d)
#pragma unroll
        for (int r = 0; r < 16; ++r) oT[d][r] = 0.f;
    float m = -INFINITY, lsum = 0.f;
    const int nt = 4 * qb + 4;
    const bf16* Kg = BIG + ((size_t)b * T_) * CD_N + 2560 + h * 128;
    const int kr0 = tid >> 4, kc = tid & 15;
    const int vd0 = tid >> 3, vc = tid & 7;
    u32x4 kreg[2], vreg[2]; float breg = 0.f;
#define FX_LOAD(kt) do { kreg[0] = *(const u32x4*)(Kg + (size_t)((kt) * 64 + kr0) * CD_N + kc * 8); kreg[1] = *(const u32x4*)(Kg + (size_t)((kt) * 64 + kr0 + 32) * CD_N + kc * 8); \
        vreg[0] = *(const u32x4*)(VT + (size_t)vd0 * T_ + (kt) * 64 + vc * 8); vreg[1] = *(const u32x4*)(VT + (size_t)(vd0 + 64) * T_ + (kt) * 64 + vc * 8); \
        if (tid < 64) breg = (Fref - CUMF[(kt) * 64 + tid]) * 1.4426950408889634f; } while (0)
#define FX_STORE(buf) do { unsigned char* bb = lds + (buf) * FX_BUF; *(u32x4*)(bb + kr0 * FX_KROW + kc * 16) = kreg[0]; *(u32x4*)(bb + (kr0 + 32) * FX_KROW + kc * 16) = kreg[1]; \
        *(u32x4*)(bb + FX_KBYTES + vd0 * FX_VROW + vc * 16) = vreg[0]; *(u32x4*)(bb + FX_KBYTES + (vd0 + 64) * FX_VROW + vc * 16) = vreg[1]; \
        if (tid < 64) ((float*)(bb + FX_KBYTES + FX_VBYTES))[tid] = breg; } while (0)
    __syncthreads();
    FX_LOAD(0); FX_STORE(0);
    __syncthreads();
    for (int kt = 0; kt < nt; ++kt) {
        const int cur = kt & 1;
        if (kt + 1 < nt) FX_LOAD(kt + 1);
        const unsigned char* bb = lds + cur * FX_BUF;
        if (kt * 64 <= qb * 256 + wave * 32 + 31) {
            f32x16 p[2];
#pragma unroll
            for (int hf = 0; hf < 2; ++hf) {
#pragma unroll
                for (int r = 0; r < 16; ++r) p[hf][r] = 0.f;
#pragma unroll
                for (int ks = 0; ks < 8; ++ks) { const bf16x8_t kf = *(const bf16x8_t*)(bb + (32 * hf + l31) * FX_KROW + (16 * ks + 8 * hi) * 2);
                    p[hf] = __builtin_amdgcn_mfma_f32_32x32x16_bf16(kf, qf[ks], p[hf], 0, 0, 0); }
            }
            const float* Bs = (const float*)(bb + FX_KBYTES + FX_VBYTES);
            const bool band = (kt >= 4 * qb);
            float mx = -INFINITY;
#pragma unroll
            for (int hf = 0; hf < 2; ++hf)
#pragma unroll
                for (int g = 0; g < 4; ++g) { const f32x4 bv = *(const f32x4*)(Bs + 32 * hf + 8 * g + 4 * hi);
#pragma unroll
                    for (int e = 0; e < 4; ++e) { const int r = 4 * g + e; float s = p[hf][r] + bv[e];
                        if (band) { const int kv = kt * 64 + 32 * hf + 8 * g + 4 * hi + e; if (kv > tq) s = -INFINITY; }
                        p[hf][r] = s; mx = fmaxf(mx, s); } }
            mx = fmaxf(mx, __shfl_xor(mx, 32));
            const float mn = fmaxf(m, mx); const float alpha = __builtin_amdgcn_exp2f(m - mn); m = mn;
            float ps = 0.f;
#pragma unroll
            for (int hf = 0; hf < 2; ++hf)
#pragma unroll
                for (int r = 0; r < 16; ++r) { const float e = __builtin_amdgcn_exp2f(p[hf][r] - mn); p[hf][r] = e; ps += e; }
            lsum = lsum * alpha + ps;
#pragma unroll
            for (int d = 0; d < 4; ++d)
#pragma unroll
                for (int r = 0; r < 16; ++r) oT[d][r] *= alpha;
            bf16x8_t pb[4];
#pragma unroll
            for (int ks2 = 0; ks2 < 4; ++ks2) { const int hf = ks2 >> 1, c = ks2 & 1; u32x4 w;
#pragma unroll
                for (int e = 0; e < 4; ++e) w[e] = pg8::cvt_pk_bf16(p[hf][8 * c + 2 * e], p[hf][8 * c + 2 * e + 1]);
                pb[ks2] = __builtin_bit_cast(bf16x8_t, w); }
            const unsigned char* vb = bb + FX_KBYTES;
#pragma unroll
            for (int d = 0; d < 4; ++d)
#pragma unroll
                for (int ks2 = 0; ks2 < 4; ++ks2) { const unsigned char* vp = vb + (32 * d + l31) * FX_VROW + (16 * ks2 + 4 * hi) * 2;
                    const s16x4_t lo = *(const s16x4_t*)vp, hi4 = *(const s16x4_t*)(vp + 16);
                    const bf16x8_t vf = (bf16x8_t){lo[0], lo[1], lo[2], lo[3], hi4[0], hi4[1], hi4[2], hi4[3]};
                    oT[d] = __builtin_amdgcn_mfma_f32_32x32x16_bf16(vf, pb[ks2], oT[d], 0, 0, 0); }
        }
        if (kt + 1 < nt) FX_STORE(cur ^ 1);
        __syncthreads();
    }
#undef FX_LOAD
#undef FX_STORE
    lsum += __shfl_xor(lsum, 32);
    const float il = 1.f / lsum;
    bf16* yp = Y + rowq * D_ + 512 + h * 128;
#pragma unroll
    for (int d = 0; d < 4; ++d)
#pragma unroll
        for (int g = 0; g < 4; ++g) { u32x2 w; w.x = pk2(oT[d][4 * g] * il, oT[d][4 * g + 1] * il); w.y = pk2(oT[d][4 * g + 2] * il, oT[d][4 * g + 3] * il);
            *(u32x2*)(yp + 32 * d + 8 * g + 4 * hi) = w; }
}

template <int MODE  >
__device__ __forceinline__ void scalar_stream(ArgsP a, int j, int bh, unsigned char* lds) {
    constexpr int DV = MODE == 0 ? 128 : 64;
    constexpr int RS = 144;
    constexpr int OFF_QN = 0, OFF_QT = 9216, OFF_KN = 18432, OFF_KOT = 27648, OFF_VT = 36864, OFF_P = OFF_VT + DV * RS, OFF_ST = OFF_P + 9216, OFF_OB = OFF_ST + DV * RS;
    constexpr int OBS = DV * 4 + 16;
    constexpr int OFF_CUM = OFF_OB + 64 * OBS, OFF_TAB = OFF_CUM + 512;
    const int tid = tid_fresh(), lane = tid & 63, wave = tid >> 6, l31 = lane & 31, hi = lane >> 5;
    const int b = MODE == 0 ? (bh >> 2) : (bh >> 3), h = MODE == 0 ? (bh & 3) : (bh & 7), g = h >> 2;
    const bf16* BIG = (const bf16*)(a->ws + WS_BIG);
    const float* rope = (const float*)(a->ws + WS_ROPE); const float* GATE = (const float*)(a->ws + WS_GATE);
    bf16* Y = (bf16*)(a->ws + WS_UY); float* TMP = (float*)(a->ws + WS_ST);
    const float LOG2E = 1.4426950408889634f;
    const float gamma = 1.f - exp2f(-5.f - (float)h), lg2gamma = log2f(gamma);
    float dtb = 0.f, Aneg = 0.f, Dh = 0.f;
    if (MODE == 1) { dtb = a->in[11][j * 8 + h]; Aneg = -expf(a->in[12][j * 8 + h]); Dh = a->in[13][j * 8 + h]; }
    const float* gnw = a->in[8] + (j * 4 + h) * 128;
    float* cumL = (float*)(lds + OFF_CUM); float* tab = (float*)(lds + OFF_TAB);
    float gw[16];
#pragma unroll
    for (int e = 0; e < 16; ++e) gw[e] = (MODE == 0) ? gnw[(tid & 7) * 16 + e] : 0.f;
    const int st = lane, sc8 = wave;
    __syncthreads();
    for (int i = tid; i < (DV * RS + 9216) / 4; i += 512) ((unsigned*)(lds + OFF_P))[i] = 0u;
    if (MODE == 1) {
        const float* cw = a->in[9] + j * 4 * 768; const float* cb = a->in[10] + j * 768;
        for (int i = tid; i < 3 * 8 * 5 * 8; i += 512) { const int e = i & 7, w = (i >> 3) % 5, c8 = (i / 40) & 7, which = i / 320;
            const int col = (which == 0 ? h * 64 : (which == 1 ? 512 + g * 64 : 640 + g * 64)) + c8 * 8 + e;
            tab[i] = (w < 4) ? cw[w * 768 + col] : cb[col]; }
    }
    f32x16 sacc;
#pragma unroll
    for (int r = 0; r < 16; ++r) sacc[r] = 0.f;
    u32x4 rq, rk, rv0, rv1; f32x4 rcs, rsn; u32x4 rx[3][4]; float rgate = 0.f;
#define ST_LOAD(c) do { const size_t row = (size_t)b * T_ + (c) * 64 + st; \
        if (MODE == 0) { rq = *(const u32x4*)(BIG + row * AB_N + h * 64 + sc8 * 8); rk = *(const u32x4*)(BIG + row * AB_N + 256 + h * 64 + sc8 * 8); \
            rcs = *(const f32x4*)(rope + ((c) * 64 + st) * 32 + sc8 * 4); rsn = *(const f32x4*)(rope + T_ * 32 + ((c) * 64 + st) * 32 + sc8 * 4); \
            rv0 = *(const u32x4*)(BIG + row * AB_N + 512 + h * 128 + sc8 * 8); rv1 = *(const u32x4*)(BIG + row * AB_N + 512 + h * 128 + (sc8 + 8) * 8); } \
        else { _Pragma("unroll") for (int wh = 0; wh < 3; ++wh) { const int col = (wh == 0 ? h * 64 : (wh == 1 ? 512 + g * 64 : 640 + g * 64)) + sc8 * 8; \
                _Pragma("unroll") for (int w = 0; w < 4; ++w) { const int tt = (c) * 64 + st - 3 + w; \
                    rx[wh][w] = (tt >= 0) ? *(const u32x4*)(BIG + ((size_t)b * T_ + tt) * AB_N + 2048 + col) : (u32x4){0u, 0u, 0u, 0u}; } } \
            rgate = GATE[((size_t)b * T_ + (c) * 64 + lane) * 8 + h]; } } while (0)
    ST_LOAD(0);
    __syncthreads();
    for (int c = 0; c < T_ / 64; ++c) {
        if (MODE == 0) {
            float q[8], k[8];
#pragma unroll
            for (int e = 0; e < 4; ++e) { const float q1 = bflo(rq[e]), q2 = bfhi(rq[e]), k1 = bflo(rk[e]) * 0.125f, k2 = bfhi(rk[e]) * 0.125f; const float cs = rcs[e], sn = rsn[e];
                q[2 * e] = q1 * cs - q2 * sn; q[2 * e + 1] = q1 * sn + q2 * cs; k[2 * e] = k1 * cs - k2 * sn; k[2 * e + 1] = k1 * sn + k2 * cs; }
            const float gi = __builtin_amdgcn_exp2f((float)(st + 1) * lg2gamma), go = __builtin_amdgcn_exp2f((float)(63 - st) * lg2gamma);
            u32x4 w0, w1, w2;
#pragma unroll
            for (int e = 0; e < 4; ++e) { w0[e] = pk2(q[2 * e], q[2 * e + 1]); w1[e] = pk2(q[2 * e] * gi, q[2 * e + 1] * gi); w2[e] = pk2(k[2 * e], k[2 * e + 1]); }
            *(u32x4*)(lds + OFF_QN + st * RS + sc8 * 16) = w0; *(u32x4*)(lds + OFF_QT + st * RS + sc8 * 16) = w1; *(u32x4*)(lds + OFF_KN + st * RS + sc8 * 16) = w2;
#pragma unroll
            for (int e = 0; e < 8; ++e) *(bf16*)(lds + OFF_KOT + (sc8 * 8 + e) * RS + st * 2) = (bf16)f2bf(k[e] * go);
#pragma unroll
            for (int e = 0; e < 4; ++e) { *(bf16*)(lds + OFF_VT + (sc8 * 8 + 2 * e) * RS + st * 2) = (bf16)(rv0[e] & 0xffffu); *(bf16*)(lds + OFF_VT + (sc8 * 8 + 2 * e + 1) * RS + st * 2) = (bf16)(rv0[e] >> 16);
                *(bf16*)(lds + OFF_VT + ((sc8 + 8) * 8 + 2 * e) * RS + st * 2) = (bf16)(rv1[e] & 0xffffu); *(bf16*)(lds + OFF_VT + ((sc8 + 8) * 8 + 2 * e + 1) * RS + st * 2) = (bf16)(rv1[e] >> 16); }
        } else {
            const float dtv = softplusf(rgate + dtb); float cumv = dtv * Aneg;
#pragma unroll
            for (int o = 1; o < 64; o <<= 1) { const float n = __shfl_up(cumv, o); if (lane >= o) cumv += n; }
            const float cum_t = cumv, dt_t = dtv, cum_last = __shfl(cumv, 63);
            if (wave == 0) { cumL[lane] = cumv; if (lane == 63) cumL[64] = cumv; }
            float val[3][8];
#pragma unroll
            for (int wh = 0; wh < 3; ++wh) { const float* tb = tab + (wh * 8 + sc8) * 40;
#pragma unroll
                for (int e = 0; e < 8; ++e) val[wh][e] = tb[32 + e];
#pragma unroll
                for (int w = 0; w < 4; ++w)
#pragma unroll
                    for (int e = 0; e < 4; ++e) { val[wh][2 * e] += tb[w * 8 + 2 * e] * bflo(rx[wh][w][e]); val[wh][2 * e + 1] += tb[w * 8 + 2 * e + 1] * bfhi(rx[wh][w][e]); }
#pragma unroll
                for (int e = 0; e < 8; ++e) val[wh][e] = siluf(val[wh][e]); }
            const float ei = __expf(cum_t), eo = dt_t * __expf(cum_last - cum_t);
            u32x4 w0, w1, w2;
#pragma unroll
            for (int e = 0; e < 4; ++e) { w0[e] = pk2(val[2][2 * e], val[2][2 * e + 1]); w1[e] = pk2(val[2][2 * e] * ei, val[2][2 * e + 1] * ei); w2[e] = pk2(val[1][2 * e] * dt_t, val[1][2 * e + 1] * dt_t); }
            *(u32x4*)(lds + OFF_QN + st * RS + sc8 * 16) = w0; *(u32x4*)(lds + OFF_QT + st * RS + sc8 * 16) = w1; *(u32x4*)(lds + OFF_KN + st * RS + sc8 * 16) = w2;
#pragma unroll
            for (int e = 0; e < 8; ++e) { *(bf16*)(lds + OFF_KOT + (sc8 * 8 + e) * RS + st * 2) = (bf16)f2bf(val[1][e] * eo); *(bf16*)(lds + OFF_VT + (sc8 * 8 + e) * RS + st * 2) = (bf16)f2bf(val[0][e]); }
        }
        LBAR();
        if (c + 1 < T_ / 64) ST_LOAD(c + 1);
        unsigned rg[8];
        u32x4 rgA, rgB;
        if (MODE == 0) { const bf16* gp = BIG + ((size_t)b * T_ + c * 64 + (tid >> 3)) * AB_N + 1024 + h * 128 + (tid & 7) * 16; rgA = *(const u32x4*)gp; rgB = *(const u32x4*)(gp + 8);
        } else {
#pragma unroll
            for (int k = 0; k < 4; ++k) { const int idx = tid + 512 * k; rg[k] = *(const unsigned*)(BIG + ((size_t)b * T_ + c * 64 + (idx >> 5)) * AB_N + 1536 + h * 64 + 2 * (idx & 31)); }
        }
        if (wave < 3) {
            const int jb = (wave == 2) ? 1 : 0, ib = (wave == 0) ? 0 : 1;
            f32x16 acc;
#pragma unroll
            for (int r = 0; r < 16; ++r) acc[r] = 0.f;
#pragma unroll
            for (int s = 0; s < 4; ++s) { const bf16x8_t af = *(const bf16x8_t*)(lds + OFF_KN + (32 * jb + l31) * RS + (16 * s + 8 * hi) * 2), bfr = *(const bf16x8_t*)(lds + OFF_QN + (32 * ib + l31) * RS + (16 * s + 8 * hi) * 2);
                acc = __builtin_amdgcn_mfma_f32_32x32x16_bf16(af, bfr, acc, 0, 0, 0); }
            const int i = 32 * ib + l31; const float cum_i = (MODE == 1) ? cumL[i] : 0.f;
#pragma unroll
            for (int g4 = 0; g4 < 4; ++g4) { const int j0 = 32 * jb + 8 * g4 + 4 * hi; float v[4];
                f32x4 cj = (f32x4){0.f, 0.f, 0.f, 0.f}; if (MODE == 1) cj = *(const f32x4*)(cumL + j0);
#pragma unroll
                for (int e = 0; e < 4; ++e) { const int jj = j0 + e; const float ex = (MODE == 0) ? (float)(i - jj) * lg2gamma : (cum_i - cj[e]) * LOG2E;
                    v[e] = (jj <= i) ? acc[4 * g4 + e] * __builtin_amdgcn_exp2f(ex) : 0.f; }
                u32x2 w; w.x = pk2(v[0], v[1]); w.y = pk2(v[2], v[3]);
                *(u32x2*)(lds + OFF_P + i * RS + j0 * 2) = w; }
        }
        LBAR();
        if (MODE == 0 || wave < 4) {
            const int ib = wave & 1, vb = (wave >> 1) & 3;
            f32x16 acc;
#pragma unroll
            for (int r = 0; r < 16; ++r) acc[r] = 0.f;
#pragma unroll
            for (int s = 0; s < 4; ++s) { const bf16x8_t af = *(const bf16x8_t*)(lds + OFF_P + (32 * ib + l31) * RS + (16 * s + 8 * hi) * 2), bfr = *(const bf16x8_t*)(lds + OFF_VT + (32 * vb + l31) * RS + (16 * s + 8 * hi) * 2);
                acc = __builtin_amdgcn_mfma_f32_32x32x16_bf16(af, bfr, acc, 0, 0, 0); }
#pragma unroll
            for (int s = 0; s < 4; ++s) { const bf16x8_t af = *(const bf16x8_t*)(lds + OFF_QT + (32 * ib + l31) * RS + (16 * s + 8 * hi) * 2), bfr = *(const bf16x8_t*)(lds + OFF_ST + (32 * vb + l31) * RS + (16 * s + 8 * hi) * 2);
                acc = __builtin_amdgcn_mfma_f32_32x32x16_bf16(af, bfr, acc, 0, 0, 0); }
            if (MODE == 1) {
#pragma unroll
                for (int g4 = 0; g4 < 4; ++g4) { const u32x2 xv = *(const u32x2*)(lds + OFF_VT + (32 * vb + l31) * RS + (32 * ib + 8 * g4 + 4 * hi) * 2);
                    acc[4 * g4] += Dh * bflo(xv.x); acc[4 * g4 + 1] += Dh * bfhi(xv.x); acc[4 * g4 + 2] += Dh * bflo(xv.y); acc[4 * g4 + 3] += Dh * bfhi(xv.y); }
            }
#pragma unroll
            for (int r = 0; r < 16; ++r) *(float*)(lds + OFF_OB + (32 * ib + crow16(r, hi)) * OBS + (32 * vb + l31) * 4) = acc[r];
        }
        const int sdb = wave & 1, svb = (MODE == 0) ? (wave >> 1) : ((wave >> 1) & 1);
        if (MODE == 0 || wave >= 4) {
            const float alast = (MODE == 0) ? exp2f(64.f * lg2gamma) : __expf(cumL[64]);
#pragma unroll
            for (int r = 0; r < 16; ++r) sacc[r] *= alast;
#pragma unroll
            for (int s = 0; s < 4; ++s) { const bf16x8_t af = *(const bf16x8_t*)(lds + OFF_KOT + (32 * sdb + l31) * RS + (16 * s + 8 * hi) * 2), bfr = *(const bf16x8_t*)(lds + OFF_VT + (32 * svb + l31) * RS + (16 * s + 8 * hi) * 2);
                sacc = __builtin_amdgcn_mfma_f32_32x32x16_bf16(af, bfr, sacc, 0, 0, 0); }
        }
        LBAR();
        if (MODE == 0 || wave >= 4) {
#pragma unroll
            for (int g4 = 0; g4 < 4; ++g4) { u32x2 w; w.x = pk2(sacc[4 * g4], sacc[4 * g4 + 1]); w.y = pk2(sacc[4 * g4 + 2], sacc[4 * g4 + 3]);
                *(u32x2*)(lds + OFF_ST + (32 * svb + l31) * RS + (32 * sdb + 8 * g4 + 4 * hi) * 2) = w; }
        }
        if (MODE == 0) {
            const int i = tid >> 3, part = tid & 7; const size_t row = (size_t)b * T_ + c * 64 + i;
            float o[16]; float sm = 0.f, sq = 0.f;
#pragma unroll
            for (int q4 = 0; q4 < 4; ++q4) { const f32x4 v = *(const f32x4*)(lds + OFF_OB + i * OBS + part * 64 + q4 * 16);
                o[4 * q4] = v.x; o[4 * q4 + 1] = v.y; o[4 * q4 + 2] = v.z; o[4 * q4 + 3] = v.w; sm += (v.x + v.y) + (v.z + v.w); sq += (v.x * v.x + v.y * v.y) + (v.z * v.z + v.w * v.w); }
            sm += __shfl_xor(sm, 1); sq += __shfl_xor(sq, 1); sm += __shfl_xor(sm, 2); sq += __shfl_xor(sq, 2); sm += __shfl_xor(sm, 4); sq += __shfl_xor(sq, 4);
            const float mean = sm * (1.f / 128.f); const float rs = rsqrtf(fmaxf(sq * (1.f / 128.f) - mean * mean, 0.f) + EPS_);
            u32x4 w0, w1;
#pragma unroll
            for (int e = 0; e < 4; ++e) { w0[e] = pk2((o[2 * e] - mean) * rs * gw[2 * e] * siluf(bflo(rgA[e])), (o[2 * e + 1] - mean) * rs * gw[2 * e + 1] * siluf(bfhi(rgA[e])));
                w1[e] = pk2((o[8 + 2 * e] - mean) * rs * gw[8 + 2 * e] * siluf(bflo(rgB[e])), (o[8 + 2 * e + 1] - mean) * rs * gw[8 + 2 * e + 1] * siluf(bfhi(rgB[e]))); }
            *(u32x4*)(Y + row * D_ + h * 128 + part * 16) = w0; *(u32x4*)(Y + row * D_ + h * 128 + part * 16 + 8) = w1;
        } else {
#pragma unroll
            for (int k = 0; k < 4; ++k) { const int idx = tid + 512 * k, i = idx >> 5, p = 2 * (idx & 31); const size_t row = (size_t)b * T_ + c * 64 + i;
                const f32x2_t y = *(const f32x2_t*)(lds + OFF_OB + i * OBS + p * 4);
                f32x2_t o; o.x = y.x * siluf(bflo(rg[k])); o.y = y.y * siluf(bfhi(rg[k]));
                *(f32x2_t*)(TMP + row * 512 + h * 64 + p) = o; }
        }
    }
#undef ST_LOAD
    __syncthreads();
}

__device__ __forceinline__ void hg_stream(ArgsP a, int j, int bh, unsigned char* lds) {
    constexpr int RS = 144, RW = 272;
    constexpr int OFF_QX = 0, OFF_KV = 17408, OFF_OB = 0  , OFF_QT = 43520, OFF_KOT = 60928, OFF_VT = 79360, OFF_P = 97792, OFF_ST = 107008, OFF_AL = 141824;
    constexpr int OBS = 528;
    const int tid = tid_fresh(), lane = tid & 63, wave = tid >> 6, l31 = lane & 31, hi = lane >> 5;
    const int b = bh >> 2, h = bh & 3;
    const bf16* BIG = (const bf16*)(a->ws + WS_BIG); bf16* Y = (bf16*)(a->ws + WS_UY);
    const float* nw = a->in[18] + j * 128;
    const int c8 = wave * 2 + hi, tseg = l31;
    float lbv[8];
#pragma unroll
    for (int e = 0; e < 8; ++e) { lbv[e] = 0.f; if (j == 1) { const float l0 = a->in[17][h * 128 + c8 * 8 + e], l1 = a->in[17][512 + h * 128 + c8 * 8 + e]; lbv[e] = 1.f / (1.f + expf(l0 - l1)); } }
    float* alL = (float*)(lds + OFF_AL);
    float gw[16];
#pragma unroll
    for (int e = 0; e < 16; ++e) gw[e] = nw[(tid & 7) * 16 + e];
    __syncthreads();
    for (int i = tid; i < (9216 + 34816) / 4; i += 512) ((unsigned*)(lds + OFF_P))[i] = 0u;
    f32x16 sacc[2];
#pragma unroll
    for (int t = 0; t < 2; ++t)
#pragma unroll
        for (int r = 0; r < 16; ++r) sacc[t][r] = 0.f;
    u32x4 rz[2], rq[2], rv[2];
#define HG_LOAD(c) do { _Pragma("unroll") for (int rr = 0; rr < 2; ++rr) { const size_t row = (size_t)b * T_ + (c) * 64 + 2 * tseg + rr; const bf16* p = BIG + row * CD_N + h * 128 + c8 * 8; \
        rq[rr] = *(const u32x4*)p; rz[rr] = *(const u32x4*)(p + 512); rv[rr] = *(const u32x4*)(p + 1024); } } while (0)
    HG_LOAD(0);
    __syncthreads();
    for (int c = 0; c < T_ / 64; ++c) {
        {
            float lf[2][8], kk[2][8], qv[2][8], cum[2][8];
#pragma unroll
            for (int rr = 0; rr < 2; ++rr)
#pragma unroll
                for (int e = 0; e < 4; ++e) {
                    const float z0 = fmaxf(bflo(rz[rr][e]), -60.f), z1 = fmaxf(bfhi(rz[rr][e]), -60.f);
                    const float e0 = __builtin_amdgcn_exp2f(-1.4426950408889634f * z0), e1 = __builtin_amdgcn_exp2f(-1.4426950408889634f * z1);
                    const float s0 = __builtin_amdgcn_rcpf(1.f + e0), s1 = __builtin_amdgcn_rcpf(1.f + e1);
                    const float f0 = lbv[2 * e] + (1.f - lbv[2 * e]) * s0, f1 = lbv[2 * e + 1] + (1.f - lbv[2 * e + 1]) * s1;
                    lf[rr][2 * e] = __logf(f0); lf[rr][2 * e + 1] = __logf(f1);
                    kk[rr][2 * e] = (1.f - lbv[2 * e]) * (e0 * s0); kk[rr][2 * e + 1] = (1.f - lbv[2 * e + 1]) * (e1 * s1);
                    qv[rr][2 * e] = bflo(rq[rr][e]); qv[rr][2 * e + 1] = bfhi(rq[rr][e]); }
            float ref1[8], clast[8];
#pragma unroll
            for (int e = 0; e < 8; ++e) {
                float s = lf[0][e] + lf[1][e];
#pragma unroll
                for (int o = 1; o < 32; o <<= 1) { const float n = __shfl_up(s, o, 32); if (tseg >= o) s += n; }
                cum[1][e] = s; cum[0][e] = s - lf[1][e];
                ref1[e] = __shfl(s, 15, 32); clast[e] = __shfl(s, 31, 32); }
            const bool blk1 = tseg >= 16;
            u32x4 wqx[2], wqt[2], wk0[2], wk1[2];
            float ko[2][8];
#pragma unroll
            for (int rr = 0; rr < 2; ++rr) {
                float qx[8], qt[8], k0[8], k1[8];
#pragma unroll
                for (int e = 0; e < 8; ++e) { const float cm = cum[rr][e]; const float rf = blk1 ? ref1[e] : 0.f;
                    qx[e] = qv[rr][e] * __expf(cm - rf); qt[e] = qv[rr][e] * __expf(cm);
                    k0[e] = kk[rr][e] * __expf(rf - cm);
                    k1[e] = kk[rr][e] * __expf(ref1[e] - cm);
                    ko[rr][e] = kk[rr][e] * __expf(clast[e] - cm); }
#pragma unroll
                for (int e = 0; e < 4; ++e) { wqx[rr][e] = pk2(qx[2 * e], qx[2 * e + 1]); wqt[rr][e] = pk2(qt[2 * e], qt[2 * e + 1]); wk0[rr][e] = pk2(k0[2 * e], k0[2 * e + 1]); wk1[rr][e] = pk2(k1[2 * e], k1[2 * e + 1]); }
            }
#pragma unroll
            for (int rr = 0; rr < 2; ++rr) { const int t = 2 * tseg + rr;
                *(u32x4*)(lds + OFF_QX + t * RW + c8 * 16) = wqx[rr]; *(u32x4*)(lds + OFF_QT + t * RW + c8 * 16) = wqt[rr];
                if (!blk1) { *(u32x4*)(lds + OFF_KV + t * RW + c8 * 16) = wk0[rr]; *(u32x4*)(lds + OFF_KV + 8704 + t * RW + c8 * 16) = wk1[rr]; }
                else       { *(u32x4*)(lds + OFF_KV + 2 * 8704 + (t - 32) * RW + c8 * 16) = wk0[rr]; } }
#pragma unroll
            for (int e = 0; e < 8; ++e) { *(unsigned*)(lds + OFF_KOT + (c8 * 8 + e) * RS + tseg * 4) = pk2(ko[0][e], ko[1][e]); }
#pragma unroll
            for (int e = 0; e < 4; ++e) { *(unsigned*)(lds + OFF_VT + (c8 * 8 + 2 * e) * RS + tseg * 4) = (rv[0][e] & 0xffffu) | (rv[1][e] << 16);
                *(unsigned*)(lds + OFF_VT + (c8 * 8 + 2 * e + 1) * RS + tseg * 4) = (rv[0][e] >> 16) | (rv[1][e] & 0xffff0000u); }
            if (tseg == 31) {
#pragma unroll
                for (int e = 0; e < 8; ++e) alL[c8 * 8 + e] = __expf(clast[e]); }
        }
        LBAR();
        if (c + 1 < T_ / 64) HG_LOAD(c + 1);
        u32x4 rgA, rgB;
        { const bf16* gp = BIG + ((size_t)b * T_ + c * 64 + (tid >> 3)) * CD_N + 1536 + h * 128 + (tid & 7) * 16; rgA = *(const u32x4*)gp; rgB = *(const u32x4*)(gp + 8); }
        if (wave < 3) {
            const int ib = (wave == 0) ? 0 : 1, jb = (wave == 2) ? 1 : 0;
            f32x16 acc;
#pragma unroll
            for (int r = 0; r < 16; ++r) acc[r] = 0.f;
#pragma unroll
            for (int s = 0; s < 8; ++s) { const bf16x8_t af = *(const bf16x8_t*)(lds + OFF_KV + wave * 8704 + l31 * RW + (16 * s + 8 * hi) * 2), bfr = *(const bf16x8_t*)(lds + OFF_QX + (32 * ib + l31) * RW + (16 * s + 8 * hi) * 2);
                acc = __builtin_amdgcn_mfma_f32_32x32x16_bf16(af, bfr, acc, 0, 0, 0); }
            const int i = 32 * ib + l31;
#pragma unroll
            for (int g4 = 0; g4 < 4; ++g4) { const int j0 = 32 * jb + 8 * g4 + 4 * hi; float v[4];
#pragma unroll
                for (int e = 0; e < 4; ++e) v[e] = (j0 + e <= i) ? acc[4 * g4 + e] : 0.f;
                u32x2 w; w.x = pk2(v[0], v[1]); w.y = pk2(v[2], v[3]);
                *(u32x2*)(lds + OFF_P + i * RS + j0 * 2) = w; }
        }
        LBAR();
        {
            const int ib = wave & 1, vb = wave >> 1;
            f32x16 acc;
#pragma unroll
            for (int r = 0; r < 16; ++r) acc[r] = 0.f;
#pragma unroll
            for (int s = 0; s < 4; ++s) { const bf16x8_t af = *(const bf16x8_t*)(lds + OFF_P + (32 * ib + l31) * RS + (16 * s + 8 * hi) * 2), bfr = *(const bf16x8_t*)(lds + OFF_VT + (32 * vb + l31) * RS + (16 * s + 8 * hi) * 2);
                acc = __builtin_amdgcn_mfma_f32_32x32x16_bf16(af, bfr, acc, 0, 0, 0); }
#pragma unroll
            for (int s = 0; s < 8; ++s) { const bf16x8_t af = *(const bf16x8_t*)(lds + OFF_QT + (32 * ib + l31) * RW + (16 * s + 8 * hi) * 2), bfr = *(const bf16x8_t*)(lds + OFF_ST + (32 * vb + l31) * RW + (16 * s + 8 * hi) * 2);
                acc = __builtin_amdgcn_mfma_f32_32x32x16_bf16(af, bfr, acc, 0, 0, 0); }
#pragma unroll
            for (int r = 0; r < 16; ++r) *(float*)(lds + OFF_OB + (32 * ib + crow16(r, hi)) * OBS + (32 * vb + l31) * 4) = acc[r];
        }
        const int svb = wave >> 1;
#pragma unroll
        for (int t = 0; t < 2; ++t) { const int db = 2 * (wave & 1) + t;
#pragma unroll
            for (int g4 = 0; g4 < 4; ++g4) { const f32x4 al = *(const f32x4*)(alL + 32 * db + 8 * g4 + 4 * hi);
#pragma unroll
                for (int e = 0; e < 4; ++e) sacc[t][4 * g4 + e] *= al[e]; }
#pragma unroll
            for (int s = 0; s < 4; ++s) { const bf16x8_t af = *(const bf16x8_t*)(lds + OFF_KOT + (32 * db + l31) * RS + (16 * s + 8 * hi) * 2), bfr = *(const bf16x8_t*)(lds + OFF_VT + (32 * svb + l31) * RS + (16 * s + 8 * hi) * 2);
                sacc[t] = __builtin_amdgcn_mfma_f32_32x32x16_bf16(af, bfr, sacc[t], 0, 0, 0); } }
        LBAR();
#pragma unroll
        for (int t = 0; t < 2; ++t) { const int db = 2 * (wave & 1) + t;
#pragma unroll
            for (int g4 = 0; g4 < 4; ++g4) { u32x2 w; w.x = pk2(sacc[t][4 * g4], sacc[t][4 * g4 + 1]); w.y = pk2(sacc[t][4 * g4 + 2], sacc[t][4 * g4 + 3]);
                *(u32x2*)(lds + OFF_ST + (32 * svb + l31) * RW + (32 * db + 8 * g4 + 4 * hi) * 2) = w; } }
        { const int i = tid >> 3, part = tid & 7; const size_t row = (size_t)b * T_ + c * 64 + i;
            float o[16]; float sq = 0.f;
#pragma unroll
            for (int q4 = 0; q4 < 4; ++q4) { const f32x4 v = *(const f32x4*)(lds + OFF_OB + i * OBS + part * 64 + q4 * 16);
                o[4 * q4] = v.x; o[4 * q4 + 1] = v.y; o[4 * q4 + 2] = v.z; o[4 * q4 + 3] = v.w; sq += (v.x * v.x + v.y * v.y) + (v.z * v.z + v.w * v.w); }
            sq += __shfl_xor(sq, 1); sq += __shfl_xor(sq, 2); sq += __shfl_xor(sq, 4);
            const float rs = rsqrtf(sq * (1.f / 128.f) + EPS_);
            u32x4 w0, w1;
#pragma unroll
            for (int e = 0; e < 4; ++e) { w0[e] = pk2(o[2 * e] * rs * gw[2 * e] * siluf(bflo(rgA[e])), o[2 * e + 1] * rs * gw[2 * e + 1] * siluf(bfhi(rgA[e])));
                w1[e] = pk2(o[8 + 2 * e] * rs * gw[8 + 2 * e] * siluf(bflo(rgB[e])), o[8 + 2 * e + 1] * rs * gw[8 + 2 * e + 1] * siluf(bfhi(rgB[e]))); }
            *(u32x4*)(Y + row * D_ + h * 128 + part * 16) = w0; *(u32x4*)(Y + row * D_ + h * 128 + part * 16 + 8) = w1; }
        LBAR();
    }
#undef HG_LOAD
}

__device__ __forceinline__ void fox_unit2(ArgsP a, int bh, int qb, unsigned char* lds) {
    const int tid = tid_fresh(), lane = tid & 63, wave = tid >> 6, l31 = lane & 31, hi = lane >> 5;
    const int b = bh >> 2, h = bh & 3;
    const bf16* BIG = (const bf16*)(a->ws + WS_BIG); bf16* Y = (bf16*)(a->ws + WS_UY);
    const bf16* VT = (const bf16*)(a->ws + WS_VT) + (size_t)bh * 128 * T_;
    const float* CUMF = (const float*)(a->ws + WS_CUMF) + (size_t)bh * T_;
    const int tq = qb * 256 + wave * 32 + l31; const size_t rowq = (size_t)b * T_ + tq;
    const float Fref = CUMF[qb * 256];
    bf16x8_t qf[8];
#pragma unroll
    for (int ks = 0; ks < 8; ++ks) qf[ks] = *(const bf16x8_t*)(BIG + BIGX(rowq, 2048 + h * 128 + 16 * ks + 8 * hi));
    f32x16 oT[4];
#pragma unroll
    for (int d = 0; d < 4; ++d)
#pragma unroll
        for (int r = 0; r < 16; ++r) oT[d][r] = 0.f;
    float m = -INFINITY, lsum = 0.f, alpha = 1.f;
    const int nt = 4 * qb + 4;
    const bf16* Kg = BIG + BIGX((size_t)b * T_, 2560 + h * 128);
    const int kr0 = tid >> 4, kc = tid & 15, vd0 = tid >> 3, vc = tid & 7;
    u32x4 kreg[2], vreg[2]; float breg;
#define FY_LOAD(kt) do { kreg[0] = *(const u32x4*)(Kg + (size_t)((kt) * 64 + kr0) * 256 + kc * 8); kreg[1] = *(const u32x4*)(Kg + (size_t)((kt) * 64 + kr0 + 32) * 256 + kc * 8); \
        vreg[0] = *(const u32x4*)(VT + (size_t)vd0 * T_ + (kt) * 64 + vc * 8); vreg[1] = *(const u32x4*)(VT + (size_t)(vd0 + 64) * T_ + (kt) * 64 + vc * 8); \
        breg = (Fref - CUMF[(kt) * 64 + lane]) * 1.4426950408889634f; } while (0)
#define FY_STORE(bb) do { *(u32x4*)((bb) + kr0 * FX_KROW + kc * 16) = kreg[0]; *(u32x4*)((bb) + (kr0 + 32) * FX_KROW + kc * 16) = kreg[1]; \
        *(u32x4*)((bb) + FX_KBYTES + vd0 * FX_VROW + vc * 16) = vreg[0]; *(u32x4*)((bb) + FX_KBYTES + (vd0 + 64) * FX_VROW + vc * 16) = vreg[1]; \
        ((float*)((bb) + FX_KBYTES + FX_VBYTES))[lane] = breg; } while (0)
#define FY_QK(S, bb) do { _Pragma("unroll") for (int hf = 0; hf < 2; ++hf) { _Pragma("unroll") for (int r = 0; r < 16; ++r) S[hf][r] = 0.f; \
        _Pragma("unroll") for (int ks = 0; ks < 8; ++ks) { const bf16x8_t kf = *(const bf16x8_t*)((bb) + (32 * hf + l31) * FX_KROW + (16 * ks + 8 * hi) * 2); \
            S[hf] = __builtin_amdgcn_mfma_f32_32x32x16_bf16(kf, qf[ks], S[hf], 0, 0, 0); } } } while (0)
#define FY_BMAX(S, bb, kt, MASK) do { const float* Bs = (const float*)((bb) + FX_KBYTES + FX_VBYTES); float mx = -INFINITY; \
        _Pragma("unroll") for (int hf = 0; hf < 2; ++hf) _Pragma("unroll") for (int g = 0; g < 4; ++g) { const f32x4 bv = *(const f32x4*)(Bs + 32 * hf + 8 * g + 4 * hi); \
            _Pragma("unroll") for (int e = 0; e < 4; ++e) { const int r = 4 * g + e; float s = S[hf][r] + bv[e]; \
                if (MASK) { const int kv = (kt) * 64 + 32 * hf + 8 * g + 4 * hi + e; if (kv > tq) s = -INFINITY; } \
                S[hf][r] = s; mx = fmaxf(mx, s); } } \
        mx = fmaxf(mx, __shfl_xor(mx, 32)); const float mn = fmaxf(m, mx); alpha = __builtin_amdgcn_exp2f(m - mn); m = mn; } while (0)
#define FY_EXP(S) do { float ps = 0.f; \
        _Pragma("unroll") for (int hf = 0; hf < 2; ++hf) _Pragma("unroll") for (int r = 0; r < 16; ++r) { const float e = __builtin_amdgcn_exp2f(S[hf][r] - m); S[hf][r] = e; ps += e; } \
        lsum = lsum * alpha + ps; \
        _Pragma("unroll") for (int d = 0; d < 4; ++d) _Pragma("unroll") for (int r = 0; r < 16; ++r) oT[d][r] *= alpha; \
        _Pragma("unroll") for (int ks2 = 0; ks2 < 4; ++ks2) { const int hf = ks2 >> 1, c = ks2 & 1; u32x4 w; \
            _Pragma("unroll") for (int e = 0; e < 4; ++e) w[e] = pk2(S[hf][8 * c + 2 * e], S[hf][8 * c + 2 * e + 1]); \
            pb[ks2] = __builtin_bit_cast(bf16x8_t, w); } } while (0)
#define FY_PV(bb) do { const unsigned char* vb = (bb) + FX_KBYTES; \
        _Pragma("unroll") for (int d = 0; d < 4; ++d) _Pragma("unroll") for (int ks2 = 0; ks2 < 4; ++ks2) { const unsigned char* vp = vb + (32 * d + l31) * FX_VROW + (16 * ks2 + 8 * hi) * 2; \
            const bf16x8_t vf = *(const bf16x8_t*)vp; \
            oT[d] = __builtin_amdgcn_mfma_f32_32x32x16_bf16(vf, pb[ks2], oT[d], 0, 0, 0); } } while (0)
    __syncthreads();
    FY_LOAD(0); FY_STORE(lds);
    FY_LOAD(1); FY_STORE(lds + FX_BUF);
    __syncthreads();
    f32x16 sc[2], sn[2]; bf16x8_t pb[4];
    FY_QK(sc, lds);
    FY_BMAX(sc, lds, 0, true);
    int bc = 0, bn = FX_BUF, bs = 2 * FX_BUF;
#define FY_ITER(MASK) do { const int tl = (t + 2 < nt) ? t + 2 : nt - 1; FY_LOAD(tl); \
        const bool do_next = !(MASK) || (64 * (t + 1) <= tqw_max), do_cur = !(MASK) || (64 * t <= tqw_max);     \
        if (do_next) FY_QK(sn, lds + bn); if (do_cur) FY_EXP(sc); \
        if (do_cur) FY_PV(lds + bc); if (do_next) FY_BMAX(sn, lds + bn, t + 1, MASK); \
        sc[0] = sn[0]; sc[1] = sn[1]; \
        FY_STORE(lds + bs); \
        const int tmp_ = bc; bc = bn; bn = bs; bs = tmp_; \
        __syncthreads(); } while (0)
    const int tqw_max = qb * 256 + wave * 32 + 31;
    int t = 0;
    for (; t + 1 < 4 * qb; ++t) FY_ITER(false);
    for (; t + 1 < nt; ++t) FY_ITER(true);
    if (64 * (nt - 1) <= tqw_max) { FY_EXP(sc); FY_PV(lds + bc); }
#undef FY_ITER
#undef FY_LOAD
#undef FY_STORE
#undef FY_QK
#undef FY_BMAX
#undef FY_EXP
#undef FY_PV
    lsum += __shfl_xor(lsum, 32);
    const float il = 1.f / lsum;
    bf16* yp = Y + rowq * D_ + 512 + h * 128;
#pragma unroll
    for (int d = 0; d < 4; ++d)
#pragma unroll
        for (int g = 0; g < 4; ++g) { u32x2 w; w.x = pk2(oT[d][4 * g] * il, oT[d][4 * g + 1] * il); w.y = pk2(oT[d][4 * g + 2] * il, oT[d][4 * g + 3] * il);
            *(u32x2*)(yp + 32 * d + 8 * g + 4 * hi) = w; }
}

constexpr size_t ST_TMP = 0, ST_DSRET = 32 * MiB, ST_DSSSD = 64 * MiB, ST_ALSSD = 96 * MiB;
constexpr size_t ST_DSHG = 32 * MiB, ST_ALHG = 96 * MiB;

template <int MODE  , int PASS  >
__device__ __forceinline__ void scalar_pass(ArgsP a, int j, int bh, int c0, int c1, unsigned char* lds) {
    constexpr int DV = MODE == 0 ? 128 : 64;
    constexpr int RS = 144;
    constexpr int OFF_QN = 0, OFF_QT = 9216, OFF_KN = 18432, OFF_KOT = 27648, OFF_VT = 36864, OFF_P = OFF_VT + DV * RS, OFF_ST = OFF_P + 9216, OFF_OB = OFF_ST + DV * RS;
    constexpr int OBS = DV * 4 + 16;
    constexpr int OFF_CUM = OFF_OB + 64 * OBS, OFF_TAB = OFF_CUM + 512;
    const int tid = tid_fresh(), lane = tid & 63, wave = tid >> 6, l31 = lane & 31, hi = lane >> 5;
    const int b = MODE == 0 ? (bh >> 2) : (bh >> 3), h = MODE == 0 ? (bh & 3) : (bh & 7), g = h >> 2;
    const bf16* BIG = (const bf16*)(a->ws + WS_BIG);
    const float* rope = (const float*)(a->ws + WS_ROPE); const float* GATE = (const float*)(a->ws + WS_GATE);
    bf16* Y = (bf16*)(a->ws + WS_UY); bf16* TMP = (bf16*)(a->ws + WS_ST + ST_TMP);
    bf16* DS = (bf16*)(a->ws + WS_ST + (MODE == 0 ? ST_DSRET : ST_DSSSD)) + (size_t)bh * 64 * (DV * 64);
    float* ALS = (float*)(a->ws + WS_ST + ST_ALSSD) + bh * 64;
    const float LOG2E = 1.4426950408889634f;
    const float gamma = 1.f - exp2f(-5.f - (float)h), lg2gamma = log2f(gamma);
    float dtb = 0.f, Aneg = 0.f, Dh = 0.f;
    if (MODE == 1) { dtb = a->in[11][j * 8 + h]; Aneg = -expf(a->in[12][j * 8 + h]); Dh = a->in[13][j * 8 + h]; }
    const float* gnw = a->in[8] + (j * 4 + h) * 128;
    float* cumL = (float*)(lds + OFF_CUM); float* tab = (float*)(lds + OFF_TAB);
    float gw[16];
#pragma unroll
    for (int e = 0; e < 16; ++e) gw[e] = (MODE == 0 && PASS == 1) ? gnw[(tid & 7) * 16 + e] : 0.f;
    const int st = tid >> 3, sc8 = lane & 7;
    const int tsw = (st ^ (sc8 << 3)) * 2;
    __syncthreads();
    if (PASS == 1) { for (int i = tid; i < 9216 / 4; i += 512) ((unsigned*)(lds + OFF_P))[i] = 0u; }
    if (MODE == 1) {
        const float* cw = a->in[9] + j * 4 * 768; const float* cb = a->in[10] + j * 768;
        for (int i = tid; i < 3 * 8 * 5 * 8; i += 512) { const int e = i & 7, w = (i >> 3) % 5, c8 = (i / 40) & 7, which = i / 320;
            const int col = (which == 0 ? h * 64 : (which == 1 ? 512 + g * 64 : 640 + g * 64)) + c8 * 8 + e;
            tab[i] = (w < 4) ? cw[w * 768 + col] : cb[col]; }
    }
    u32x4 rq, rk, rv0, rv1, rs0, rs1; f32x4 rcs, rsn; u32x4 rx[3][4]; float rgate = 0.f;
    constexpr int WH0 = (PASS == 0) ? 0 : 0, WH1 = (PASS == 0) ? 2 : 3;
#define SP_LOAD(c) do { const size_t row = (size_t)b * T_ + (c) * 64 + st; \
        if (MODE == 0) { if (PASS == 1) rq = *(const u32x4*)(BIG + BIGX(row, h * 64 + sc8 * 8)); rk = *(const u32x4*)(BIG + BIGX(row, 256 + h * 64 + sc8 * 8)); \
            rcs = *(const f32x4*)(rope + ((c) * 64 + st) * 32 + sc8 * 4); rsn = *(const f32x4*)(rope + T_ * 32 + ((c) * 64 + st) * 32 + sc8 * 4); \
            rv0 = *(const u32x4*)(BIG + BIGX(row, 512 + h * 128 + sc8 * 8)); rv1 = *(const u32x4*)(BIG + BIGX(row, 512 + h * 128 + (sc8 + 8) * 8)); } \
        else { _Pragma("unroll") for (int wh = WH0; wh < WH1; ++wh) { const int col = (wh == 0 ? h * 64 : (wh == 1 ? 512 + g * 64 : 640 + g * 64)) + sc8 * 8; \
                _Pragma("unroll") for (int w = 0; w < 4; ++w) { const int tt = (c) * 64 + st - 3 + w; \
                    rx[wh][w] = (tt >= 0) ? *(const u32x4*)(BIG + BIGX((size_t)b * T_ + tt, 2048 + col)) : (u32x4){0u, 0u, 0u, 0u}; } } \
            rgate = GATE[((size_t)b * T_ + (c) * 64 + lane) * 8 + h]; } \
        if (PASS == 1) { const bf16* sp = DS + (size_t)(c) * (DV * 64); rs0 = *(const u32x4*)(sp + tid * 8); if (MODE == 0) rs1 = *(const u32x4*)(sp + (tid + 512) * 8); } } while (0)
    SP_LOAD(c0);
    __syncthreads();
    for (int c = c0; c < c1; ++c) {
        for (int rs_ = 0; rs_ < RU_STAGE; ++rs_) {
        if (MODE == 0) {
            float q[8], k[8];
#pragma unroll
            for (int e = 0; e < 4; ++e) { const float k1 = bflo(rk[e]) * 0.125f, k2 = bfhi(rk[e]) * 0.125f; const float cs = rcs[e], sn = rsn[e];
                k[2 * e] = k1 * cs - k2 * sn; k[2 * e + 1] = k1 * sn + k2 * cs;
                if (PASS == 1) { const float q1 = bflo(rq[e]), q2 = bfhi(rq[e]); q[2 * e] = q1 * cs - q2 * sn; q[2 * e + 1] = q1 * sn + q2 * cs; } }
            if (PASS == 1) {
                const float gi = __builtin_amdgcn_exp2f((float)(st + 1) * lg2gamma);
                u32x4 w0, w1, w2;
#pragma unroll
                for (int e = 0; e < 4; ++e) { w0[e] = pk2(q[2 * e], q[2 * e + 1]); w1[e] = pk2(q[2 * e] * gi, q[2 * e + 1] * gi); w2[e] = pk2(k[2 * e], k[2 * e + 1]); }
                *(u32x4*)(lds + OFF_QN + st * RS + sc8 * 16) = w0; *(u32x4*)(lds + OFF_QT + st * RS + sc8 * 16) = w1; *(u32x4*)(lds + OFF_KN + st * RS + sc8 * 16) = w2;
            } else {
                const float go = __builtin_amdgcn_exp2f((float)(63 - st) * lg2gamma);
#pragma unroll
                for (int e = 0; e < 8; ++e) *(bf16*)(lds + OFF_KOT + (sc8 * 8 + e) * RS + tsw) = (bf16)f2bf(k[e] * go);
            }
#pragma unroll
            for (int e = 0; e < 4; ++e) { *(bf16*)(lds + OFF_VT + (sc8 * 8 + 2 * e) * RS + tsw) = (bf16)(rv0[e] & 0xffffu); *(bf16*)(lds + OFF_VT + (sc8 * 8 + 2 * e + 1) * RS + tsw) = (bf16)(rv0[e] >> 16);
                *(bf16*)(lds + OFF_VT + ((sc8 + 8) * 8 + 2 * e) * RS + tsw) = (bf16)(rv1[e] & 0xffffu); *(bf16*)(lds + OFF_VT + ((sc8 + 8) * 8 + 2 * e + 1) * RS + tsw) = (bf16)(rv1[e] >> 16); }
        } else {
            const float dtv = softplusf(rgate + dtb); float cumv = dtv * Aneg;
#pragma unroll
            for (int o = 1; o < 64; o <<= 1) { const float n = __shfl_up(cumv, o); if (lane >= o) cumv += n; }
            const float cum_t = __shfl(cumv, st), dt_t = __shfl(dtv, st), cum_last = __shfl(cumv, 63);
            if (wave == 0) { cumL[lane] = cumv; if (lane == 63) { cumL[64] = cumv; if (PASS == 0) ALS[c] = __expf(cumv); } }
            float val[3][8];
#pragma unroll
            for (int wh = WH0; wh < WH1; ++wh) { const float* tb = tab + (wh * 8 + sc8) * 40;
#pragma unroll
                for (int e = 0; e < 8; ++e) val[wh][e] = tb[32 + e];
#pragma unroll
                for (int w = 0; w < 4; ++w)
#pragma unroll
                    for (int e = 0; e < 4; ++e) { val[wh][2 * e] += tb[w * 8 + 2 * e] * bflo(rx[wh][w][e]); val[wh][2 * e + 1] += tb[w * 8 + 2 * e + 1] * bfhi(rx[wh][w][e]); }
#pragma unroll
                for (int e = 0; e < 8; ++e) val[wh][e] = siluf(val[wh][e]); }
            if (PASS == 1) {
                const float ei = __expf(cum_t);
                u32x4 w0, w1, w2;
#pragma unroll
                for (int e = 0; e < 4; ++e) { w0[e] = pk2(val[2][2 * e], val[2][2 * e + 1]); w1[e] = pk2(val[2][2 * e] * ei, val[2][2 * e + 1] * ei); w2[e] = pk2(val[1][2 * e] * dt_t, val[1][2 * e + 1] * dt_t); }
                *(u32x4*)(lds + OFF_QN + st * RS + sc8 * 16) = w0; *(u32x4*)(lds + OFF_QT + st * RS + sc8 * 16) = w1; *(u32x4*)(lds + OFF_KN + st * RS + sc8 * 16) = w2;
            } else {
                const float eo = dt_t * __expf(cum_last - cum_t);
#pragma unroll
                for (int e = 0; e < 8; ++e) *(bf16*)(lds + OFF_KOT + (sc8 * 8 + e) * RS + tsw) = (bf16)f2bf(val[1][e] * eo);
            }
#pragma unroll
            for (int e = 0; e < 8; ++e) *(bf16*)(lds + OFF_VT + (sc8 * 8 + e) * RS + tsw) = (bf16)f2bf(val[0][e]);
        }
        if (PASS == 1) {
            *(u32x4*)(lds + OFF_ST + (tid >> 3) * RS + (tid & 7) * 16) = rs0;
            if (MODE == 0) *(u32x4*)(lds + OFF_ST + ((tid >> 3) + 64) * RS + (tid & 7) * 16) = rs1;
        }
        LBAR();
        }
        if (c + 1 < c1) SP_LOAD(c + 1);
        if (PASS == 0) {
            if (MODE == 0 || wave < 4) {
                const int sdb = wave & 1, svb = (MODE == 0) ? (wave >> 1) : ((wave >> 1) & 1);
                f32x16 sacc;
#pragma unroll
                for (int r = 0; r < 16; ++r) sacc[r] = 0.f;
#pragma unroll
                for (int s = 0; s < 4; ++s) { const bf16x8_t af = *(const bf16x8_t*)(lds + OFF_KOT + (32 * sdb + l31) * RS + (((2 * s + hi) ^ ((l31 >> 3) & 7) ^ ((4 * sdb) & 7)) * 16)), bfr = *(const bf16x8_t*)(lds + OFF_VT + (32 * svb + l31) * RS + (((2 * s + hi) ^ ((l31 >> 3) & 7) ^ ((4 * svb) & 7)) * 16));
                    sacc = __builtin_amdgcn_mfma_f32_32x32x16_bf16(af, bfr, sacc, 0, 0, 0); }
                bf16* dp = DS + (size_t)c * (DV * 64) + (32 * svb + l31) * 64 + 32 * sdb + 4 * hi;
#pragma unroll
                for (int g4 = 0; g4 < 4; ++g4) { u32x2 w; w.x = pk2(sacc[4 * g4], sacc[4 * g4 + 1]); w.y = pk2(sacc[4 * g4 + 2], sacc[4 * g4 + 3]); *(u32x2*)(dp + 8 * g4) = w; }
            }
            LBAR();
        } else {
            unsigned rg[4]; u32x4 rgA, rgB;
            if (MODE == 0) { const bf16* gp = BIG + BIGX((size_t)b * T_ + c * 64 + (tid >> 3), 1024 + h * 128 + (tid & 7) * 16); rgA = *(const u32x4*)gp; rgB = *(const u32x4*)(gp + 8);
            } else {
#pragma unroll
                for (int k = 0; k < 4; ++k) { const int idx = tid + 512 * k; rg[k] = *(const unsigned*)(BIG + BIGX((size_t)b * T_ + c * 64 + (idx >> 5), 1536 + h * 64 + 2 * (idx & 31))); }
            }
            for (int rg_ = 0; rg_ < RU_G; ++rg_) {
            if (wave < 3) {
                const int jb = (wave == 2) ? 1 : 0, ib = (wave == 0) ? 0 : 1;
                f32x16 acc;
#pragma unroll
                for (int r = 0; r < 16; ++r) acc[r] = 0.f;
#pragma unroll
                for (int s = 0; s < 4; ++s) { const bf16x8_t af = *(const bf16x8_t*)(lds + OFF_KN + (32 * jb + l31) * RS + (16 * s + 8 * hi) * 2), bfr = *(const bf16x8_t*)(lds + OFF_QN + (32 * ib + l31) * RS + (16 * s + 8 * hi) * 2);
                    acc = __builtin_amdgcn_mfma_f32_32x32x16_bf16(af, bfr, acc, 0, 0, 0); }
                const int i = 32 * ib + l31; const float cum_i = (MODE == 1) ? cumL[i] : 0.f;
#pragma unroll
                for (int g4 = 0; g4 < 4; ++g4) { const int j0 = 32 * jb + 8 * g4 + 4 * hi; float v[4];
                    f32x4 cj = (f32x4){0.f, 0.f, 0.f, 0.f}; if (MODE == 1) cj = *(const f32x4*)(cumL + j0);
#pragma unroll
                    for (int e = 0; e < 4; ++e) { const int jj = j0 + e; const float ex = (MODE == 0) ? (float)(i - jj) * lg2gamma : (cum_i - cj[e]) * LOG2E;
                        v[e] = (jj <= i) ? acc[4 * g4 + e] * __builtin_amdgcn_exp2f(ex) : 0.f; }
                    u32x2 w; w.x = pk2(v[0], v[1]); w.y = pk2(v[2], v[3]);
                    *(u32x2*)(lds + OFF_P + i * RS + j0 * 2) = w; }
            }
            LBAR();
            }
            for (int ro_ = 0; ro_ < RU_O; ++ro_) {
            if (MODE == 0 || wave < 4) {
                const int ib = wave & 1, vb = (wave >> 1) & 3;
                f32x16 acc;
#pragma unroll
                for (int r = 0; r < 16; ++r) acc[r] = 0.f;
#pragma unroll
                for (int s = 0; s < 4; ++s) { const bf16x8_t af = *(const bf16x8_t*)(lds + OFF_P + (32 * ib + l31) * RS + (16 * s + 8 * hi) * 2), bfr = *(const bf16x8_t*)(lds + OFF_VT + (32 * vb + l31) * RS + (((2 * s + hi) ^ ((l31 >> 3) & 7) ^ ((4 * vb) & 7)) * 16));
                    acc = __builtin_amdgcn_mfma_f32_32x32x16_bf16(af, bfr, acc, 0, 0, 0); }
#pragma unroll
                for (int s = 0; s < 4; ++s) { const bf16x8_t af = *(const bf16x8_t*)(lds + OFF_QT + (32 * ib + l31) * RS + (16 * s + 8 * hi) * 2), bfr = *(const bf16x8_t*)(lds + OFF_ST + (32 * vb + l31) * RS + (16 * s + 8 * hi) * 2);
                    acc = __builtin_amdgcn_mfma_f32_32x32x16_bf16(af, bfr, acc, 0, 0, 0); }
                if (MODE == 1) {
#pragma unroll
                    for (int g4 = 0; g4 < 4; ++g4) { const u32x2 xv = *(const u32x2*)(lds + OFF_VT + (32 * vb + l31) * RS + (((4 * ib + g4) ^ ((l31 >> 3) & 7) ^ ((4 * vb) & 7)) * 16) + 8 * hi);
                        acc[4 * g4] += Dh * bflo(xv.x); acc[4 * g4 + 1] += Dh * bfhi(xv.x); acc[4 * g4 + 2] += Dh * bflo(xv.y); acc[4 * g4 + 3] += Dh * bfhi(xv.y); }
                }
#pragma unroll
                for (int r = 0; r < 16; ++r) *(float*)(lds + OFF_OB + (32 * ib + crow16(r, hi)) * OBS + (32 * vb + l31) * 4) = acc[r];
            }
            LBAR();
            }
            for (int rf_ = 0; rf_ < RU_FIN; ++rf_) {
            if (MODE == 0) {
                const int i = tid >> 3, part = tid & 7; const size_t row = (size_t)b * T_ + c * 64 + i;
                float o[16]; float sm = 0.f, sq = 0.f;
#pragma unroll
                for (int q4 = 0; q4 < 4; ++q4) { const f32x4 v = *(const f32x4*)(lds + OFF_OB + i * OBS + part * 64 + q4 * 16);
                    o[4 * q4] = v.x; o[4 * q4 + 1] = v.y; o[4 * q4 + 2] = v.z; o[4 * q4 + 3] = v.w; sm += (v.x + v.y) + (v.z + v.w); sq += (v.x * v.x + v.y * v.y) + (v.z * v.z + v.w * v.w); }
                sm += __shfl_xor(sm, 1); sq += __shfl_xor(sq, 1); sm += __shfl_xor(sm, 2); sq += __shfl_xor(sq, 2); sm += __shfl_xor(sm, 4); sq += __shfl_xor(sq, 4);
                const float mean = sm * (1.f / 128.f); const float rs = rsqrtf(fmaxf(sq * (1.f / 128.f) - mean * mean, 0.f) + EPS_);
                u32x4 w0, w1;
#pragma unroll
                for (int e = 0; e < 4; ++e) { w0[e] = pk2((o[2 * e] - mean) * rs * gw[2 * e] * siluf(bflo(rgA[e])), (o[2 * e + 1] - mean) * rs * gw[2 * e + 1] * siluf(bfhi(rgA[e])));
                    w1[e] = pk2((o[8 + 2 * e] - mean) * rs * gw[8 + 2 * e] * siluf(bflo(rgB[e])), (o[8 + 2 * e + 1] - mean) * rs * gw[8 + 2 * e + 1] * siluf(bfhi(rgB[e]))); }
                *(u32x4*)(Y + row * D_ + h * 128 + part * 16) = w0; *(u32x4*)(Y + row * D_ + h * 128 + part * 16 + 8) = w1;
            } else {
#pragma unroll
                for (int k = 0; k < 4; ++k) { const int idx = tid + 512 * k, i = idx >> 5, p = 2 * (idx & 31); const size_t row = (size_t)b * T_ + c * 64 + i;
                    const f32x2_t y = *(const f32x2_t*)(lds + OFF_OB + i * OBS + p * 4);
                    *(unsigned*)(TMP + row * 512 + h * 64 + p) = pk2(y.x * siluf(bflo(rg[k])), y.y * siluf(bfhi(rg[k]))); }
            }
            }
        }
    }
#undef SP_LOAD
    __syncthreads();
}

template <int MODE>
__device__ __forceinline__ void scalar_scan(ArgsP a) {
    constexpr int E2 = (MODE == 0 ? 128 : 64) * 64 / 2;
    constexpr int NS = MODE == 0 ? 32 : 64;
    unsigned* DS = (unsigned*)(a->ws + WS_ST + (MODE == 0 ? ST_DSRET : ST_DSSSD));
    const float* ALS = (const float*)(a->ws + WS_ST + ST_ALSSD);
    for (int it = bid_fresh() * 512 + tid_fresh(); it < NS * E2; it += gdim_fresh() * 512) {
        const int s = it / E2, e = it % E2;
        unsigned* p = DS + (size_t)s * 64 * E2 + e;
        float al = 1.f; if (MODE == 0) { const int h = s & 3; const float gamma = 1.f - exp2f(-5.f - (float)h); al = exp2f(64.f * log2f(gamma)); }
        float r0 = 0.f, r1 = 0.f;
        unsigned wn[8]; float an[8];
#pragma unroll
        for (int k = 0; k < 8; ++k) { wn[k] = p[(size_t)k * E2]; an[k] = (MODE == 0) ? al : ALS[s * 64 + k]; }
        for (int c0 = 0; c0 < 64; c0 += 8) {
            unsigned w[8]; float av[8];
#pragma unroll
            for (int k = 0; k < 8; ++k) { w[k] = wn[k]; av[k] = an[k]; }
            if (c0 + 8 < 64) {
#pragma unroll
                for (int k = 0; k < 8; ++k) { wn[k] = p[(size_t)(c0 + 8 + k) * E2]; an[k] = (MODE == 0) ? al : ALS[s * 64 + c0 + 8 + k]; } }
#pragma unroll
            for (int k = 0; k < 8; ++k) { p[(size_t)(c0 + k) * E2] = pk2(r0, r1); r0 = av[k] * r0 + bflo(w[k]); r1 = av[k] * r1 + bfhi(w[k]); }
        }
    }
}

template <int PASS  >
__device__ __forceinline__ void hg_pass(ArgsP a, int j, int bh, int c0, int c1, unsigned char* lds) {
    constexpr int RS = 144, RW = 272;
    constexpr int OFF_QX = 0, OFF_KV = 17408, OFF_OB = 0  , OFF_QT = 43520, OFF_KOT = 60928, OFF_VT = 79360, OFF_P = 97792, OFF_ST = 107008, OFF_AL = 141824;
    constexpr int OBS = 528;
    const int tid = tid_fresh(), lane = tid & 63, wave = tid >> 6, l31 = lane & 31, hi = lane >> 5;
    const int b = bh >> 2, h = bh & 3;
    const bf16* BIG = (const bf16*)(a->ws + WS_BIG); bf16* Y = (bf16*)(a->ws + WS_UY);
    bf16* DS = (bf16*)(a->ws + WS_ST + ST_DSHG) + (size_t)bh * 64 * 16384;
    float* ALG = (float*)(a->ws + WS_ST + ST_ALHG) + (size_t)bh * 64 * 128;
    const float* nw = a->in[18] + j * 128;
    const int c8 = wave * 2 + hi, tseg = l31;
    float lbv[8];
#pragma unroll
    for (int e = 0; e < 8; ++e) { lbv[e] = 0.f; if (j == 1) { const float l0 = a->in[17][h * 128 + c8 * 8 + e], l1 = a->in[17][512 + h * 128 + c8 * 8 + e]; lbv[e] = 1.f / (1.f + expf(l0 - l1)); } }
    float gw[16];
#pragma unroll
    for (int e = 0; e < 16; ++e) gw[e] = (PASS == 1) ? nw[(tid & 7) * 16 + e] : 0.f;
    __syncthreads();
    if (PASS == 1) { for (int i = tid; i < 9216 / 4; i += 512) ((unsigned*)(lds + OFF_P))[i] = 0u; }
    u32x4 rz[2], rq[2], rv[2], rs[4];
#define HP_LOAD(c) do { _Pragma("unroll") for (int rr = 0; rr < 2; ++rr) { const size_t row = (size_t)b * T_ + (c) * 64 + 2 * tseg + rr; \
        if (PASS == 1) rq[rr] = *(const u32x4*)(BIG + BIGX(row, h * 128 + c8 * 8)); rz[rr] = *(const u32x4*)(BIG + BIGX(row, 512 + h * 128 + c8 * 8)); rv[rr] = *(const u32x4*)(BIG + BIGX(row, 1024 + h * 128 + c8 * 8)); } \
        if (PASS == 1) { const bf16* sp = DS + (size_t)(c) * 16384; _Pragma("unroll") for (int k = 0; k < 4; ++k) rs[k] = *(const u32x4*)(sp + (tid + 512 * k) * 8); } } while (0)
    HP_LOAD(c0);
    __syncthreads();
    for (int c = c0; c < c1; ++c) {
        {
            float lf[2][8], kk[2][8], qv[2][8], cum[2][8];
#pragma unroll
            for (int rr = 0; rr < 2; ++rr)
#pragma unroll
                for (int e = 0; e < 4; ++e) {
                    const float z0 = fmaxf(bflo(rz[rr][e]), -60.f), z1 = fmaxf(bfhi(rz[rr][e]), -60.f);
                    const float e0 = __builtin_amdgcn_exp2f(-1.4426950408889634f * z0), e1 = __builtin_amdgcn_exp2f(-1.4426950408889634f * z1);
                    const float s0 = __builtin_amdgcn_rcpf(1.f + e0), s1 = __builtin_amdgcn_rcpf(1.f + e1);
                    const float f0 = lbv[2 * e] + (1.f - lbv[2 * e]) * s0, f1 = lbv[2 * e + 1] + (1.f - lbv[2 * e + 1]) * s1;
                    lf[rr][2 * e] = __logf(f0); lf[rr][2 * e + 1] = __logf(f1);
                    kk[rr][2 * e] = (1.f - lbv[2 * e]) * (e0 * s0); kk[rr][2 * e + 1] = (1.f - lbv[2 * e + 1]) * (e1 * s1);
                    if (PASS == 1) { qv[rr][2 * e] = bflo(rq[rr][e]); qv[rr][2 * e + 1] = bfhi(rq[rr][e]); } }
            float ref1[8], clast[8];
#pragma unroll
            for (int e = 0; e < 8; ++e) {
                float s = lf[0][e] + lf[1][e];
#pragma unroll
                for (int o = 1; o < 32; o <<= 1) { const float n = __shfl_up(s, o, 32); if (tseg >= o) s += n; }
                cum[1][e] = s; cum[0][e] = s - lf[1][e];
                ref1[e] = __shfl(s, 15, 32); clast[e] = __shfl(s, 31, 32); }
            const bool blk1 = tseg >= 16;
            if (PASS == 1) {
#pragma unroll
                for (int rr = 0; rr < 2; ++rr) { const int t = 2 * tseg + rr;
                    float qx[8], qt[8], k0[8], k1[8];
#pragma unroll
                    for (int e = 0; e < 8; ++e) { const float cm = cum[rr][e]; const float rf = blk1 ? ref1[e] : 0.f;
                        qx[e] = qv[rr][e] * __expf(cm - rf); qt[e] = qv[rr][e] * __expf(cm);
                        k0[e] = kk[rr][e] * __expf(rf - cm); k1[e] = kk[rr][e] * __expf(ref1[e] - cm); }
                    u32x4 wqx, wqt, wk0, wk1;
#pragma unroll
                    for (int e = 0; e < 4; ++e) { wqx[e] = pk2(qx[2 * e], qx[2 * e + 1]); wqt[e] = pk2(qt[2 * e], qt[2 * e + 1]); wk0[e] = pk2(k0[2 * e], k0[2 * e + 1]); wk1[e] = pk2(k1[2 * e], k1[2 * e + 1]); }
                    *(u32x4*)(lds + OFF_QX + t * RW + c8 * 16) = wqx; *(u32x4*)(lds + OFF_QT + t * RW + c8 * 16) = wqt;
                    if (!blk1) { *(u32x4*)(lds + OFF_KV + t * RW + c8 * 16) = wk0; *(u32x4*)(lds + OFF_KV + 8704 + t * RW + c8 * 16) = wk1; }
                    else       { *(u32x4*)(lds + OFF_KV + 2 * 8704 + (t - 32) * RW + c8 * 16) = wk0; } }
#pragma unroll
                for (int k = 0; k < 4; ++k) { const int id = tid + 512 * k; *(u32x4*)(lds + OFF_ST + (id >> 4) * RW + (id & 15) * 16) = rs[k]; }
            } else {
#pragma unroll
                for (int e = 0; e < 8; ++e) { *(unsigned*)(lds + OFF_KOT + (c8 * 8 + e) * RS + tseg * 4) = pk2(kk[0][e] * __expf(clast[e] - cum[0][e]), kk[1][e] * __expf(clast[e] - cum[1][e])); }
                if (tseg == 31) {
#pragma unroll
                    for (int e = 0; e < 8; ++e) ALG[c * 128 + c8 * 8 + e] = __expf(clast[e]); }
            }
#pragma unroll
            for (int e = 0; e < 4; ++e) { *(unsigned*)(lds + OFF_VT + (c8 * 8 + 2 * e) * RS + tseg * 4) = (rv[0][e] & 0xffffu) | (rv[1][e] << 16);
                *(unsigned*)(lds + OFF_VT + (c8 * 8 + 2 * e + 1) * RS + tseg * 4) = (rv[0][e] >> 16) | (rv[1][e] & 0xffff0000u); }
        }
        LBAR();
        if (c + 1 < c1) HP_LOAD(c + 1);
        if (PASS == 0) {
            const int svb = wave >> 1;
#pragma unroll
            for (int t = 0; t < 2; ++t) { const int db = 2 * (wave & 1) + t;
                f32x16 sacc;
#pragma unroll
                for (int r = 0; r < 16; ++r) sacc[r] = 0.f;
#pragma unroll
                for (int s = 0; s < 4; ++s) { const bf16x8_t af = *(const bf16x8_t*)(lds + OFF_KOT + (32 * db + l31) * RS + (16 * s + 8 * hi) * 2), bfr = *(const bf16x8_t*)(lds + OFF_VT + (32 * svb + l31) * RS + (16 * s + 8 * hi) * 2);
                    sacc = __builtin_amdgcn_mfma_f32_32x32x16_bf16(af, bfr, sacc, 0, 0, 0); }
                bf16* dp = DS + (size_t)c * 16384 + (32 * svb + l31) * 128 + 32 * db + 4 * hi;
#pragma unroll
                for (int g4 = 0; g4 < 4; ++g4) { u32x2 w; w.x = pk2(sacc[4 * g4], sacc[4 * g4 + 1]); w.y = pk2(sacc[4 * g4 + 2], sacc[4 * g4 + 3]); *(u32x2*)(dp + 8 * g4) = w; } }
            LBAR();
        } else {
            u32x4 rgA, rgB;
            { const bf16* gp = BIG + BIGX((size_t)b * T_ + c * 64 + (tid >> 3), 1536 + h * 128 + (tid & 7) * 16); rgA = *(const u32x4*)gp; rgB = *(const u32x4*)(gp + 8); }
            if (wave < 3) {
                const int ib = (wave == 0) ? 0 : 1, jb = (wave == 2) ? 1 : 0;
                f32x16 acc;
#pragma unroll
                for (int r = 0; r < 16; ++r) acc[r] = 0.f;
#pragma unroll
                for (int s = 0; s < 8; ++s) { const bf16x8_t af = *(const bf16x8_t*)(lds + OFF_KV + wave * 8704 + l31 * RW + (16 * s + 8 * hi) * 2), bfr = *(const bf16x8_t*)(lds + OFF_QX + (32 * ib + l31) * RW + (16 * s + 8 * hi) * 2);
                    acc = __builtin_amdgcn_mfma_f32_32x32x16_bf16(af, bfr, acc, 0, 0, 0); }
                const int i = 32 * ib + l31;
#pragma unroll
                for (int g4 = 0; g4 < 4; ++g4) { const int j0 = 32 * jb + 8 * g4 + 4 * hi; float v[4];
#pragma unroll
                    for (int e = 0; e < 4; ++e) v[e] = (j0 + e <= i) ? acc[4 * g4 + e] : 0.f;
                    u32x2 w; w.x = pk2(v[0], v[1]); w.y = pk2(v[2], v[3]);
                    *(u32x2*)(lds + OFF_P + i * RS + j0 * 2) = w; }
            }
            LBAR();
            {
                const int ib = wave & 1, vb = wave >> 1;
                f32x16 acc;
#pragma unroll
                for (int r = 0; r < 16; ++r) acc[r] = 0.f;
#pragma unroll
                for (int s = 0; s < 4; ++s) { const bf16x8_t af = *(const bf16x8_t*)(lds + OFF_P + (32 * ib + l31) * RS + (16 * s + 8 * hi) * 2), bfr = *(const bf16x8_t*)(lds + OFF_VT + (32 * vb + l31) * RS + (16 * s + 8 * hi) * 2);
                    acc = __builtin_amdgcn_mfma_f32_32x32x16_bf16(af, bfr, acc, 0, 0, 0); }
#pragma unroll
                for (int s = 0; s < 8; ++s) { const bf16x8_t af = *(const bf16x8_t*)(lds + OFF_QT + (32 * ib + l31) * RW + (16 * s + 8 * hi) * 2), bfr = *(const bf16x8_t*)(lds + OFF_ST + (32 * vb + l31) * RW + (16 * s + 8 * hi) * 2);
                    acc = __builtin_amdgcn_mfma_f32_32x32x16_bf16(af, bfr, acc, 0, 0, 0); }
#pragma unroll
                for (int r = 0; r < 16; ++r) *(float*)(lds + OFF_OB + (32 * ib + crow16(r, hi)) * OBS + (32 * vb + l31) * 4) = acc[r];
            }
            LBAR();
            { const int i = tid >> 3, part = tid & 7; const size_t row = (size_t)b * T_ + c * 64 + i;
                float o[16]; float sq = 0.f;
#pragma unroll
                for (int q4 = 0; q4 < 4; ++q4) { const f32x4 v = *(const f32x4*)(lds + OFF_OB + i * OBS + part * 64 + q4 * 16);
                    o[4 * q4] = v.x; o[4 * q4 + 1] = v.y; o[4 * q4 + 2] = v.z; o[4 * q4 + 3] = v.w; sq += (v.x * v.x + v.y * v.y) + (v.z * v.z + v.w * v.w); }
                sq += __shfl_xor(sq, 1); sq += __shfl_xor(sq, 2); sq += __shfl_xor(sq, 4);
                const float rsn = rsqrtf(sq * (1.f / 128.f) + EPS_);
                u32x4 w0, w1;
#pragma unroll
                for (int e = 0; e < 4; ++e) { w0[e] = pk2(o[2 * e] * rsn * gw[2 * e] * siluf(bflo(rgA[e])), o[2 * e + 1] * rsn * gw[2 * e + 1] * siluf(bfhi(rgA[e])));
                    w1[e] = pk2(o[8 + 2 * e] * rsn * gw[8 + 2 * e] * siluf(bflo(rgB[e])), o[8 + 2 * e + 1] * rsn * gw[8 + 2 * e + 1] * siluf(bfhi(rgB[e]))); }
                *(u32x4*)(Y + row * D_ + h * 128 + part * 16) = w0; *(u32x4*)(Y + row * D_ + h * 128 + part * 16 + 8) = w1; }
            LBAR();
        }
    }
#undef HP_LOAD
    __syncthreads();
}

__device__ __forceinline__ void hg_scan(ArgsP a) {
    constexpr int E2 = 8192;
    unsigned* DS = (unsigned*)(a->ws + WS_ST + ST_DSHG);
    const float* ALG = (const float*)(a->ws + WS_ST + ST_ALHG);
    for (int it = bid_fresh() * 512 + tid_fresh(); it < 32 * E2; it += gdim_fresh() * 512) {
        const int s = it / E2, e = it % E2; const int d = (2 * e) & 127;
        unsigned* p = DS + (size_t)s * 64 * E2 + e;
        const float* al = ALG + (size_t)s * 64 * 128 + d;
        float r0 = 0.f, r1 = 0.f;
        unsigned wn[8]; f32x2_t an[8];
#pragma unroll
        for (int k = 0; k < 8; ++k) { wn[k] = p[(size_t)k * E2]; an[k] = *(const f32x2_t*)(al + k * 128); }
        for (int c0 = 0; c0 < 64; c0 += 8) {
            unsigned w[8]; f32x2_t av[8];
#pragma unroll
            for (int k = 0; k < 8; ++k) { w[k] = wn[k]; av[k] = an[k]; }
            if (c0 + 8 < 64) {
#pragma unroll
                for (int k = 0; k < 8; ++k) { wn[k] = p[(size_t)(c0 + 8 + k) * E2]; an[k] = *(const f32x2_t*)(al + (c0 + 8 + k) * 128); } }
#pragma unroll
            for (int k = 0; k < 8; ++k) { p[(size_t)(c0 + k) * E2] = pk2(r0, r1); r0 = av[k].x * r0 + bflo(w[k]); r1 = av[k].y * r1 + bfhi(w[k]); }
        }
    }
}

#ifndef REP_PROLOGUE
#define REP_PROLOGUE 1
#endif
#ifndef REP_NORM
#define REP_NORM 1
#endif
#ifndef REP_INPROJ
#define REP_INPROJ 1
#endif
#ifndef REP_EVENMIX
#define REP_EVENMIX 1
#endif
#ifndef REP_ODDMIX
#define REP_ODDMIX 1
#endif
#ifndef REP_SYNC
#define REP_SYNC 1
#endif
#ifndef REP_FOX
#define REP_FOX 1
#endif
#ifndef REP_UP
#define REP_UP 1
#endif
__global__ void __launch_bounds__(512, 2) fwd_kernel(Args a_unused) {
    extern __shared__ __attribute__((aligned(16))) unsigned char lds[];
    cg::grid_group grid = cg::this_grid();
    PG8_LAS unsigned char* lds3 = (PG8_LAS unsigned char*)lds;
    volatile int* s_nextp = (volatile int*)(lds + 141 * 1024);
    volatile LAS unsigned* xmisc = (volatile LAS unsigned*)((LAS unsigned char*)lds + 145920);
    if (tid_fresh() < 2) xmisc[tid_fresh()] = 0u;
    __syncthreads();
    { ArgsP a = fresh_args(); (void)xcd_barrier_post((unsigned*)(a->ws + WS_CTL) + 4096, xmisc); }
#define XSYNC() do { ArgsP a_ = fresh_args(); XcdBarrier xb_; xb_.bar = (unsigned*)(a_->ws + WS_CTL) + 4096; xb_.x = xb_xcc_id(); xb_.st = (volatile LAS unsigned*)((LAS unsigned char*)lds + 145920); xcd_barrier(xb_); } while (0)

    for (int rep = 0; rep < REP_PROLOGUE; ++rep) { { ArgsP a = fresh_args(); prologue(a, lds); }
    XSYNC(); }
    { ArgsP a = fresh_args(); if (a->ws == nullptr) grid.sync(); }

#pragma unroll 1
    for (int L = 0; L < 4; ++L) {
        const int j = L >> 1; const bool even = (L & 1) == 0;
        for (int rep = 0; rep < REP_NORM; ++rep) {
        { ArgsP a = fresh_args(); unsigned char* ws = a->ws;
          const float* Wg = even ? a->in[6] + (size_t)j * D_ * AB_LD : a->in[15] + (size_t)j * D_ * CD_LD; const int ldw = even ? AB_LD : CD_LD, goff = even ? AB_N : CD_N, ng = even ? 8 : 4;
          if (L == 0) norm_phase<false, true>(a->in[0], a->in[1] + L * D_, (bf16*)(ws + WS_UY), Wg, ldw, goff, ng, (float*)(ws + WS_GATE), (float*)(ws + WS_RSTD1), lds);
          else        norm_phase<true, false>(a->out, a->in[1] + L * D_, nullptr, Wg, ldw, goff, ng, (float*)(ws + WS_GATE), (float*)(ws + WS_RSTD1), lds); }
        XSYNC(); }
        for (int rep = 0; rep < REP_INPROJ; ++rep) {
        { const int bx = bid_fresh(); if (!even && bx < 32) { ArgsP a = fresh_args(); cumf_seq(a, j, bx, lds); } }
#ifndef NO_INPROJ
        if (even) { ArgsP a = fresh_args(); unsigned char* ws = a->ws;
            pg8::Gemm g{(L == 0) ? (const bf16*)(ws + WS_UY) : (const bf16*)a->out, (const bf16*)(ws + WS_WABIN) + (size_t)j * AB_N * D_, M_, AB_N, D_}; pg8::StaticOrder S; S.init(M_, AB_N, gdim_fresh(), bid_fresh());
            pg8::EpiBf16BlkR E{(bf16*)(ws + WS_BIG), M_, (const float*)(ws + WS_RSTD1)};
            pg8::gemm_phase<pg8::EpiBf16BlkR, pg8::StaticOrder, true, true>(lds3, g, S, E);
        } else { ArgsP a = fresh_args(); unsigned char* ws = a->ws;
            pg8::Gemm g{(const bf16*)a->out, (const bf16*)(ws + WS_WCDIN) + (size_t)j * CD_N * D_, M_, CD_N, D_}; pg8::StaticOrder S; S.init(M_, CD_N, gdim_fresh(), bid_fresh());
            pg8::EpiBf16BlkR E{(bf16*)(ws + WS_BIG), M_, (const float*)(ws + WS_RSTD1)};
            pg8::gemm_phase<pg8::EpiBf16BlkR, pg8::StaticOrder, true, true>(lds3, g, S, E);
        }
#endif
        XSYNC(); }
        if (even) {
          for (int rep = 0; rep < REP_EVENMIX; ++rep) {
            if (rep) XSYNC();
#define EVEN_PASS(PASS) do { ArgsP a = fresh_args(); const int G_ = gdim_fresh(), bx = bid_fresh(); const int perr = (2048 + G_ - 1) / G_, pers = (4096 + G_ - 1) / G_;     \
              { int u = bx * perr; const int end = min(u + perr, 2048); while (u < end) { const int bh = u >> 6, ce = min(end, (bh + 1) * 64); scalar_pass<0, PASS>(a, j, bh, u & 63, ce - bh * 64, lds); u = ce; } } \
              { int u = bx * pers; const int end = min(u + pers, 4096); while (u < end) { const int bh = u >> 6, ce = min(end, (bh + 1) * 64); scalar_pass<1, PASS>(a, j, bh, u & 63, ce - bh * 64, lds); u = ce; } } } while (0)
            EVEN_PASS(0);
            XSYNC();
            { ArgsP a = fresh_args(); scalar_scan<0>(a); scalar_scan<1>(a); }
            XSYNC();
            EVEN_PASS(1);
            XSYNC();
            { ArgsP a = fresh_args(); ssd_norm_phase(a, j); }
          }
        } else {
          for (int rep = 0; rep < REP_ODDMIX; ++rep) {
            if (rep) XSYNC();
#define HG_PASS(PASS) do { ArgsP a = fresh_args(); const int G_ = gdim_fresh(), bx = bid_fresh(); const int per = (2048 + G_ - 1) / G_; int u = bx * per; const int end = min(u + per, 2048); \
              while (u < end) { const int bh = u >> 6, ce = min(end, (bh + 1) * 64); hg_pass<PASS>(a, j, bh, u & 63, ce - bh * 64, lds); u = ce; } } while (0)
            if (rep == 0) { { ArgsP a = fresh_args(); fox_prep(a, j, lds); } }
            HG_PASS(0);
            XSYNC();
            { ArgsP a = fresh_args(); hg_scan(a); }
            for (int rf = 0; rf < REP_FOX; ++rf) { ArgsP a = fresh_args(); unsigned* ctl = (unsigned*)(a->ws + WS_CTL) + 64 * 8 * rf;
              for (;;) {
                __syncthreads();
                if (tid_fresh() == 0) *s_nextp = (int)atomicAdd(ctl + 64 * (1 + L + 4 * rep), 1u);
                __syncthreads();
                const int u = *s_nextp;
                if (u >= 512) break;
                fox_unit2(a, u & 31, 15 - (u >> 5), lds);
              } }
            XSYNC();
            HG_PASS(1);
          }
        }
        for (int rep = 0; rep < REP_SYNC; ++rep) XSYNC();
#ifndef NO_OUTPROJ
        { ArgsP a = fresh_args(); unsigned char* ws = a->ws;
            const bf16* Wt = even ? (const bf16*)(ws + WS_WABOUT) + (size_t)j * D_ * D_ : (const bf16*)(ws + WS_WCDOUT) + (size_t)j * D_ * D_;
            pg8::Gemm g{(const bf16*)(ws + WS_UY), Wt, M_, D_, D_}; pg8::StaticOrder S; S.init(M_, D_, gdim_fresh(), bid_fresh());
            if (L == 0) { pg8::EpiResidT<false, true> E{a->in[0], a->out, D_, (float*)(ws + WS_RSP)}; pg8::gemm_phase<pg8::EpiResidT<false, true>, pg8::StaticOrder, true, true>(lds3, g, S, E); }
            else { pg8::EpiResidT<true, true> E{a->out, (L == 3) ? (void*)(ws + WS_ST) : (void*)a->out, D_, (float*)(ws + WS_RSP)}; pg8::gemm_phase<pg8::EpiResidT<true, true>, pg8::StaticOrder, true, true>(lds3, g, S, E); }
        }
#endif
        XSYNC();
        { ArgsP a = fresh_args(); rstd_phase(a); }
        XSYNC();
        for (int rep = 0; rep < REP_UP; ++rep) {
#ifndef NO_UP
        { ArgsP a = fresh_args(); unsigned char* ws = a->ws;
            pg8::Gemm g{(L == 3) ? (const bf16*)(ws + WS_ST) : (const bf16*)a->out, (const bf16*)(ws + WS_WGU) + (size_t)L * 2 * FF_ * D_, M_, 2 * FF_, D_}; pg8::StaticOrder S; S.init(M_, 2 * FF_, gdim_fresh(), bid_fresh());
            pg8::EpiSwigluR E{(bf16*)(ws + WS_BIG), FF_, (const float*)(ws + WS_RSTD)};
            pg8::gemm_phase<pg8::EpiSwigluR, pg8::StaticOrder, true, true>(lds3, g, S, E);
        }
#endif
        XSYNC(); }
#ifndef NO_DOWN
        { ArgsP a = fresh_args(); unsigned char* ws = a->ws;
            pg8::Gemm g{(const bf16*)(ws + WS_BIG), (const bf16*)(ws + WS_WDN) + (size_t)L * D_ * FF_, M_, D_, FF_}; pg8::StaticOrder S; S.init(M_, D_, gdim_fresh(), bid_fresh());
            if (L == 3) { pg8::EpiResidT<true, false> E{ws + WS_ST, a->out, D_, nullptr}; pg8::gemm_phase<pg8::EpiResidT<true, false>, pg8::StaticOrder, true, true>(lds3, g, S, E); }
            else { pg8::EpiResidT<true, true> E{a->out, a->out, D_, nullptr}; pg8::gemm_phase<pg8::EpiResidT<true, true>, pg8::StaticOrder, true, true>(lds3, g, S, E); }
        }
#endif
        if (L < 3) XSYNC();
    }
}

extern "C" void kernel_launch(void* const* d_in, const int* in_sizes, int n_in, void* d_out, int out_size, void* d_ws, size_t ws_size, hipStream_t stream) {
    static int grid = 0;
    if (grid == 0) {
        if (n_in != 22 || ws_size < WS_END) { fprintf(stderr, "kernel_launch: unexpected n_in %d / ws %zu\n", n_in, ws_size); grid = -1; return; }
        int dev = 0, cus = 0, per_cu = 0;
        (void)hipGetDevice(&dev); (void)hipDeviceGetAttribute(&cus, hipDeviceAttributeMultiprocessorCount, dev);
        (void)hipFuncSetAttribute((const void*)fwd_kernel, hipFuncAttributeMaxDynamicSharedMemorySize, LDS_BYTES);
        (void)hipOccupancyMaxActiveBlocksPerMultiprocessor(&per_cu, (const void*)fwd_kernel, 512, LDS_BYTES);
        (void)hipGetLastError();
        if (per_cu < 1) per_cu = 1;
        grid = cus * per_cu;
        fprintf(stderr, "kernel_launch: cus %d per_cu %d grid %d\n", cus, per_cu, grid);
    }
    if (grid < 0) return;
    (void)hipMemsetAsync((char*)d_ws + WS_CTL, 0, 65536, stream);
    Args a{};
    for (int i = 0; i < 22; ++i) a.in[i] = (const float*)d_in[i];
    a.out = (float*)d_out; a.ws = (unsigned char*)d_ws;
    void* args[] = {&a};
    hipError_t e = hipLaunchCooperativeKernel((const void*)fwd_kernel, dim3(grid), dim3(512), args, LDS_BYTES, stream);
    if (e != hipSuccess) fprintf(stderr, "cooperative launch failed: %s (grid %d)\n", hipGetErrorString(e), grid);
}
```

```cpp
#include <hip/hip_runtime.h>
#include <hip/hip_cooperative_groups.h>
#include <cstdio>
#include <cstdint>
#include <cmath>
namespace cg = cooperative_groups;
#ifndef RU_STAGE
#define RU_STAGE 1
#endif
#ifndef RU_G
#define RU_G 1
#endif
#ifndef RU_O
#define RU_O 1
#endif
#ifndef RU_FIN
#define RU_FIN 1
#endif
__device__ __forceinline__ int tid_fresh() { int t = threadIdx.x; asm volatile("" : "+v"(t)); return t; }
__device__ __forceinline__ int bid_fresh() { int t = blockIdx.x; asm volatile("" : "+s"(t)); return t; }
__device__ __forceinline__ int gdim_fresh() { int t = gridDim.x; asm volatile("" : "+s"(t)); return t; }
namespace pg8 {
#define PG8_LAS __attribute__((address_space(3)))
typedef unsigned short bf16_t;
typedef short bf16x8 __attribute__((ext_vector_type(8)));
typedef float f32x4 __attribute__((ext_vector_type(4)));
typedef unsigned u32x4 __attribute__((ext_vector_type(4)));
constexpr int BM = 256, BK = 64, HALF = 128, HTB = HALF * BK * 2  , STAGE_BYTES = 8 * HTB, NXCD = 8, WGM = 4;

__host__ __device__ __forceinline__ int lds_byte(int r, int c) { const int st = (r >> 4) * 2 + (c >> 5), rr = r & 15, cc = c & 31, ob = rr * 64 + cc * 2; return st * 1024 + (ob ^ (((ob >> 9) & 1) << 5)); }
__host__ __device__ __forceinline__ void stage_rc(int b, int& R, int& C) { const int st = b / 1024, sb = b % 1024, swz = sb ^ (((sb >> 9) & 1) << 5); R = (st >> 1) * 16 + swz / 64; C = (st & 1) * 32 + (swz % 64) / 2; }
__host__ __device__ __forceinline__ int perm32(int rho) { const int n = rho >> 4, i = rho & 15; return 8 * (i >> 2) + 4 * n + (i & 3); }

struct Unit { int pm, pn; };
struct Gemm { const bf16_t* A; const bf16_t* Bt; int M, N, K; };

struct StaticOrder {
    int nM, nN, nwg, G, c;
    __host__ __device__ void init(int M, int N, int G_, int c_) { nM = M / BM; nN = N / BM; nwg = nM * nN; G = G_; c = c_; }
    __host__ __device__ bool next(int i, Unit& u) const {
        const long L = (long)i * G + c; if (L >= nwg) return false;
        int wgid = (int)L; { const int q = nwg / NXCD, r = nwg % NXCD, xcd = wgid % NXCD, off = wgid / NXCD; wgid = (xcd < r ? xcd * (q + 1) : r * (q + 1) + (xcd - r) * q) + off; }
        const int nig = WGM * nN, gid = wgid / nig, fm = gid * WGM, gsz = (nM - fm) < WGM ? (nM - fm) : WGM;
        u.pm = fm + ((wgid % nig) % gsz); u.pn = (wgid % nig) / gsz; return true;
    }
    __device__ __forceinline__ void a_ready(const Unit&) const {}
    __device__ __forceinline__ void done(const Unit&) const {}
};

__device__ __forceinline__ unsigned cvt_pk_bf16(float lo, float hi) { unsigned r; asm volatile("v_cvt_pk_bf16_f32 %0, %1, %2" : "=v"(r) : "v"(lo), "v"(hi)); return r; }
typedef float f32x2 __attribute__((ext_vector_type(2)));
__device__ __forceinline__ f32x2 gelu_pk(f32x2 v) {
    const f32x2 av = __builtin_elementwise_abs(v), d = av * 0.2316418882f + 1.0f;
    f32x2 t; t.x = __builtin_amdgcn_rcpf(d.x); t.y = __builtin_amdgcn_rcpf(d.y);
    f32x2 q = t * 0.5307027145f + (-0.7265760135f); q = q * t + 0.7107068705f; q = q * t + (-0.142248368f); q = q * t + 0.127414796f; q = q * t;
    const f32x2 s = (v * v) * (-0.72134752044f);
    f32x2 e; e.x = __builtin_amdgcn_exp2f(s.x); e.y = __builtin_amdgcn_exp2f(s.y);
    const f32x2 m = v * (q * e), r = v - m;
    f32x2 o; o.x = v.x < 0.f ? m.x : r.x; o.y = v.y < 0.f ? m.y : r.y; return o;
}

template <int ACT  > struct EpiBf16 {
    static constexpr bool PERM = true, AFTER_DRAIN = false; static_assert(ACT == 0 || ACT == 1, "EpiBf16: ACT is 0 (none) or 1 (gelu_pk)");
    bf16_t* O; int ldc; const float* bias; int split_cols; size_t split_stride; float scale0;
    __device__ __forceinline__ void operator()(const f32x4 (&acc)[2][2][4][2], const Unit& u, int wr, int wc, int fr, int fq) const {
        const int row0 = u.pm * BM + wr * 64 + fr; int colt = u.pn * BM; bf16_t* base = O;
        float sc = 1.f; if (split_cols) { const int t = colt / split_cols; base += (size_t)t * split_stride; colt -= t * split_cols; if (t == 0) sc = scale0; }
        const int col0 = colt + wc * 32 + 8 * fq, bcol0 = u.pn * BM + wc * 32 + 8 * fq;
        f32x4 bv[2][2];
#pragma unroll
        for (int bj = 0; bj < 2; ++bj)
#pragma unroll
            for (int n = 0; n < 2; ++n) bv[bj][n] = bias ? *(const f32x4*)(bias + bcol0 + bj * HALF + 4 * n) : (f32x4){0.f, 0.f, 0.f, 0.f};
#pragma unroll
        for (int ai = 0; ai < 2; ++ai)
#pragma unroll
            for (int m = 0; m < 4; ++m) { bf16_t* rowp = base + (size_t)(row0 + ai * HALF + m * 16) * ldc + col0;
#pragma unroll
                for (int bj = 0; bj < 2; ++bj) { f32x4 v0 = acc[ai][bj][m][0] + bv[bj][0], v1 = acc[ai][bj][m][1] + bv[bj][1];
                    if (ACT == 1) { f32x2 a = gelu_pk((f32x2){v0[0], v0[1]}), b = gelu_pk((f32x2){v0[2], v0[3]}), c = gelu_pk((f32x2){v1[0], v1[1]}), d = gelu_pk((f32x2){v1[2], v1[3]});
                        v0 = (f32x4){a.x, a.y, b.x, b.y}; v1 = (f32x4){c.x, c.y, d.x, d.y}; }
                    v0 = v0 * sc; v1 = v1 * sc; u32x4 w; w.x = cvt_pk_bf16(v0[0], v0[1]); w.y = cvt_pk_bf16(v0[2], v0[3]); w.z = cvt_pk_bf16(v1[0], v1[1]); w.w = cvt_pk_bf16(v1[2], v1[3]);
                    *(u32x4*)(rowp + bj * HALF) = w; } }
    }
};

template <class Epi, class Sched, bool ALIGN_EPI = false, bool SP2 = false>
__device__ __forceinline__ void gemm_phase(PG8_LAS unsigned char* lds, const Gemm g, const Sched& S, const Epi& E) {
    const int tid = tid_fresh(), wid = __builtin_amdgcn_readfirstlane(tid >> 6), lane = tid & 63, wr = wid >> 2, wc = wid & 3, fr = lane & 15, fq = lane >> 4;
    const int K = g.K, nt = K / BK;
    unsigned voffA[2], voffB[2];
#pragma unroll
    for (int i = 0; i < 2; ++i) { int R, C; stage_rc(tid * 16 + i * 8192, R, C); const int Rb = Epi::PERM ? ((R & ~31) + perm32(R & 31)) : R;
        voffA[i] = (unsigned)(R * K + C) * 2u; voffB[i] = (unsigned)(Rb * K + C) * 2u; }
    const size_t kstep = (size_t)(BK * 2);
    const size_t hstep = (size_t)HALF * K * 2;
    const size_t tstep = 2 * hstep;
    const unsigned ldsw = (unsigned)wid * 1024u;
    const int aoff = lds_byte(wr * 64 + fr, fq * 8), boff = lds_byte(wc * 32 + fr, fq * 8);
#define PG8_SA(b, h) (((b) * 2 + (h)) * HTB)
#define PG8_SB(b, h) ((4 + (b) * 2 + (h)) * HTB)
#define PG8_STAGE(bufoff, gbase, voff) do { _Pragma("unroll") for (int _i = 0; _i < 2; ++_i) \
        __builtin_amdgcn_global_load_lds((const unsigned*)((const char*)(gbase) + (voff)[_i]), (PG8_LAS unsigned*)(lds + (bufoff) + ldsw + _i * 8192), 16, 0, 0); } while (0)
#define PG8_LDA(dst, b, h) do { _Pragma("unroll") for (int m = 0; m < 4; ++m) _Pragma("unroll") for (int k = 0; k < 2; ++k) dst[m][k] = *(const PG8_LAS bf16x8*)(lds + PG8_SA(b, h) + aoff + m * 2048 + k * 1024); } while (0)
#define PG8_LDB(dst, b, h) do { _Pragma("unroll") for (int n = 0; n < 2; ++n) _Pragma("unroll") for (int k = 0; k < 2; ++k) dst[n][k] = *(const PG8_LAS bf16x8*)(lds + PG8_SB(b, h) + boff + n * 2048 + k * 1024); } while (0)
#define PG8_MMA(ai, bj, At, Bt) do { __builtin_amdgcn_s_setprio(1); _Pragma("unroll") for (int m = 0; m < 4; ++m) _Pragma("unroll") for (int n = 0; n < 2; ++n) _Pragma("unroll") for (int k = 0; k < 2; ++k) \
        acc[ai][bj][m][n] = __builtin_amdgcn_mfma_f32_16x16x32_bf16(Bt[n][k], At[m][k], acc[ai][bj][m][n], 0, 0, 0); __builtin_amdgcn_s_setprio(0); } while (0)
#define PG8_WAIT_V(n) asm volatile("s_waitcnt vmcnt(" #n ")" ::: "memory")
#define PG8_WAIT_L(n) asm volatile("s_waitcnt lgkmcnt(" #n ")" ::: "memory")
#define PG8_BAR __builtin_amdgcn_s_barrier()
#define PG8_SCHED __builtin_amdgcn_sched_barrier(0)
    Unit cur, nxt; int ui = 0;
    if (!S.next(0, cur)) return;
    f32x4 acc[2][2][4][2];
#pragma unroll
    for (int a = 0; a < 2; ++a)
#pragma unroll
        for (int b = 0; b < 2; ++b)
#pragma unroll
            for (int m = 0; m < 4; ++m)
#pragma unroll
                for (int n = 0; n < 2; ++n) acc[a][b][m][n] = (f32x4){0.f, 0.f, 0.f, 0.f};
    bf16x8 At[4][2], B0[2][2], B1[2][2];
    const char* cA = (const char*)g.A + (size_t)cur.pm * tstep; const char* cB = (const char*)g.Bt + (size_t)cur.pn * tstep;
    S.a_ready(cur);
    if constexpr (SP2) {
        PG8_STAGE(PG8_SB(0, 0), cB, voffB); PG8_STAGE(PG8_SB(0, 1), cB + hstep, voffB); PG8_STAGE(PG8_SA(0, 0), cA, voffA); PG8_STAGE(PG8_SA(0, 1), cA + hstep, voffA);
        if (wr == 1) PG8_BAR;
        PG8_WAIT_V(2); PG8_BAR;
        PG8_STAGE(PG8_SB(1, 0), cB + kstep, voffB); PG8_STAGE(PG8_SA(1, 0), cA + kstep, voffA); PG8_STAGE(PG8_SB(1, 1), cB + hstep + kstep, voffB);
        PG8_WAIT_V(6); PG8_BAR;
    } else {
        PG8_STAGE(PG8_SB(0, 0), cB, voffB); PG8_STAGE(PG8_SA(0, 0), cA, voffA); PG8_STAGE(PG8_SB(0, 1), cB + hstep, voffB); PG8_STAGE(PG8_SA(0, 1), cA + hstep, voffA);
        if (wr == 1) PG8_BAR;
        PG8_WAIT_V(4); PG8_BAR;
        PG8_STAGE(PG8_SB(1, 0), cB + kstep, voffB); PG8_STAGE(PG8_SA(1, 0), cA + kstep, voffA); PG8_STAGE(PG8_SB(1, 1), cB + hstep + kstep, voffB);
        PG8_WAIT_V(6); PG8_BAR;
    }
    for (;;) {
        const bool has_next = S.next(ui + 1, nxt);
        const char* nA = has_next ? (const char*)g.A + (size_t)nxt.pm * tstep : cA; const char* nB = has_next ? (const char*)g.Bt + (size_t)nxt.pn * tstep : cB;
        for (int t = 0; t < nt; t += 2) {
            const bool last = (t == nt - 2);
            const char* a1 = cA + (size_t)(t + 1) * kstep;
            const char* a2 = last ? nA : cA + (size_t)(t + 2) * kstep; const char* b2 = last ? nB : cB + (size_t)(t + 2) * kstep;
            const char* a3 = a2 + kstep; const char* b3 = b2 + kstep;
            if (last && has_next) S.a_ready(nxt);
            if constexpr (SP2) {
            PG8_LDB(B0, 0, 0); PG8_LDB(B1, 0, 1); PG8_SCHED; PG8_LDA(At, 0, 0); PG8_STAGE(PG8_SA(1, 1), a1 + hstep, voffA);
            PG8_WAIT_V(8); PG8_WAIT_L(0); PG8_BAR; PG8_MMA(0, 0, At, B0); PG8_MMA(0, 1, At, B1); PG8_BAR; PG8_SCHED;
            PG8_LDA(At, 0, 1); PG8_STAGE(PG8_SB(0, 0), b2, voffB); PG8_STAGE(PG8_SB(0, 1), b2 + hstep, voffB); PG8_STAGE(PG8_SA(0, 0), a2, voffA);
            PG8_WAIT_V(8); PG8_WAIT_L(0); PG8_BAR; PG8_MMA(1, 0, At, B0); PG8_MMA(1, 1, At, B1); PG8_BAR; PG8_SCHED;
            PG8_LDB(B0, 1, 0); PG8_LDB(B1, 1, 1); PG8_SCHED; PG8_LDA(At, 1, 0); PG8_STAGE(PG8_SA(0, 1), a2 + hstep, voffA);
            PG8_WAIT_V(8); PG8_WAIT_L(0); PG8_BAR; PG8_MMA(0, 0, At, B0); PG8_MMA(0, 1, At, B1); PG8_BAR; PG8_SCHED;
            PG8_LDA(At, 1, 1); PG8_STAGE(PG8_SB(1, 0), b3, voffB); PG8_STAGE(PG8_SB(1, 1), b3 + hstep, voffB); PG8_STAGE(PG8_SA(1, 0), a3, voffA);
            PG8_WAIT_V(8); PG8_WAIT_L(0); PG8_BAR; PG8_MMA(1, 0, At, B0); PG8_MMA(1, 1, At, B1); PG8_BAR; PG8_SCHED;
            } else {
            PG8_LDB(B0, 0, 0); PG8_SCHED; PG8_LDA(At, 0, 0); PG8_STAGE(PG8_SA(1, 1), a1 + hstep, voffA);
            PG8_WAIT_L(8); PG8_BAR; PG8_WAIT_L(0); PG8_MMA(0, 0, At, B0); PG8_BAR; PG8_SCHED;
            PG8_LDB(B1, 0, 1); PG8_STAGE(PG8_SB(0, 0), b2, voffB);
            PG8_BAR; PG8_WAIT_L(0); PG8_MMA(0, 1, At, B1); PG8_BAR;
            PG8_LDA(At, 0, 1); PG8_STAGE(PG8_SA(0, 0), a2, voffA);
            PG8_BAR; PG8_WAIT_L(0); PG8_MMA(1, 0, At, B0); PG8_BAR; PG8_SCHED;
            PG8_STAGE(PG8_SB(0, 1), b2 + hstep, voffB);
            PG8_WAIT_V(6); PG8_BAR; PG8_MMA(1, 1, At, B1); PG8_BAR;
            PG8_LDB(B0, 1, 0); PG8_SCHED; PG8_LDA(At, 1, 0); PG8_STAGE(PG8_SA(0, 1), a2 + hstep, voffA);
            PG8_WAIT_L(8); PG8_BAR; PG8_WAIT_L(0); PG8_MMA(0, 0, At, B0); PG8_BAR; PG8_SCHED;
            PG8_LDB(B1, 1, 1); PG8_STAGE(PG8_SB(1, 0), b3, voffB);
            PG8_BAR; PG8_WAIT_L(0); PG8_MMA(0, 1, At, B1); PG8_BAR;
            PG8_LDA(At, 1, 1); PG8_STAGE(PG8_SA(1, 0), a3, voffA);
            PG8_BAR; PG8_WAIT_L(0); PG8_MMA(1, 0, At, B0); PG8_BAR; PG8_SCHED;
            PG8_STAGE(PG8_SB(1, 1), b3 + hstep, voffB);
            PG8_WAIT_V(6); PG8_BAR; PG8_MMA(1, 1, At, B1); PG8_BAR;
            }
        }
        if constexpr (ALIGN_EPI) { if (wr == 0) PG8_BAR; }
        if constexpr (!Epi::AFTER_DRAIN) { E(acc, cur, wr, wc, fr, fq); S.done(cur); }
        if (!has_next) break;
#pragma unroll
        for (int a = 0; a < 2; ++a)
#pragma unroll
            for (int b = 0; b < 2; ++b)
#pragma unroll
                for (int m = 0; m < 4; ++m)
#pragma unroll
                    for (int n = 0; n < 2; ++n) acc[a][b][m][n] = (f32x4){0.f, 0.f, 0.f, 0.f};
        cur = nxt; cA = nA; cB = nB; ++ui;
        if constexpr (ALIGN_EPI) { if (wr == 1) PG8_BAR; }
    }
    PG8_WAIT_V(0);
    if constexpr (!ALIGN_EPI) { if (wr == 0) PG8_BAR; }
    PG8_BAR;
    if constexpr (Epi::AFTER_DRAIN) { E.fused(acc, cur, wr, wc, fr, fq, lds, wid, lane); S.done(cur); }
#undef PG8_SA
#undef PG8_SB
#undef PG8_STAGE
#undef PG8_LDA
#undef PG8_LDB
#undef PG8_MMA
#undef PG8_WAIT_V
#undef PG8_WAIT_L
#undef PG8_BAR
#undef PG8_SCHED
}
}

namespace pg8 {
__device__ __forceinline__ float silu_f(float x) { return x * __builtin_amdgcn_rcpf(1.0f + __builtin_amdgcn_exp2f(-1.4426950408889634f * x)); }
struct EpiSwiglu {
    static constexpr bool PERM = true, AFTER_DRAIN = false;
    bf16_t* O; int ldc;
    __device__ __forceinline__ void operator()(const f32x4 (&acc)[2][2][4][2], const Unit& u, int wr, int wc, int fr, int fq) const {
        const int row0 = u.pm * BM + wr * 64 + fr; const int col0 = u.pn * HALF + wc * 32 + 8 * fq;
#pragma unroll
        for (int ai = 0; ai < 2; ++ai)
#pragma unroll
            for (int m = 0; m < 4; ++m) { bf16_t* rowp = O + (size_t)(row0 + ai * HALF + m * 16) * ldc + col0;
                const f32x4 g0 = acc[ai][0][m][0], g1 = acc[ai][0][m][1], u0 = acc[ai][1][m][0], u1 = acc[ai][1][m][1];
                f32x4 v0, v1;
#pragma unroll
                for (int i = 0; i < 4; ++i) { v0[i] = silu_f(g0[i]) * u0[i]; v1[i] = silu_f(g1[i]) * u1[i]; }
                u32x4 w; w.x = cvt_pk_bf16(v0[0], v0[1]); w.y = cvt_pk_bf16(v0[2], v0[3]); w.z = cvt_pk_bf16(v1[0], v1[1]); w.w = cvt_pk_bf16(v1[2], v1[3]);
                *(u32x4*)rowp = w; }
    }
};
struct EpiSwigluR {
    static constexpr bool PERM = true, AFTER_DRAIN = false;
    bf16_t* O; int ldc; const float* rstd;
    __device__ __forceinline__ void operator()(const f32x4 (&acc)[2][2][4][2], const Unit& u, int wr, int wc, int fr, int fq) const {
        const int row0 = u.pm * BM + wr * 64 + fr; const int col0 = u.pn * HALF + wc * 32 + 8 * fq;
        float rs[2][4];
        { const f32x4 r0 = *(const f32x4*)(rstd + u.pm * BM + (wr * 16 + fr) * 8), r1 = *(const f32x4*)(rstd + u.pm * BM + (wr * 16 + fr) * 8 + 4);
#pragma unroll
          for (int m = 0; m < 4; ++m) { rs[0][m] = r0[m]; rs[1][m] = r1[m]; } }
#pragma unroll
        for (int ai = 0; ai < 2; ++ai)
#pragma unroll
            for (int m = 0; m < 4; ++m) { bf16_t* rowp = O + (size_t)(row0 + ai * HALF + m * 16) * ldc + col0; const float r = rs[ai][m];
                const f32x4 g0 = acc[ai][0][m][0] * r, g1 = acc[ai][0][m][1] * r, u0 = acc[ai][1][m][0] * r, u1 = acc[ai][1][m][1] * r;
                f32x4 v0, v1;
#pragma unroll
                for (int i = 0; i < 4; ++i) { v0[i] = silu_f(g0[i]) * u0[i]; v1[i] = silu_f(g1[i]) * u1[i]; }
                u32x4 w; w.x = cvt_pk_bf16(v0[0], v0[1]); w.y = cvt_pk_bf16(v0[2], v0[3]); w.z = cvt_pk_bf16(v1[0], v1[1]); w.w = cvt_pk_bf16(v1[2], v1[3]);
                *(u32x4*)rowp = w; }
    }
};
struct EpiBf16BlkR {
    static constexpr bool PERM = true, AFTER_DRAIN = false;
    bf16_t* O; int Mrows; const float* rstd;
    __device__ __forceinline__ void operator()(const f32x4 (&acc)[2][2][4][2], const Unit& u, int wr, int wc, int fr, int fq) const {
        const int row0 = u.pm * BM + wr * 64 + fr; const int col0 = wc * 32 + 8 * fq;
        float rs[2][4];
        { const f32x4 r0 = *(const f32x4*)(rstd + u.pm * BM + (wr * 16 + fr) * 8), r1 = *(const f32x4*)(rstd + u.pm * BM + (wr * 16 + fr) * 8 + 4);
#pragma unroll
          for (int m = 0; m < 4; ++m) { rs[0][m] = r0[m]; rs[1][m] = r1[m]; } }
#pragma unroll
        for (int ai = 0; ai < 2; ++ai)
#pragma unroll
            for (int m = 0; m < 4; ++m) { const int row = row0 + ai * HALF + m * 16; const float r = rs[ai][m];
#pragma unroll
                for (int bj = 0; bj < 2; ++bj) { const f32x4 v0 = acc[ai][bj][m][0] * r, v1 = acc[ai][bj][m][1] * r;
                    u32x4 w; w.x = cvt_pk_bf16(v0[0], v0[1]); w.y = cvt_pk_bf16(v0[2], v0[3]); w.z = cvt_pk_bf16(v1[0], v1[1]); w.w = cvt_pk_bf16(v1[2], v1[3]);
                    *(u32x4*)(O + ((size_t)u.pn * Mrows + row) * 256 + bj * HALF + col0) = w; } }
    }
};
template <bool BIN, bool BOUT> struct EpiResidT {
    static constexpr bool PERM = true, AFTER_DRAIN = false;
    const void* base; void* out; int ldc; float* rsp;
    __device__ __forceinline__ void operator()(const f32x4 (&acc)[2][2][4][2], const Unit& u, int wr, int wc, int fr, int fq) const {
        const int row0 = u.pm * BM + wr * 64 + fr; const int col0 = u.pn * BM + wc * 32 + 8 * fq;
#pragma unroll
        for (int ai = 0; ai < 2; ++ai) {
            f32x4 bs[4][2][2];
#pragma unroll
            for (int m = 0; m < 4; ++m) { const size_t off = (size_t)(row0 + ai * HALF + m * 16) * ldc + col0;
#pragma unroll
                for (int bj = 0; bj < 2; ++bj) {
                    if (BIN) { const u32x4 w = *(const u32x4*)((const bf16_t*)base + off + bj * HALF);
                        bs[m][bj][0] = (f32x4){__uint_as_float(w.x << 16), __uint_as_float(w.x & 0xffff0000u), __uint_as_float(w.y << 16), __uint_as_float(w.y & 0xffff0000u)};
                        bs[m][bj][1] = (f32x4){__uint_as_float(w.z << 16), __uint_as_float(w.z & 0xffff0000u), __uint_as_float(w.w << 16), __uint_as_float(w.w & 0xffff0000u)}; }
                    else { bs[m][bj][0] = *(const f32x4*)((const float*)base + off + bj * HALF); bs[m][bj][1] = *(const f32x4*)((const float*)base + off + bj * HALF + 4); } } }
#pragma unroll
            for (int m = 0; m < 4; ++m) { const size_t off = (size_t)(row0 + ai * HALF + m * 16) * ldc + col0; float ss = 0.f;
#pragma unroll
                for (int bj = 0; bj < 2; ++bj) { const f32x4 o0 = bs[m][bj][0] + acc[ai][bj][m][0], o1 = bs[m][bj][1] + acc[ai][bj][m][1];
                    ss += ((o0[0] * o0[0] + o0[1] * o0[1]) + (o0[2] * o0[2] + o0[3] * o0[3])) + ((o1[0] * o1[0] + o1[1] * o1[1]) + (o1[2] * o1[2] + o1[3] * o1[3]));
                    if (BOUT) { u32x4 w; w.x = cvt_pk_bf16(o0[0], o0[1]); w.y = cvt_pk_bf16(o0[2], o0[3]); w.z = cvt_pk_bf16(o1[0], o1[1]); w.w = cvt_pk_bf16(o1[2], o1[3]); *(u32x4*)((bf16_t*)out + off + bj * HALF) = w; }
                    else { *(f32x4*)((float*)out + off + bj * HALF) = o0; *(f32x4*)((float*)out + off + bj * HALF + 4) = o1; } }
                if (rsp) { ss += __shfl_xor(ss, 16); ss += __shfl_xor(ss, 32); if (fq == 0) rsp[(size_t)(row0 + ai * HALF + m * 16) * 16 + u.pn * 4 + wc] = ss; } }
            asm volatile("" ::: "memory");
        }
    }
};
}

#define LAS __attribute__((address_space(3)))
typedef unsigned short bf16;
typedef unsigned u32x4 __attribute__((ext_vector_type(4)));
typedef unsigned u32x2 __attribute__((ext_vector_type(2)));
typedef float f32x4 __attribute__((ext_vector_type(4)));
typedef float f32x2_t __attribute__((ext_vector_type(2)));

constexpr int M_ = 32768, D_ = 1024, T_ = 4096, FF_ = 2816;
constexpr int AB_N = 2816, AB_LD = 2824, CD_N = 3584, CD_LD = 3588;
constexpr float EPS_ = 1e-6f;
constexpr size_t MiB = 1u << 20;
constexpr size_t WS_CTL = 0, WS_ROPE = 1 * MiB, WS_GATE = 2 * MiB, WS_CUMF = 3 * MiB,
    WS_WABIN = 4 * MiB, WS_WABOUT = 15 * MiB, WS_WCDIN = 19 * MiB, WS_WCDOUT = 33 * MiB, WS_WGU = 37 * MiB, WS_WDN = 81 * MiB,
    WS_UY = 104 * MiB, WS_BIG = 168 * MiB, WS_ST = 392 * MiB, WS_END = 512 * MiB;
#define BIGX(row, col) ((((size_t)((col) >> 8)) * M_ + (size_t)(row)) * 256 + ((col) & 255))
constexpr size_t WS_RSTD1 = WS_CUMF + 512 * 1024;
constexpr size_t WS_RSP = WS_ST + 100 * MiB, WS_RSTD = WS_ST + 103 * MiB;
constexpr int LDS_BYTES = 147456;

struct Args { const float* in[22]; float* out; unsigned char* ws; };
typedef const Args __attribute__((address_space(4)))* ArgsP;
__device__ __forceinline__ ArgsP fresh_args() { auto p = __builtin_amdgcn_kernarg_segment_ptr(); asm volatile("" : "+s"(p)); return (ArgsP)p; }

typedef __bf16 bf16x2_hw __attribute__((ext_vector_type(2)));
__device__ __forceinline__ unsigned pk2(float lo, float hi) { f32x2_t v = {lo, hi}; bf16x2_hw b = __builtin_convertvector(v, bf16x2_hw); return __builtin_bit_cast(unsigned, b); }
__device__ __forceinline__ unsigned f2bf(float f) { return pk2(f, 0.f) & 0xffffu; }
__device__ __forceinline__ float bflo(unsigned u) { return __uint_as_float(u << 16); }
__device__ __forceinline__ float bfhi(unsigned u) { return __uint_as_float(u & 0xffff0000u); }
__device__ __forceinline__ float bf2f(bf16 v) { return __uint_as_float(((unsigned)v) << 16); }
__device__ __forceinline__ float siluf(float x) { return x * __builtin_amdgcn_rcpf(1.f + __builtin_amdgcn_exp2f(-1.4426950408889634f * x)); }
__device__ __forceinline__ float sigmf(float x) { return __builtin_amdgcn_rcpf(1.f + __builtin_amdgcn_exp2f(-1.4426950408889634f * x)); }
__device__ __forceinline__ float softplusf(float x) { return x > 20.f ? x : log1pf(expf(x)); }
__device__ __forceinline__ float logsigf(float x) { return fminf(x, 0.f) - log1pf(expf(-fabsf(x))); }
__device__ __forceinline__ float wave_sum(float v) {
#pragma unroll
    for (int o = 1; o < 64; o <<= 1) v += __shfl_xor(v, o);
    return v;
}
#define LDS_WAIT() asm volatile("s_waitcnt lgkmcnt(0)" ::: "memory")
#define LBAR() do { asm volatile("s_waitcnt lgkmcnt(0)" ::: "memory"); __builtin_amdgcn_s_barrier(); asm volatile("" ::: "memory"); } while (0)

#define XB_TMO      128
#define XB_XCNT(j)  (256  + 64 * (j))
#define XB_XSUB(j)  (1280 + 64 * (j))
#define XB_XGEN(j)  (2304 + 64 * (j))
#define XB_TOP      3328
#define XB_TOPGEN   3392
#define XCD_BAR_WORDS 3456
#define XB_SPIN_CAP (1u << 18)

__device__ __forceinline__ unsigned xb_ld(unsigned* p)              { return __hip_atomic_load(p, __ATOMIC_RELAXED, __HIP_MEMORY_SCOPE_AGENT); }
__device__ __forceinline__ unsigned xb_add(unsigned* p, unsigned v) { return __hip_atomic_fetch_add(p, v, __ATOMIC_RELAXED, __HIP_MEMORY_SCOPE_AGENT); }
__device__ __forceinline__ unsigned xb_xcc_id() { return (unsigned)__builtin_amdgcn_s_getreg((3 << 11) | 20) & 0xFu; }
#define XB_SPIN(cond, bar) do { unsigned _sp = 0; while (cond) { __builtin_amdgcn_s_sleep(1); \
    if ((++_sp & 255u) == 0u) { if (xb_ld(&(bar)[XB_TMO])) break; if (_sp > XB_SPIN_CAP) { atomicAdd(&(bar)[XB_TMO], 1u); break; } } } } while (0)

struct XcdBarrier {
    unsigned* bar; unsigned x;
    volatile LAS unsigned* st;
};

__device__ __forceinline__ XcdBarrier xcd_barrier_post(unsigned* bar, volatile LAS unsigned* st) {
    XcdBarrier b; b.bar = bar; b.x = xb_xcc_id(); b.st = st;
    if (threadIdx.x == 0) (void)xb_add(&bar[XB_XCNT(b.x)], 1u);
    return b;
}
__device__ __forceinline__ void xcd_barrier_complete(unsigned* bar, unsigned x, unsigned& nloc, unsigned& nx) {
    const unsigned G = gridDim.x * gridDim.y * gridDim.z;
    unsigned sum, cnt, mine, sp = 0u;
    for (;;) {
        sum = 0u; cnt = 0u; mine = 0u;
#pragma unroll
        for (unsigned j = 0; j < 16; ++j) { const unsigned c = xb_ld(&bar[XB_XCNT(j)]); sum += c; cnt += (c > 0u) ? 1u : 0u; mine = (j == x) ? c : mine; }
        if (sum == G) break;
        __builtin_amdgcn_s_sleep(1);
        if ((++sp & 255u) == 0u) { if (xb_ld(&bar[XB_TMO])) break; if (sp > XB_SPIN_CAP) { atomicAdd(&bar[XB_TMO], 1u); break; } }
    }
    nloc = mine > 0u ? mine : 1u; nx = cnt > 0u ? cnt : 1u;
}

__device__ __forceinline__ void xcd_barrier(const XcdBarrier& b) {
    asm volatile("s_waitcnt vmcnt(0)" ::: "memory");
    __syncthreads();
    if (threadIdx.x == 0) {
        unsigned* bar = b.bar;
        __builtin_amdgcn_s_waitcnt(0);
        unsigned nloc = b.st[0], nx = b.st[1];
        if (nloc == 0u) { xcd_barrier_complete(bar, b.x, nloc, nx); b.st[0] = nloc; b.st[1] = nx; }
        const unsigned old = xb_add(&bar[XB_XSUB(b.x)], 1u);
        const unsigned gen = old / nloc;
        if (old + 1u == (gen + 1u) * nloc) {
            __builtin_amdgcn_fence(__ATOMIC_RELEASE, "agent");
            asm volatile("s_waitcnt vmcnt(0)" ::: "memory");
            const unsigned og = xb_add(&bar[XB_TOP], 1u);
            const unsigned tg = og / nx;
            if (og + 1u == (tg + 1u) * nx) xb_add(&bar[XB_TOPGEN], 1u);
            else XB_SPIN(xb_ld(&bar[XB_TOPGEN]) == tg, bar);
            __builtin_amdgcn_fence(__ATOMIC_ACQUIRE, "agent");
            xb_add(&bar[XB_XGEN(b.x)], 1u);
            asm volatile("s_waitcnt vmcnt(0)" ::: "memory");
        } else {
            XB_SPIN(xb_ld(&bar[XB_XGEN(b.x)]) == gen, bar);
            __builtin_amdgcn_fence(__ATOMIC_ACQUIRE, "agent");
            asm volatile("s_waitcnt vmcnt(0)" ::: "memory");
        }
    }
    __syncthreads();
}

__device__ __forceinline__ void tr_matrix(const float* W, int ldw, int K, int N, bf16* WT, int mode, const float* kscale, float* scr, int gw, int NGW, int lane) {
    const int nblk = N / 32, nitems = (K / 64) * nblk;
    float nx[32];
    if (gw < nitems) { const int kb = gw / nblk, nb = gw % nblk;
#pragma unroll
        for (int i = 0; i < 32; ++i) { const int kk = 2 * i + (lane >> 5); nx[i] = W[(size_t)(64 * kb + kk) * ldw + 32 * nb + (lane & 31)]; } }
    for (int it = gw; it < nitems; it += NGW) {
        const int kb = it / nblk, nb = it % nblk, k0 = 64 * kb, n0 = 32 * nb;
#pragma unroll
        for (int i = 0; i < 32; ++i) { const int kk = 2 * i + (lane >> 5); scr[kk * 33 + (lane & 31)] = kscale ? nx[i] * kscale[k0 + kk] : nx[i]; }
        if (it + NGW < nitems) { const int kb2 = (it + NGW) / nblk, nb2 = (it + NGW) % nblk;
#pragma unroll
            for (int i = 0; i < 32; ++i) { const int kk = 2 * i + (lane >> 5); nx[i] = W[(size_t)(64 * kb2 + kk) * ldw + 32 * nb2 + (lane & 31)]; } }
        LDS_WAIT();
        const int c = lane & 7;
#pragma unroll
        for (int j = 0; j < 4; ++j) { const int nn = (lane >> 3) + 8 * j; const float* s = scr + (8 * c) * 33 + nn;
            u32x4 o; o.x = pk2(s[0 * 33], s[1 * 33]); o.y = pk2(s[2 * 33], s[3 * 33]); o.z = pk2(s[4 * 33], s[5 * 33]); o.w = pk2(s[6 * 33], s[7 * 33]);
            const int n = n0 + nn; const int r = (mode == 0) ? n : ((n >> 7) * 256 + (n & 127) + (mode == 2 ? 128 : 0));
            *(u32x4*)(WT + (size_t)r * K + k0 + 8 * c) = o; }
        LDS_WAIT();
    }
}

__device__ __forceinline__ void prologue(ArgsP a, unsigned char* lds) {
    const int tid = tid_fresh(), lane = tid & 63, wave = tid >> 6;
    const int gw = bid_fresh() * 8 + wave, NGW = gdim_fresh() * 8;
    float* scr = (float*)(lds + wave * 16384);
    unsigned char* ws = a->ws;
#pragma unroll 1
    for (int mi = 0; mi < 20; ++mi) {
        const float* W; int ldw, K, N, mode; bf16* WT; const float* ksc = nullptr;
        if (mi < 8) { const int jj = mi >> 2, t = mi & 3;
            if (t == 0)      { W = a->in[6] + (size_t)jj * D_ * AB_LD; ldw = AB_LD; K = D_; N = AB_N; WT = (bf16*)(ws + WS_WABIN) + (size_t)jj * AB_N * D_; ksc = a->in[1] + (2 * jj) * D_; }
            else if (t == 1) { W = a->in[7] + (size_t)jj * D_ * D_; ldw = D_; K = D_; N = D_; WT = (bf16*)(ws + WS_WABOUT) + (size_t)jj * D_ * D_; }
            else if (t == 2) { W = a->in[15] + (size_t)jj * D_ * CD_LD; ldw = CD_LD; K = D_; N = CD_N; WT = (bf16*)(ws + WS_WCDIN) + (size_t)jj * CD_N * D_; ksc = a->in[1] + (2 * jj + 1) * D_; }
            else             { W = a->in[16] + (size_t)jj * D_ * D_; ldw = D_; K = D_; N = D_; WT = (bf16*)(ws + WS_WCDOUT) + (size_t)jj * D_ * D_; }
            mode = 0;
        } else { const int L = (mi - 8) / 3, t = (mi - 8) % 3; bf16* gu = (bf16*)(ws + WS_WGU) + (size_t)L * 2 * FF_ * D_;
            if (t == 0)      { W = a->in[3] + (size_t)L * D_ * FF_; ldw = FF_; K = D_; N = FF_; WT = gu; mode = 1; ksc = a->in[2] + L * D_; }
            else if (t == 1) { W = a->in[4] + (size_t)L * D_ * FF_; ldw = FF_; K = D_; N = FF_; WT = gu; mode = 2; ksc = a->in[2] + L * D_; }
            else             { W = a->in[5] + (size_t)L * FF_ * D_; ldw = D_; K = FF_; N = D_; WT = (bf16*)(ws + WS_WDN) + (size_t)L * D_ * FF_; mode = 0; }
        }
        tr_matrix(W, ldw, K, N, WT, mode, ksc, scr, gw, NGW, lane);
    }
    float* rope = (float*)(ws + WS_ROPE);
    for (int idx = bid_fresh() * 512 + tid; idx < T_ * 32; idx += gdim_fresh() * 512) {
        const int t = idx >> 5, i = idx & 31;
        const float freq = powf(10000.0f, -(float)i / 31.0f);
        const float ang = (float)t * freq;
        rope[idx] = cosf(ang); rope[T_ * 32 + idx] = sinf(ang);
    }
}

__device__ __forceinline__ int rstd_slot(int row) { const int rr = row & 255; return (row & ~255) + ((((rr >> 6) & 1) * 16 + (rr & 15)) * 8 + (rr >> 7) * 4 + ((rr >> 4) & 3)); }
template <bool BIN, bool WRITE_U> __device__ __forceinline__ void norm_phase(const void* hin_, const float* gain, bf16* U, const float* Wg, int ldw, int goff, int ng, float* GATE, float* RSTD, unsigned char* lds) {
    const int tid = tid_fresh(), lane = tid & 63, wave = tid >> 6;
    float* wl = (float*)lds;
    if (ng > 0) {
        for (int idx = tid; idx < 1024 * 8; idx += 512) { const int k = idx >> 3, g = idx & 7; wl[idx] = (g < ng) ? Wg[(size_t)k * ldw + goff + g] * gain[k] : 0.f; }
    }
    __syncthreads();
    const int gw = bid_fresh() * 8 + wave, NGW = gdim_fresh() * 8;
    f32x4 gn[4];
#pragma unroll
    for (int j = 0; j < 4; ++j) gn[j] = ((const f32x4*)gain)[lane + 64 * j];
    f32x4 nxt[4], nx2[4];
#define NP_LOADROW(dst, r) do { if (BIN) { const u32x2* xr = (const u32x2*)((const bf16*)hin_ + (size_t)(r) * D_) + lane; \
            _Pragma("unroll") for (int j = 0; j < 4; ++j) { const u32x2 w = xr[64 * j]; dst[j] = (f32x4){bflo(w.x), bfhi(w.x), bflo(w.y), bfhi(w.y)}; } } \
        else { const f32x4* xr = (const f32x4*)((const float*)hin_ + (size_t)(r) * D_) + lane; _Pragma("unroll") for (int j = 0; j < 4; ++j) dst[j] = xr[64 * j]; } } while (0)
    if (gw < M_) NP_LOADROW(nxt, gw);
    if (gw + NGW < M_) NP_LOADROW(nx2, gw + NGW);
#pragma unroll 2
    for (int row = gw; row < M_; row += NGW) {
        f32x4 v[4]; float ss = 0.f;
#pragma unroll
        for (int j = 0; j < 4; ++j) { v[j] = nxt[j]; nxt[j] = nx2[j]; ss += (v[j].x * v[j].x + v[j].y * v[j].y) + (v[j].z * v[j].z + v[j].w * v[j].w); }
        if (row + 2 * NGW < M_) NP_LOADROW(nx2, row + 2 * NGW);
        const float rstd = rsqrtf(wave_sum(ss) * (1.f / D_) + EPS_);
        if (lane == 0) RSTD[rstd_slot(row)] = rstd;
        if (WRITE_U) { unsigned long long* o8 = (unsigned long long*)(U + (size_t)row * D_) + lane;
#pragma unroll
            for (int j = 0; j < 4; ++j) o8[64 * j] = (unsigned long long)pk2(v[j].x, v[j].y) | ((unsigned long long)pk2(v[j].z, v[j].w) << 32); }
        if (ng > 0) {
            float acc[8];
#pragma unroll
            for (int g = 0; g < 8; ++g) acc[g] = 0.f;
#pragma unroll
            for (int j = 0; j < 4; ++j)
#pragma unroll
                for (int e = 0; e < 4; ++e) { const int k = 4 * (lane + 64 * j) + e; const f32x4 w0 = *(const f32x4*)(wl + k * 8), w1 = *(const f32x4*)(wl + k * 8 + 4); const float x = v[j][e];
                    acc[0] += x * w0.x; acc[1] += x * w0.y; acc[2] += x * w0.z; acc[3] += x * w0.w; acc[4] += x * w1.x; acc[5] += x * w1.y; acc[6] += x * w1.z; acc[7] += x * w1.w; }
            float mine = 0.f;
#pragma unroll
            for (int g = 0; g < 8; ++g) { const float s = wave_sum(acc[g]) * rstd; if (lane == g) mine = s; }
            if (lane < 8) GATE[(size_t)row * 8 + lane] = mine;
        }
    }
}

__device__ __forceinline__ void rstd_phase(ArgsP a) {
    const float* rsp = (const float*)(a->ws + WS_RSP); float* rstd = (float*)(a->ws + WS_RSTD);
    for (int row = bid_fresh() * 512 + tid_fresh(); row < M_; row += gdim_fresh() * 512) {
        const f32x4 s0 = *(const f32x4*)(rsp + (size_t)row * 16), s1 = *(const f32x4*)(rsp + (size_t)row * 16 + 4), s2 = *(const f32x4*)(rsp + (size_t)row * 16 + 8), s3 = *(const f32x4*)(rsp + (size_t)row * 16 + 12);
        const float t = (((s0[0] + s0[1]) + (s0[2] + s0[3])) + ((s1[0] + s1[1]) + (s1[2] + s1[3]))) + (((s2[0] + s2[1]) + (s2[2] + s2[3])) + ((s3[0] + s3[1]) + (s3[2] + s3[3])));
        rstd[rstd_slot(row)] = rsqrtf(t * (1.f / D_) + EPS_); }
}

__device__ __forceinline__ void cumf_seq(ArgsP a, int j, int bh, unsigned char* lds) {
    const int tid = tid_fresh(), lane = tid & 63, wave = tid >> 6, b = bh >> 2, h = bh & 3;
    const float* GATE = (const float*)(a->ws + WS_GATE); float* CUMF = (float*)(a->ws + WS_CUMF);
    const float fb = a->in[19][j * 4 + h];
    float* tot = (float*)(lds + 140 * 1024);
    float loc[8]; float run = 0.f;
#pragma unroll
    for (int i = 0; i < 8; ++i) { run += logsigf(GATE[((size_t)b * T_ + tid * 8 + i) * 8 + h] + fb); loc[i] = run; }
    float inc = run;
#pragma unroll
    for (int o = 1; o < 64; o <<= 1) { const float n = __shfl_up(inc, o); if (lane >= o) inc += n; }
    if (lane == 63) tot[wave] = inc;
    __syncthreads();
    float off = inc - run;
    for (int w = 0; w < wave; ++w) off += tot[w];
#pragma unroll
    for (int i = 0; i < 8; ++i) CUMF[(size_t)bh * T_ + tid * 8 + i] = off + loc[i];
    __syncthreads();
}

__device__ __forceinline__ void ret_naive(ArgsP a, int j, int bh, unsigned char* lds) {
    const int b = bh >> 2, h = bh & 3, tid = tid_fresh(), lane = tid & 63, wave = tid >> 6;
    const bf16* BIG = (const bf16*)(a->ws + WS_BIG); const float* rope = (const float*)(a->ws + WS_ROPE); bf16* Y = (bf16*)(a->ws + WS_UY);
    float* qs = (float*)lds; float* ks = qs + 32 * 64; float* vs = ks + 32 * 64; float* op = vs + 32 * 128;
    const int v = tid & 127, dg = tid >> 7;
    float S[16];
#pragma unroll
    for (int d = 0; d < 16; ++d) S[d] = 0.f;
    const float gamma = 1.f - exp2f(-5.f - (float)h);
    const float* gnw = a->in[8] + (j * 4 + h) * 128;
    for (int blk = 0; blk < T_ / 32; ++blk) {
        const int t0 = blk * 32;
        __syncthreads();
#pragma unroll
        for (int r = 0; r < 2; ++r) { const int idx = tid + 512 * r, t = idx >> 5, i = idx & 31; const size_t row = (size_t)b * T_ + t0 + t;
            const unsigned qq = *(const unsigned*)(BIG + row * AB_N + h * 64 + 2 * i), kk = *(const unsigned*)(BIG + row * AB_N + 256 + h * 64 + 2 * i);
            const float c = rope[(t0 + t) * 32 + i], s = rope[T_ * 32 + (t0 + t) * 32 + i];
            const float q1 = bflo(qq), q2 = bfhi(qq), k1 = bflo(kk) * 0.125f, k2 = bfhi(kk) * 0.125f;
            qs[t * 64 + 2 * i] = q1 * c - q2 * s; qs[t * 64 + 2 * i + 1] = q1 * s + q2 * c;
            ks[t * 64 + 2 * i] = k1 * c - k2 * s; ks[t * 64 + 2 * i + 1] = k1 * s + k2 * c; }
#pragma unroll
        for (int r = 0; r < 8; ++r) { const int idx = tid + 512 * r, t = idx >> 7, c = idx & 127; vs[idx] = bf2f(BIG[((size_t)b * T_ + t0 + t) * AB_N + 512 + h * 128 + c]); }
        __syncthreads();
        for (int t = 0; t < 32; ++t) { const float vt = vs[t * 128 + v]; float o = 0.f;
#pragma unroll
            for (int d = 0; d < 16; ++d) { S[d] = S[d] * gamma + ks[t * 64 + dg * 16 + d] * vt; o += qs[t * 64 + dg * 16 + d] * S[d]; }
            op[(dg * 32 + t) * 128 + v] = o; }
        __syncthreads();
#pragma unroll
        for (int tt = 0; tt < 4; ++tt) { const int t = wave * 4 + tt; const size_t row = (size_t)b * T_ + t0 + t;
            float o0 = 0.f, o1 = 0.f;
#pragma unroll
            for (int g = 0; g < 4; ++g) { o0 += op[(g * 32 + t) * 128 + lane]; o1 += op[(g * 32 + t) * 128 + lane + 64]; }
            const float mean = wave_sum(o0 + o1) * (1.f / 128.f); const float d0 = o0 - mean, d1 = o1 - mean;
            const float rs = rsqrtf(wave_sum(d0 * d0 + d1 * d1) * (1.f / 128.f) + EPS_);
            const float g0 = bf2f(BIG[row * AB_N + 1024 + h * 128 + lane]), g1 = bf2f(BIG[row * AB_N + 1024 + h * 128 + lane + 64]);
            Y[row * D_ + h * 128 + lane] = (bf16)f2bf(d0 * rs * gnw[lane] * siluf(g0));
            Y[row * D_ + h * 128 + lane + 64] = (bf16)f2bf(d1 * rs * gnw[lane + 64] * siluf(g1)); }
    }
}

__device__ __forceinline__ void ssd_naive(ArgsP a, int j, int bh, unsigned char* lds) {
    const int b = bh >> 3, h = bh & 7, g = h >> 2, tid = tid_fresh();
    const bf16* BIG = (const bf16*)(a->ws + WS_BIG); const float* GATE = (const float*)(a->ws + WS_GATE); float* TMP = (float*)(a->ws + WS_ST);
    float* xs = (float*)lds; float* Bs = xs + 2048; float* Cs = Bs + 2048; float* dts = Cs + 2048; float* yp = dts + 64;
    const int p = tid & 63, ng = tid >> 6;
    float S[8];
#pragma unroll
    for (int i = 0; i < 8; ++i) S[i] = 0.f;
    const float* cw = a->in[9] + j * 4 * 768; const float* cb = a->in[10] + j * 768;
    const float dtb = a->in[11][j * 8 + h], A = -expf(a->in[12][j * 8 + h]), Dh = a->in[13][j * 8 + h];
    for (int blk = 0; blk < T_ / 32; ++blk) {
        const int t0 = blk * 32;
        __syncthreads();
        for (int r = 0; r < 12; ++r) { const int idx = tid + 512 * r, t = idx / 192, e = idx % 192, which = e >> 6, cc = e & 63;
            const int col = (which == 0) ? (h * 64 + cc) : (which == 1 ? 512 + g * 64 + cc : 640 + g * 64 + cc);
            float acc = cb[col];
#pragma unroll
            for (int w = 0; w < 4; ++w) { const int tt = t0 + t - 3 + w; if (tt >= 0) acc += cw[w * 768 + col] * bf2f(BIG[((size_t)b * T_ + tt) * AB_N + 2048 + col]); }
            const float val = siluf(acc);
            float* dst = (which == 0) ? xs : (which == 1 ? Bs : Cs); dst[t * 64 + cc] = val; }
        if (tid < 32) { const float dtv = softplusf(GATE[((size_t)b * T_ + t0 + tid) * 8 + h] + dtb); dts[tid] = dtv; dts[32 + tid] = expf(dtv * A); }
        __syncthreads();
        for (int t = 0; t < 32; ++t) { const float dtx = dts[t] * xs[t * 64 + p], at = dts[32 + t]; float y = 0.f;
#pragma unroll
            for (int i = 0; i < 8; ++i) { S[i] = at * S[i] + Bs[t * 64 + ng * 8 + i] * dtx; y += Cs[t * 64 + ng * 8 + i] * S[i]; }
            yp[(ng * 32 + t) * 64 + p] = y; }
        __syncthreads();
#pragma unroll
        for (int r = 0; r < 4; ++r) { const int idx = tid + 512 * r, t = idx >> 6, pp = idx & 63; const size_t row = (size_t)b * T_ + t0 + t;
            float y = Dh * xs[t * 64 + pp];
#pragma unroll
            for (int q = 0; q < 8; ++q) y += yp[(q * 32 + t) * 64 + pp];
            const float z = bf2f(BIG[row * AB_N + 1536 + h * 64 + pp]);
            TMP[row * 512 + h * 64 + pp] = y * siluf(z); }
    }
}

__device__ __forceinline__ void ssd_norm_phase(ArgsP a, int j) {
    const int tid = tid_fresh(), lane = tid & 63, wave = tid >> 6;
    const bf16* TMP = (const bf16*)(a->ws + WS_ST); bf16* Y = (bf16*)(a->ws + WS_UY);
    const float* nw = a->in[14] + j * 512;
    const int gw = bid_fresh() * 8 + wave, NGW = gdim_fresh() * 8;
#pragma unroll 4
    for (int it = gw; it < M_ * 2; it += NGW) { const int tok = it >> 1, grp = it & 1;
        const u32x2 t2 = *(const u32x2*)(TMP + (size_t)tok * 512 + grp * 256 + lane * 4);
        const f32x4 v = (f32x4){bflo(t2.x), bfhi(t2.x), bflo(t2.y), bfhi(t2.y)};
        const float rs = rsqrtf(wave_sum((v.x * v.x + v.y * v.y) + (v.z * v.z + v.w * v.w)) * (1.f / 256.f) + EPS_);
        const f32x4 w = *(const f32x4*)(nw + grp * 256 + lane * 4);
        u32x2 o; o.x = pk2(v.x * rs * w.x, v.y * rs * w.y); o.y = pk2(v.z * rs * w.z, v.w * rs * w.w);
        *(u32x2*)(Y + (size_t)tok * D_ + 512 + grp * 256 + lane * 4) = o; }
}

__device__ __forceinline__ void hg_naive(ArgsP a, int j, int bh, unsigned char* lds) {
    const int b = bh >> 2, h = bh & 3, tid = tid_fresh(), lane = tid & 63, wave = tid >> 6;
    const bf16* BIG = (const bf16*)(a->ws + WS_BIG); bf16* Y = (bf16*)(a->ws + WS_UY);
    float* qs = (float*)lds; float* fs = qs + 2048; float* ks = fs + 2048; float* is = ks + 2048; float* op = is + 2048;
    const int v = tid & 127, dg = tid >> 7;
    float S[32];
#pragma unroll
    for (int i = 0; i < 32; ++i) S[i] = 0.f;
    const float* nw = a->in[18] + j * 128;
    for (int blk = 0; blk < T_ / 16; ++blk) {
        const int t0 = blk * 16;
        __syncthreads();
#pragma unroll
        for (int r = 0; r < 4; ++r) { const int idx = tid + 512 * r, t = idx >> 7, c = idx & 127; const size_t row = (size_t)b * T_ + t0 + t;
            const float zf = bf2f(BIG[row * CD_N + 512 + h * 128 + c]);
            float lbv = 0.f; if (j == 1) { const float l0 = a->in[17][h * 128 + c], l1 = a->in[17][512 + h * 128 + c]; lbv = 1.f / (1.f + expf(l0 - l1)); }
            fs[idx] = lbv + (1.f - lbv) * sigmf(zf); ks[idx] = (1.f - lbv) * sigmf(-zf);
            qs[idx] = bf2f(BIG[row * CD_N + h * 128 + c]); is[idx] = bf2f(BIG[row * CD_N + 1024 + h * 128 + c]); }
        __syncthreads();
        for (int t = 0; t < 16; ++t) { const float iv = is[t * 128 + v]; float o = 0.f;
#pragma unroll
            for (int i = 0; i < 32; ++i) { const int d = dg * 32 + i; S[i] = fs[t * 128 + d] * S[i] + ks[t * 128 + d] * iv; o += qs[t * 128 + d] * S[i]; }
            op[(dg * 16 + t) * 128 + v] = o; }
        __syncthreads();
#pragma unroll
        for (int tt = 0; tt < 2; ++tt) { const int t = wave * 2 + tt; const size_t row = (size_t)b * T_ + t0 + t;
            float o0 = 0.f, o1 = 0.f;
#pragma unroll
            for (int g = 0; g < 4; ++g) { o0 += op[(g * 16 + t) * 128 + lane]; o1 += op[(g * 16 + t) * 128 + lane + 64]; }
            const float rs = rsqrtf(wave_sum(o0 * o0 + o1 * o1) * (1.f / 128.f) + EPS_);
            const float g0 = bf2f(BIG[row * CD_N + 1536 + h * 128 + lane]), g1 = bf2f(BIG[row * CD_N + 1536 + h * 128 + lane + 64]);
            Y[row * D_ + h * 128 + lane] = (bf16)f2bf(o0 * rs * nw[lane] * siluf(g0));
            Y[row * D_ + h * 128 + lane + 64] = (bf16)f2bf(o1 * rs * nw[lane + 64] * siluf(g1)); }
    }
}

__device__ __forceinline__ void fox_naive(ArgsP a, int j, int bh, int qb, unsigned char* lds) {
    const int b = bh >> 2, h = bh & 3, tid = tid_fresh();
    const bf16* BIG = (const bf16*)(a->ws + WS_BIG); bf16* Y = (bf16*)(a->ws + WS_UY); const float* CUMF = (const float*)(a->ws + WS_CUMF) + (size_t)bh * T_;
    float* Ks = (float*)lds; float* Vs = Ks + 64 * 128; float* Fs = Vs + 64 * 128;
    const float* qnw = a->in[20] + j * 128; const float* knw = a->in[21] + j * 128;
    const int qi = tid >> 2, part = tid & 3, tq = qb * 128 + qi;
    const size_t rowq = (size_t)b * T_ + tq;
    float q[32], o[32];
    { const u32x4* qp = (const u32x4*)(BIG + rowq * CD_N + 2048 + h * 128 + part * 32); float ss = 0.f;
#pragma unroll
      for (int i = 0; i < 4; ++i) { const u32x4 w = qp[i];
#pragma unroll
          for (int e = 0; e < 4; ++e) { q[i * 8 + 2 * e] = bflo(w[e]); q[i * 8 + 2 * e + 1] = bfhi(w[e]); } }
#pragma unroll
      for (int i = 0; i < 32; ++i) ss += q[i] * q[i];
      ss += __shfl_xor(ss, 1); ss += __shfl_xor(ss, 2);
      const float rs = rsqrtf(ss * (1.f / 128.f) + EPS_) * 0.08838834764831845f;
#pragma unroll
      for (int i = 0; i < 32; ++i) { q[i] *= rs * qnw[part * 32 + i]; o[i] = 0.f; } }
    const float Fq = CUMF[tq];
    float m = -INFINITY, l = 0.f;
    const int ntiles = 2 * qb + 2;
    for (int kt = 0; kt < ntiles; ++kt) {
        __syncthreads();
        { const int r = tid >> 3, seg = tid & 7; const size_t krow = (size_t)b * T_ + kt * 64 + r;
          const u32x4* kp = (const u32x4*)(BIG + krow * CD_N + 2560 + h * 128 + seg * 16); const u32x4* vp = (const u32x4*)(BIG + krow * CD_N + 3072 + h * 128 + seg * 16);
          float kv[16], vv[16]; float ss = 0.f;
#pragma unroll
          for (int i = 0; i < 2; ++i) { const u32x4 w = kp[i], x = vp[i];
#pragma unroll
              for (int e = 0; e < 4; ++e) { kv[i * 8 + 2 * e] = bflo(w[e]); kv[i * 8 + 2 * e + 1] = bfhi(w[e]); vv[i * 8 + 2 * e] = bflo(x[e]); vv[i * 8 + 2 * e + 1] = bfhi(x[e]); } }
#pragma unroll
          for (int i = 0; i < 16; ++i) ss += kv[i] * kv[i];
          ss += __shfl_xor(ss, 1); ss += __shfl_xor(ss, 2); ss += __shfl_xor(ss, 4);
          const float rs = rsqrtf(ss * (1.f / 128.f) + EPS_);
#pragma unroll
          for (int i = 0; i < 16; ++i) { Ks[r * 128 + seg * 16 + i] = kv[i] * rs * knw[seg * 16 + i]; Vs[r * 128 + seg * 16 + i] = vv[i]; }
          if (seg == 0) Fs[r] = CUMF[kt * 64 + r]; }
        __syncthreads();
        for (int s = 0; s < 64; ++s) {
            const int ksi = kt * 64 + s;
            const f32x4* kr = (const f32x4*)(Ks + s * 128 + part * 32); float dot = 0.f;
#pragma unroll
            for (int i = 0; i < 8; ++i) { const f32x4 w = kr[i]; dot += q[4 * i] * w.x + q[4 * i + 1] * w.y + q[4 * i + 2] * w.z + q[4 * i + 3] * w.w; }
            dot += __shfl_xor(dot, 1); dot += __shfl_xor(dot, 2);
            float logit = dot + (Fq - Fs[s]);
            if (ksi > tq) logit = -INFINITY;
            const float mn = fmaxf(m, logit); const float p = __expf(logit - mn), c = __expf(m - mn);
            m = mn; l = l * c + p;
            const f32x4* vr = (const f32x4*)(Vs + s * 128 + part * 32);
#pragma unroll
            for (int i = 0; i < 8; ++i) { const f32x4 w = vr[i]; o[4 * i] = o[4 * i] * c + p * w.x; o[4 * i + 1] = o[4 * i + 1] * c + p * w.y; o[4 * i + 2] = o[4 * i + 2] * c + p * w.z; o[4 * i + 3] = o[4 * i + 3] * c + p * w.w; }
        }
    }
    const float il = 1.f / l;
    u32x4* yp = (u32x4*)(Y + rowq * D_ + 512 + h * 128 + part * 32);
#pragma unroll
    for (int i = 0; i < 4; ++i) { u32x4 w; w.x = pk2(o[8 * i] * il, o[8 * i + 1] * il); w.y = pk2(o[8 * i + 2] * il, o[8 * i + 3] * il); w.z = pk2(o[8 * i + 4] * il, o[8 * i + 5] * il); w.w = pk2(o[8 * i + 6] * il, o[8 * i + 7] * il); yp[i] = w; }
}

constexpr size_t WS_VT = WS_ST;
__device__ __forceinline__ void fox_prep(ArgsP a, int j, unsigned char* lds) {
    const int tid = tid_fresh();
    bf16* BIG = (bf16*)(a->ws + WS_BIG); bf16* VT = (bf16*)(a->ws + WS_VT);
    const float* qnw = a->in[20] + j * 128; const float* knw = a->in[21] + j * 128;
    for (int tile = bid_fresh(); tile < 512; tile += gdim_fresh()) {
        const int b = tile >> 6, tb = tile & 63; const size_t r0 = (size_t)b * T_ + tb * 64;
        __syncthreads();
#pragma unroll
        for (int k = 0; k < 8; ++k) { const int id = tid + 512 * k, r = id >> 6, c = id & 63;
            const u32x4 w = *(const u32x4*)(BIG + BIGX(r0 + r, 3072 + c * 8));
            unsigned* dst = (unsigned*)(lds + r * 1028 + c * 16); dst[0] = w.x; dst[1] = w.y; dst[2] = w.z; dst[3] = w.w; }
#pragma unroll 2
        for (int p = 0; p < 16; ++p) { const int grp = p * 32 + (tid >> 4), sub = tid & 15; const int r = grp >> 3, which = (grp >> 2) & 1, h = grp & 3;
            bf16* ptr = BIG + BIGX(r0 + r, 2048 + which * 512 + h * 128 + sub * 8);
            const u32x4 w = *(const u32x4*)ptr; float v[8];
#pragma unroll
            for (int e = 0; e < 4; ++e) { v[2 * e] = bflo(w[e]); v[2 * e + 1] = bfhi(w[e]); }
            float ss = 0.f;
#pragma unroll
            for (int e = 0; e < 8; ++e) ss += v[e] * v[e];
            ss += __shfl_xor(ss, 1); ss += __shfl_xor(ss, 2); ss += __shfl_xor(ss, 4); ss += __shfl_xor(ss, 8);
            const float rs = rsqrtf(ss * (1.f / 128.f) + EPS_) * (which == 0 ? 0.12751743f : 1.f);
            const float* nw = (which == 0 ? qnw : knw) + sub * 8;
            u32x4 o;
#pragma unroll
            for (int e = 0; e < 4; ++e) o[e] = pk2(v[2 * e] * rs * nw[2 * e], v[2 * e + 1] * rs * nw[2 * e + 1]);
            *(u32x4*)ptr = o; }
        __syncthreads();
#pragma unroll 2
        for (int k = 0; k < 8; ++k) { const int id = tid + 512 * k, c8 = id & 7, d = (id >> 3) & 127, h = id >> 10;
            const bf16* src = (const bf16*)(lds + (8 * c8) * 1028) + h * 128 + d;
            u32x4 o;
#pragma unroll
            for (int e = 0; e < 4; ++e) { const int i0 = 2 * e, i1 = 2 * e + 1;
                const int r0 = 16 * (c8 >> 1) + 4 * (c8 & 1) + (i0 & 3) + 8 * (i0 >> 2) - 8 * c8, r1 = 16 * (c8 >> 1) + 4 * (c8 & 1) + (i1 & 3) + 8 * (i1 >> 2) - 8 * c8;
                o[e] = (unsigned)src[r0 * 514] | ((unsigned)src[r1 * 514] << 16); }
            *(u32x4*)(VT + ((size_t)(b * 4 + h) * 128 + d) * T_ + tb * 64 + c8 * 8) = o; }
    }
}

typedef short bf16x8_t __attribute__((ext_vector_type(8)));
typedef float f32x16 __attribute__((ext_vector_type(16)));
typedef short s16x4_t __attribute__((ext_vector_type(4)));
constexpr int FX_KROW = 272, FX_VROW = 144, FX_KBYTES = 64 * FX_KROW, FX_VBYTES = 128 * FX_VROW, FX_BUF = FX_KBYTES + FX_VBYTES + 256;
__device__ __forceinline__ int crow16(int r, int hi) { return (r & 3) + 8 * (r >> 2) + 4 * hi; }

__device__ __forceinline__ void fox_unit(ArgsP a, int bh, int qb, unsigned char* lds) {
    const int tid = tid_fresh(), lane = tid & 63, wave = tid >> 6, l31 = lane & 31, hi = lane >> 5;
    const int b = bh >> 2, h = bh & 3;
    const bf16* BIG = (const bf16*)(a->ws + WS_BIG); bf16* Y = (bf16*)(a->ws + WS_UY);
    const bf16* VT = (const bf16*)(a->ws + WS_VT) + (size_t)bh * 128 * T_;
    const float* CUMF = (const float*)(a->ws + WS_CUMF) + (size_t)bh * T_;
    const int tq = qb * 256 + wave * 32 + l31; const size_t rowq = (size_t)b * T_ + tq;
    const float Fref = CUMF[qb * 256];
    bf16x8_t qf[8];
#pragma unroll
    for (int ks = 0; ks < 8; ++ks) qf[ks] = *(const bf16x8_t*)(BIG + rowq * CD_N + 2048 + h * 128 + 16 * ks + 8 * hi);
    f32x16 oT[4];
#pragma unroll
    for (int d = 0; d < 4; ++d)
#pragma unroll
        for (int r = 0; r < 16; ++r) oT[d][r] = 0.f;
    float m = -INFINITY, lsum = 0.f;
    const int nt = 4 * qb + 4;
    const bf16* Kg = BIG + ((size_t)b * T_) * CD_N + 2560 + h * 128;
    const int kr0 = tid >> 4, kc = tid & 15;
    const int vd0 = tid >> 3, vc = tid & 7;
    u32x4 kreg[2], vreg[2]; float breg = 0.f;
#define FX_LOAD(kt) do { kreg[0] = *(const u32x4*)(Kg + (size_t)((kt) * 64 + kr0) * CD_N + kc * 8); kreg[1] = *(const u32x4*)(Kg + (size_t)((kt) * 64 + kr0 + 32) * CD_N + kc * 8); \
        vreg[0] = *(const u32x4*)(VT + (size_t)vd0 * T_ + (kt) * 64 + vc * 8); vreg[1] = *(const u32x4*)(VT + (size_t)(vd0 + 64) * T_ + (kt) * 64 + vc * 8); \
        if (tid < 64) breg = (Fref - CUMF[(kt) * 64 + tid]) * 1.4426950408889634f; } while (0)
#define FX_STORE(buf) do { unsigned char* bb = lds + (buf) * FX_BUF; *(u32x4*)(bb + kr0 * FX_KROW + kc * 16) = kreg[0]; *(u32x4*)(bb + (kr0 + 32) * FX_KROW + kc * 16) = kreg[1]; \
        *(u32x4*)(bb + FX_KBYTES + vd0 * FX_VROW + vc * 16) = vreg[0]; *(u32x4*)(bb + FX_KBYTES + (vd0 + 64) * FX_VROW + vc * 16) = vreg[1]; \
        if (tid < 64) ((float*)(bb + FX_KBYTES + FX_VBYTES))[tid] = breg; } while (0)
    __syncthreads();
    FX_LOAD(0); FX_STORE(0);
    __syncthreads();
    for (int kt = 0; kt < nt; ++kt) {
        const int cur = kt & 1;
        if (kt + 1 < nt) FX_LOAD(kt + 1);
        const unsigned char* bb = lds + cur * FX_BUF;
        if (kt * 64 <= qb * 256 + wave * 32 + 31) {
            f32x16 p[2];
#pragma unroll
            for (int hf = 0; hf < 2; ++hf) {
#pragma unroll
                for (int r = 0; r < 16; ++r) p[hf][r] = 0.f;
#pragma unroll
                for (int ks = 0; ks < 8; ++ks) { const bf16x8_t kf = *(const bf16x8_t*)(bb + (32 * hf + l31) * FX_KROW + (16 * ks + 8 * hi) * 2);
                    p[hf] = __builtin_amdgcn_mfma_f32_32x32x16_bf16(kf, qf[ks], p[hf], 0, 0, 0); }
            }
            const float* Bs = (const float*)(bb + FX_KBYTES + FX_VBYTES);
            const bool band = (kt >= 4 * qb);
            float mx = -INFINITY;
#pragma unroll
            for (int hf = 0; hf < 2; ++hf)
#pragma unroll
                for (int g = 0; g < 4; ++g) { const f32x4 bv = *(const f32x4*)(Bs + 32 * hf + 8 * g + 4 * hi);
#pragma unroll
                    for (int e = 0; e < 4; ++e) { const int r = 4 * g + e; float s = p[hf][r] + bv[e];
                        if (band) { const int kv = kt * 64 + 32 * hf + 8 * g + 4 * hi + e; if (kv > tq) s = -INFINITY; }
                        p[hf][r] = s; mx = fmaxf(mx, s); } }
            mx = fmaxf(mx, __shfl_xor(mx, 32));
            const float mn = fmaxf(m, mx); const float alpha = __builtin_amdgcn_exp2f(m - mn); m = mn;
            float ps = 0.f;
#pragma unroll
            for (int hf = 0; hf < 2; ++hf)
#pragma unroll
                for (int r = 0; r < 16; ++r) { const float e = __builtin_amdgcn_exp2f(p[hf][r] - mn); p[hf][r] = e; ps += e; }
            lsum = lsum * alpha + ps;
#pragma unroll
            for (int d = 0; d < 4; ++d)
#pragma unroll
                for (int r = 0; r < 16; ++r) oT[d][r] *= alpha;
            bf16x8_t pb[4];
#pragma unroll
            for (int ks2 = 0; ks2 < 4; ++ks2) { const int hf = ks2 >> 1, c = ks2 & 1; u32x4 w;
#pragma unroll
                for (int e = 0; e < 4; ++e) w[e] = pg8::cvt_pk_bf16(p[hf][8 * c + 2 * e], p[hf][8 * c + 2 * e + 1]);
                pb[ks2] = __builtin_bit_cast(bf16x8_t, w); }
            const unsigned char* vb = bb + FX_KBYTES;
#pragma unroll
            for (int d = 0; d < 4; ++d)
#pragma unroll
                for (int ks2 = 0; ks2 < 4; ++ks2) { const unsigned char* vp = vb + (32 * d + l31) * FX_VROW + (16 * ks2 + 4 * hi) * 2;
                    const s16x4_t lo = *(const s16x4_t*)vp, hi4 = *(const s16x4_t*)(vp + 16);
                    const bf16x8_t vf = (bf16x8_t){lo[0], lo[1], lo[2], lo[3], hi4[0], hi4[1], hi4[2], hi4[3]};
                    oT[d] = __builtin_amdgcn_mfma_f32_32x32x16_bf16(vf, pb[ks2], oT[d], 0, 0, 0); }
        }
        if (kt + 1 < nt) FX_STORE(cur ^ 1);
        __syncthreads();
    }
#undef FX_LOAD
#undef FX_STORE
    lsum += __shfl_xor(lsum, 32);
    const float il = 1.f / lsum;
    bf16* yp = Y + rowq * D_ + 512 + h * 128;
#pragma unroll
    for (int d = 0; d < 4; ++d)
#pragma unroll
        for (int g = 0; g < 4; ++g) { u32x2 w; w.x = pk2(oT[d][4 * g] * il, oT[d][4 * g + 1] * il); w.y = pk2(oT[d][4 * g + 2] * il, oT[d][4 * g + 3] * il);
            *(u32x2*)(yp + 32 * d + 8 * g + 4 * hi) = w; }
}

template <int MODE  >
__device__ __forceinline__ void scalar_stream(ArgsP a, int j, int bh, unsigned char* lds) {
    constexpr int DV = MODE == 0 ? 128 : 64;
    constexpr int RS = 144;
    constexpr int OFF_QN = 0, OFF_QT = 9216, OFF_KN = 18432, OFF_KOT = 27648, OFF_VT = 36864, OFF_P = OFF_VT + DV * RS, OFF_ST = OFF_P + 9216, OFF_OB = OFF_ST + DV * RS;
    constexpr int OBS = DV * 4 + 16;
    constexpr int OFF_CUM = OFF_OB + 64 * OBS, OFF_TAB = OFF_CUM + 512;
    const int tid = tid_fresh(), lane = tid & 63, wave = tid >> 6, l31 = lane & 31, hi = lane >> 5;
    const int b = MODE == 0 ? (bh >> 2) : (bh >> 3), h = MODE == 0 ? (bh & 3) : (bh & 7), g = h >> 2;
    const bf16* BIG = (const bf16*)(a->ws + WS_BIG);
    const float* rope = (const float*)(a->ws + WS_ROPE); const float* GATE = (const float*)(a->ws + WS_GATE);
    bf16* Y = (bf16*)(a->ws + WS_UY); float* TMP = (float*)(a->ws + WS_ST);
    const float LOG2E = 1.4426950408889634f;
    const float gamma = 1.f - exp2f(-5.f - (float)h), lg2gamma = log2f(gamma);
    float dtb = 0.f, Aneg = 0.f, Dh = 0.f;
    if (MODE == 1) { dtb = a->in[11][j * 8 + h]; Aneg = -expf(a->in[12][j * 8 + h]); Dh = a->in[13][j * 8 + h]; }
    const float* gnw = a->in[8] + (j * 4 + h) * 128;
    float* cumL = (float*)(lds + OFF_CUM); float* tab = (float*)(lds + OFF_TAB);
    float gw[16];
#pragma unroll
    for (int e = 0; e < 16; ++e) gw[e] = (MODE == 0) ? gnw[(tid & 7) * 16 + e] : 0.f;
    const int st = lane, sc8 = wave;
    __syncthreads();
    for (int i = tid; i < (DV * RS + 9216) / 4; i += 512) ((unsigned*)(lds + OFF_P))[i] = 0u;
    if (MODE == 1) {
        const float* cw = a->in[9] + j * 4 * 768; const float* cb = a->in[10] + j * 768;
        for (int i = tid; i < 3 * 8 * 5 * 8; i += 512) { const int e = i & 7, w = (i >> 3) % 5, c8 = (i / 40) & 7, which = i / 320;
            const int col = (which == 0 ? h * 64 : (which == 1 ? 512 + g * 64 : 640 + g * 64)) + c8 * 8 + e;
            tab[i] = (w < 4) ? cw[w * 768 + col] : cb[col]; }
    }
    f32x16 sacc;
#pragma unroll
    for (int r = 0; r < 16; ++r) sacc[r] = 0.f;
    u32x4 rq, rk, rv0, rv1; f32x4 rcs, rsn; u32x4 rx[3][4]; float rgate = 0.f;
#define ST_LOAD(c) do { const size_t row = (size_t)b * T_ + (c) * 64 + st; \
        if (MODE == 0) { rq = *(const u32x4*)(BIG + row * AB_N + h * 64 + sc8 * 8); rk = *(const u32x4*)(BIG + row * AB_N + 256 + h * 64 + sc8 * 8); \
            rcs = *(const f32x4*)(rope + ((c) * 64 + st) * 32 + sc8 * 4); rsn = *(const f32x4*)(rope + T_ * 32 + ((c) * 64 + st) * 32 + sc8 * 4); \
            rv0 = *(const u32x4*)(BIG + row * AB_N + 512 + h * 128 + sc8 * 8); rv1 = *(const u32x4*)(BIG + row * AB_N + 512 + h * 128 + (sc8 + 8) * 8); } \
        else { _Pragma("unroll") for (int wh = 0; wh < 3; ++wh) { const int col = (wh == 0 ? h * 64 : (wh == 1 ? 512 + g * 64 : 640 + g * 64)) + sc8 * 8; \
                _Pragma("unroll") for (int w = 0; w < 4; ++w) { const int tt = (c) * 64 + st - 3 + w; \
                    rx[wh][w] = (tt >= 0) ? *(const u32x4*)(BIG + ((size_t)b * T_ + tt) * AB_N + 2048 + col) : (u32x4){0u, 0u, 0u, 0u}; } } \
            rgate = GATE[((size_t)b * T_ + (c) * 64 + lane) * 8 + h]; } } while (0)
    ST_LOAD(0);
    __syncthreads();
    for (int c = 0; c < T_ / 64; ++c) {
        if (MODE == 0) {
            float q[8], k[8];
#pragma unroll
            for (int e = 0; e < 4; ++e) { const float q1 = bflo(rq[e]), q2 = bfhi(rq[e]), k1 = bflo(rk[e]) * 0.125f, k2 = bfhi(rk[e]) * 0.125f; const float cs = rcs[e], sn = rsn[e];
                q[2 * e] = q1 * cs - q2 * sn; q[2 * e + 1] = q1 * sn + q2 * cs; k[2 * e] = k1 * cs - k2 * sn; k[2 * e + 1] = k1 * sn + k2 * cs; }
            const float gi = __builtin_amdgcn_exp2f((float)(st + 1) * lg2gamma), go = __builtin_amdgcn_exp2f((float)(63 - st) * lg2gamma);
            u32x4 w0, w1, w2;
#pragma unroll
            for (int e = 0; e < 4; ++e) { w0[e] = pk2(q[2 * e], q[2 * e + 1]); w1[e] = pk2(q[2 * e] * gi, q[2 * e + 1] * gi); w2[e] = pk2(k[2 * e], k[2 * e + 1]); }
            *(u32x4*)(lds + OFF_QN + st * RS + sc8 * 16) = w0; *(u32x4*)(lds + OFF_QT + st * RS + sc8 * 16) = w1; *(u32x4*)(lds + OFF_KN + st * RS + sc8 * 16) = w2;
#pragma unroll
            for (int e = 0; e < 8; ++e) *(bf16*)(lds + OFF_KOT + (sc8 * 8 + e) * RS + st * 2) = (bf16)f2bf(k[e] * go);
#pragma unroll
            for (int e = 0; e < 4; ++e) { *(bf16*)(lds + OFF_VT + (sc8 * 8 + 2 * e) * RS + st * 2) = (bf16)(rv0[e] & 0xffffu); *(bf16*)(lds + OFF_VT + (sc8 * 8 + 2 * e + 1) * RS + st * 2) = (bf16)(rv0[e] >> 16);
                *(bf16*)(lds + OFF_VT + ((sc8 + 8) * 8 + 2 * e) * RS + st * 2) = (bf16)(rv1[e] & 0xffffu); *(bf16*)(lds + OFF_VT + ((sc8 + 8) * 8 + 2 * e + 1) * RS + st * 2) = (bf16)(rv1[e] >> 16); }
        } else {
            const float dtv = softplusf(rgate + dtb); float cumv = dtv * Aneg;
#pragma unroll
            for (int o = 1; o < 64; o <<= 1) { const float n = __shfl_up(cumv, o); if (lane >= o) cumv += n; }
            const float cum_t = cumv, dt_t = dtv, cum_last = __shfl(cumv, 63);
            if (wave == 0) { cumL[lane] = cumv; if (lane == 63) cumL[64] = cumv; }
            float val[3][8];
#pragma unroll
            for (int wh = 0; wh < 3; ++wh) { const float* tb = tab + (wh * 8 + sc8) * 40;
#pragma unroll
                for (int e = 0; e < 8; ++e) val[wh][e] = tb[32 + e];
#pragma unroll
                for (int w = 0; w < 4; ++w)
#pragma unroll
                    for (int e = 0; e < 4; ++e) { val[wh][2 * e] += tb[w * 8 + 2 * e] * bflo(rx[wh][w][e]); val[wh][2 * e + 1] += tb[w * 8 + 2 * e + 1] * bfhi(rx[wh][w][e]); }
#pragma unroll
                for (int e = 0; e < 8; ++e) val[wh][e] = siluf(val[wh][e]); }
            const float ei = __expf(cum_t), eo = dt_t * __expf(cum_last - cum_t);
            u32x4 w0, w1, w2;
#pragma unroll
            for (int e = 0; e < 4; ++e) { w0[e] = pk2(val[2][2 * e], val[2][2 * e + 1]); w1[e] = pk2(val[2][2 * e] * ei, val[2][2 * e + 1] * ei); w2[e] = pk2(val[1][2 * e] * dt_t, val[1][2 * e + 1] * dt_t); }
            *(u32x4*)(lds + OFF_QN + st * RS + sc8 * 16) = w0; *(u32x4*)(lds + OFF_QT + st * RS + sc8 * 16) = w1; *(u32x4*)(lds + OFF_KN + st * RS + sc8 * 16) = w2;
#pragma unroll
            for (int e = 0; e < 8; ++e) { *(bf16*)(lds + OFF_KOT + (sc8 * 8 + e) * RS + st * 2) = (bf16)f2bf(val[1][e] * eo); *(bf16*)(lds + OFF_VT + (sc8 * 8 + e) * RS + st * 2) = (bf16)f2bf(val[0][e]); }
        }
        LBAR();
        if (c + 1 < T_ / 64) ST_LOAD(c + 1);
        unsigned rg[8];
        u32x4 rgA, rgB;
        if (MODE == 0) { const bf16* gp = BIG + ((size_t)b * T_ + c * 64 + (tid >> 3)) * AB_N + 1024 + h * 128 + (tid & 7) * 16; rgA = *(const u32x4*)gp; rgB = *(const u32x4*)(gp + 8);
        } else {
#pragma unroll
            for (int k = 0; k < 4; ++k) { const int idx = tid + 512 * k; rg[k] = *(const unsigned*)(BIG + ((size_t)b * T_ + c * 64 + (idx >> 5)) * AB_N + 1536 + h * 64 + 2 * (idx & 31)); }
        }
        if (wave < 3) {
            const int jb = (wave == 2) ? 1 : 0, ib = (wave == 0) ? 0 : 1;
            f32x16 acc;
#pragma unroll
            for (int r = 0; r < 16; ++r) acc[r] = 0.f;
#pragma unroll
            for (int s = 0; s < 4; ++s) { const bf16x8_t af = *(const bf16x8_t*)(lds + OFF_KN + (32 * jb + l31) * RS + (16 * s + 8 * hi) * 2), bfr = *(const bf16x8_t*)(lds + OFF_QN + (32 * ib + l31) * RS + (16 * s + 8 * hi) * 2);
                acc = __builtin_amdgcn_mfma_f32_32x32x16_bf16(af, bfr, acc, 0, 0, 0); }
            const int i = 32 * ib + l31; const float cum_i = (MODE == 1) ? cumL[i] : 0.f;
#pragma unroll
            for (int g4 = 0; g4 < 4; ++g4) { const int j0 = 32 * jb + 8 * g4 + 4 * hi; float v[4];
                f32x4 cj = (f32x4){0.f, 0.f, 0.f, 0.f}; if (MODE == 1) cj = *(const f32x4*)(cumL + j0);
#pragma unroll
                for (int e = 0; e < 4; ++e) { const int jj = j0 + e; const float ex = (MODE == 0) ? (float)(i - jj) * lg2gamma : (cum_i - cj[e]) * LOG2E;
                    v[e] = (jj <= i) ? acc[4 * g4 + e] * __builtin_amdgcn_exp2f(ex) : 0.f; }
                u32x2 w; w.x = pk2(v[0], v[1]); w.y = pk2(v[2], v[3]);
                *(u32x2*)(lds + OFF_P + i * RS + j0 * 2) = w; }
        }
        LBAR();
        if (MODE == 0 || wave < 4) {
            const int ib = wave & 1, vb = (wave >> 1) & 3;
            f32x16 acc;
#pragma unroll
            for (int r = 0; r < 16; ++r) acc[r] = 0.f;
#pragma unroll
            for (int s = 0; s < 4; ++s) { const bf16x8_t af = *(const bf16x8_t*)(lds + OFF_P + (32 * ib + l31) * RS + (16 * s + 8 * hi) * 2), bfr = *(const bf16x8_t*)(lds + OFF_VT + (32 * vb + l31) * RS + (16 * s + 8 * hi) * 2);
                acc = __builtin_amdgcn_mfma_f32_32x32x16_bf16(af, bfr, acc, 0, 0, 0); }
#pragma unroll
            for (int s = 0; s < 4; ++s) { const bf16x8_t af = *(const bf16x8_t*)(lds + OFF_QT + (32 * ib + l31) * RS + (16 * s + 8 * hi) * 2), bfr = *(const bf16x8_t*)(lds + OFF_ST + (32 * vb + l31) * RS + (16 * s + 8 * hi) * 2);
                acc = __builtin_amdgcn_mfma_f32_32x32x16_bf16(af, bfr, acc, 0, 0, 0); }
            if (MODE == 1) {
#pragma unroll
                for (int g4 = 0; g4 < 4; ++g4) { const u32x2 xv = *(const u32x2*)(lds + OFF_VT + (32 * vb + l31) * RS + (32 * ib + 8 * g4 + 4 * hi) * 2);
                    acc[4 * g4] += Dh * bflo(xv.x); acc[4 * g4 + 1] += Dh * bfhi(xv.x); acc[4 * g4 + 2] += Dh * bflo(xv.y); acc[4 * g4 + 3] += Dh * bfhi(xv.y); }
            }
#pragma unroll
            for (int r = 0; r < 16; ++r) *(float*)(lds + OFF_OB + (32 * ib + crow16(r, hi)) * OBS + (32 * vb + l31) * 4) = acc[r];
        }
        const int sdb = wave & 1, svb = (MODE == 0) ? (wave >> 1) : ((wave >> 1) & 1);
        if (MODE == 0 || wave >= 4) {
            const float alast = (MODE == 0) ? exp2f(64.f * lg2gamma) : __expf(cumL[64]);
#pragma unroll
            for (int r = 0; r < 16; ++r) sacc[r] *= alast;
#pragma unroll
            for (int s = 0; s < 4; ++s) { const bf16x8_t af = *(const bf16x8_t*)(lds + OFF_KOT + (32 * sdb + l31) * RS + (16 * s + 8 * hi) * 2), bfr = *(const bf16x8_t*)(lds + OFF_VT + (32 * svb + l31) * RS + (16 * s + 8 * hi) * 2);
                sacc = __builtin_amdgcn_mfma_f32_32x32x16_bf16(af, bfr, sacc, 0, 0, 0); }
        }
        LBAR();
        if (MODE == 0 || wave >= 4) {
#pragma unroll
            for (int g4 = 0; g4 < 4; ++g4) { u32x2 w; w.x = pk2(sacc[4 * g4], sacc[4 * g4 + 1]); w.y = pk2(sacc[4 * g4 + 2], sacc[4 * g4 + 3]);
                *(u32x2*)(lds + OFF_ST + (32 * svb + l31) * RS + (32 * sdb + 8 * g4 + 4 * hi) * 2) = w; }
        }
        if (MODE == 0) {
            const int i = tid >> 3, part = tid & 7; const size_t row = (size_t)b * T_ + c * 64 + i;
            float o[16]; float sm = 0.f, sq = 0.f;
#pragma unroll
            for (int q4 = 0; q4 < 4; ++q4) { const f32x4 v = *(const f32x4*)(lds + OFF_OB + i * OBS + part * 64 + q4 * 16);
                o[4 * q4] = v.x; o[4 * q4 + 1] = v.y; o[4 * q4 + 2] = v.z; o[4 * q4 + 3] = v.w; sm += (v.x + v.y) + (v.z + v.w); sq += (v.x * v.x + v.y * v.y) + (v.z * v.z + v.w * v.w); }
            sm += __shfl_xor(sm, 1); sq += __shfl_xor(sq, 1); sm += __shfl_xor(sm, 2); sq += __shfl_xor(sq, 2); sm += __shfl_xor(sm, 4); sq += __shfl_xor(sq, 4);
            const float mean = sm * (1.f / 128.f); const float rs = rsqrtf(fmaxf(sq * (1.f / 128.f) - mean * mean, 0.f) + EPS_);
            u32x4 w0, w1;
#pragma unroll
            for (int e = 0; e < 4; ++e) { w0[e] = pk2((o[2 * e] - mean) * rs * gw[2 * e] * siluf(bflo(rgA[e])), (o[2 * e + 1] - mean) * rs * gw[2 * e + 1] * siluf(bfhi(rgA[e])));
                w1[e] = pk2((o[8 + 2 * e] - mean) * rs * gw[8 + 2 * e] * siluf(bflo(rgB[e])), (o[8 + 2 * e + 1] - mean) * rs * gw[8 + 2 * e + 1] * siluf(bfhi(rgB[e]))); }
            *(u32x4*)(Y + row * D_ + h * 128 + part * 16) = w0; *(u32x4*)(Y + row * D_ + h * 128 + part * 16 + 8) = w1;
        } else {
#pragma unroll
            for (int k = 0; k < 4; ++k) { const int idx = tid + 512 * k, i = idx >> 5, p = 2 * (idx & 31); const size_t row = (size_t)b * T_ + c * 64 + i;
                const f32x2_t y = *(const f32x2_t*)(lds + OFF_OB + i * OBS + p * 4);
                f32x2_t o; o.x = y.x * siluf(bflo(rg[k])); o.y = y.y * siluf(bfhi(rg[k]));
                *(f32x2_t*)(TMP + row * 512 + h * 64 + p) = o; }
        }
    }
#undef ST_LOAD
    __syncthreads();
}

__device__ __forceinline__ void hg_stream(ArgsP a, int j, int bh, unsigned char* lds) {
    constexpr int RS = 144, RW = 272;
    constexpr int OFF_QX = 0, OFF_KV = 17408, OFF_OB = 0  , OFF_QT = 43520, OFF_KOT = 60928, OFF_VT = 79360, OFF_P = 97792, OFF_ST = 107008, OFF_AL = 141824;
    constexpr int OBS = 528;
    const int tid = tid_fresh(), lane = tid & 63, wave = tid >> 6, l31 = lane & 31, hi = lane >> 5;
    const int b = bh >> 2, h = bh & 3;
    const bf16* BIG = (const bf16*)(a->ws + WS_BIG); bf16* Y = (bf16*)(a->ws + WS_UY);
    const float* nw = a->in[18] + j * 128;
    const int c8 = wave * 2 + hi, tseg = l31;
    float lbv[8];
#pragma unroll
    for (int e = 0; e < 8; ++e) { lbv[e] = 0.f; if (j == 1) { const float l0 = a->in[17][h * 128 + c8 * 8 + e], l1 = a->in[17][512 + h * 128 + c8 * 8 + e]; lbv[e] = 1.f / (1.f + expf(l0 - l1)); } }
    float* alL = (float*)(lds + OFF_AL);
    float gw[16];
#pragma unroll
    for (int e = 0; e < 16; ++e) gw[e] = nw[(tid & 7) * 16 + e];
    __syncthreads();
    for (int i = tid; i < (9216 + 34816) / 4; i += 512) ((unsigned*)(lds + OFF_P))[i] = 0u;
    f32x16 sacc[2];
#pragma unroll
    for (int t = 0; t < 2; ++t)
#pragma unroll
        for (int r = 0; r < 16; ++r) sacc[t][r] = 0.f;
    u32x4 rz[2], rq[2], rv[2];
#define HG_LOAD(c) do { _Pragma("unroll") for (int rr = 0; rr < 2; ++rr) { const size_t row = (size_t)b * T_ + (c) * 64 + 2 * tseg + rr; const bf16* p = BIG + row * CD_N + h * 128 + c8 * 8; \
        rq[rr] = *(const u32x4*)p; rz[rr] = *(const u32x4*)(p + 512); rv[rr] = *(const u32x4*)(p + 1024); } } while (0)
    HG_LOAD(0);
    __syncthreads();
    for (int c = 0; c < T_ / 64; ++c) {
        {
            float lf[2][8], kk[2][8], qv[2][8], cum[2][8];
#pragma unroll
            for (int rr = 0; rr < 2; ++rr)
#pragma unroll
                for (int e = 0; e < 4; ++e) {
                    const float z0 = fmaxf(bflo(rz[rr][e]), -60.f), z1 = fmaxf(bfhi(rz[rr][e]), -60.f);
                    const float e0 = __builtin_amdgcn_exp2f(-1.4426950408889634f * z0), e1 = __builtin_amdgcn_exp2f(-1.4426950408889634f * z1);
                    const float s0 = __builtin_amdgcn_rcpf(1.f + e0), s1 = __builtin_amdgcn_rcpf(1.f + e1);
                    const float f0 = lbv[2 * e] + (1.f - lbv[2 * e]) * s0, f1 = lbv[2 * e + 1] + (1.f - lbv[2 * e + 1]) * s1;
                    lf[rr][2 * e] = __logf(f0); lf[rr][2 * e + 1] = __logf(f1);
                    kk[rr][2 * e] = (1.f - lbv[2 * e]) * (e0 * s0); kk[rr][2 * e + 1] = (1.f - lbv[2 * e + 1]) * (e1 * s1);
                    qv[rr][2 * e] = bflo(rq[rr][e]); qv[rr][2 * e + 1] = bfhi(rq[rr][e]); }
            float ref1[8], clast[8];
#pragma unroll
            for (int e = 0; e < 8; ++e) {
                float s = lf[0][e] + lf[1][e];
#pragma unroll
                for (int o = 1; o < 32; o <<= 1) { const float n = __shfl_up(s, o, 32); if (tseg >= o) s += n; }
                cum[1][e] = s; cum[0][e] = s - lf[1][e];
                ref1[e] = __shfl(s, 15, 32); clast[e] = __shfl(s, 31, 32); }
            const bool blk1 = tseg >= 16;
            u32x4 wqx[2], wqt[2], wk0[2], wk1[2];
            float ko[2][8];
#pragma unroll
            for (int rr = 0; rr < 2; ++rr) {
                float qx[8], qt[8], k0[8], k1[8];
#pragma unroll
                for (int e = 0; e < 8; ++e) { const float cm = cum[rr][e]; const float rf = blk1 ? ref1[e] : 0.f;
                    qx[e] = qv[rr][e] * __expf(cm - rf); qt[e] = qv[rr][e] * __expf(cm);
                    k0[e] = kk[rr][e] * __expf(rf - cm);
                    k1[e] = kk[rr][e] * __expf(ref1[e] - cm);
                    ko[rr][e] = kk[rr][e] * __expf(clast[e] - cm); }
#pragma unroll
                for (int e = 0; e < 4; ++e) { wqx[rr][e] = pk2(qx[2 * e], qx[2 * e + 1]); wqt[rr][e] = pk2(qt[2 * e], qt[2 * e + 1]); wk0[rr][e] = pk2(k0[2 * e], k0[2 * e + 1]); wk1[rr][e] = pk2(k1[2 * e], k1[2 * e + 1]); }
            }
#pragma unroll
            for (int rr = 0; rr < 2; ++rr) { const int t = 2 * tseg + rr;
                *(u32x4*)(lds + OFF_QX + t * RW + c8 * 16) = wqx[rr]; *(u32x4*)(lds + OFF_QT + t * RW + c8 * 16) = wqt[rr];
                if (!blk1) { *(u32x4*)(lds + OFF_KV + t * RW + c8 * 16) = wk0[rr]; *(u32x4*)(lds + OFF_KV + 8704 + t * RW + c8 * 16) = wk1[rr]; }
                else       { *(u32x4*)(lds + OFF_KV + 2 * 8704 + (t - 32) * RW + c8 * 16) = wk0[rr]; } }
#pragma unroll
            for (int e = 0; e < 8; ++e) { *(unsigned*)(lds + OFF_KOT + (c8 * 8 + e) * RS + tseg * 4) = pk2(ko[0][e], ko[1][e]); }
#pragma unroll
            for (int e = 0; e < 4; ++e) { *(unsigned*)(lds + OFF_VT + (c8 * 8 + 2 * e) * RS + tseg * 4) = (rv[0][e] & 0xffffu) | (rv[1][e] << 16);
                *(unsigned*)(lds + OFF_VT + (c8 * 8 + 2 * e + 1) * RS + tseg * 4) = (rv[0][e] >> 16) | (rv[1][e] & 0xffff0000u); }
            if (tseg == 31) {
#pragma unroll
                for (int e = 0; e < 8; ++e) alL[c8 * 8 + e] = __expf(clast[e]); }
        }
        LBAR();
        if (c + 1 < T_ / 64) HG_LOAD(c + 1);
        u32x4 rgA, rgB;
        { const bf16* gp = BIG + ((size_t)b * T_ + c * 64 + (tid >> 3)) * CD_N + 1536 + h * 128 + (tid & 7) * 16; rgA = *(const u32x4*)gp; rgB = *(const u32x4*)(gp + 8); }
        if (wave < 3) {
            const int ib = (wave == 0) ? 0 : 1, jb = (wave == 2) ? 1 : 0;
            f32x16 acc;
#pragma unroll
            for (int r = 0; r < 16; ++r) acc[r] = 0.f;
#pragma unroll
            for (int s = 0; s < 8; ++s) { const bf16x8_t af = *(const bf16x8_t*)(lds + OFF_KV + wave * 8704 + l31 * RW + (16 * s + 8 * hi) * 2), bfr = *(const bf16x8_t*)(lds + OFF_QX + (32 * ib + l31) * RW + (16 * s + 8 * hi) * 2);
                acc = __builtin_amdgcn_mfma_f32_32x32x16_bf16(af, bfr, acc, 0, 0, 0); }
            const int i = 32 * ib + l31;
#pragma unroll
            for (int g4 = 0; g4 < 4; ++g4) { const int j0 = 32 * jb + 8 * g4 + 4 * hi; float v[4];
#pragma unroll
                for (int e = 0; e < 4; ++e) v[e] = (j0 + e <= i) ? acc[4 * g4 + e] : 0.f;
                u32x2 w; w.x = pk2(v[0], v[1]); w.y = pk2(v[2], v[3]);
                *(u32x2*)(lds + OFF_P + i * RS + j0 * 2) = w; }
        }
        LBAR();
        {
            const int ib = wave & 1, vb = wave >> 1;
            f32x16 acc;
#pragma unroll
            for (int r = 0; r < 16; ++r) acc[r] = 0.f;
#pragma unroll
            for (int s = 0; s < 4; ++s) { const bf16x8_t af = *(const bf16x8_t*)(lds + OFF_P + (32 * ib + l31) * RS + (16 * s + 8 * hi) * 2), bfr = *(const bf16x8_t*)(lds + OFF_VT + (32 * vb + l31) * RS + (16 * s + 8 * hi) * 2);
                acc = __builtin_amdgcn_mfma_f32_32x32x16_bf16(af, bfr, acc, 0, 0, 0); }
#pragma unroll
            for (int s = 0; s < 8; ++s) { const bf16x8_t af = *(const bf16x8_t*)(lds + OFF_QT + (32 * ib + l31) * RW + (16 * s + 8 * hi) * 2), bfr = *(const bf16x8_t*)(lds + OFF_ST + (32 * vb + l31) * RW + (16 * s + 8 * hi) * 2);
                acc = __builtin_amdgcn_mfma_f32_32x32x16_bf16(af, bfr, acc, 0, 0, 0); }
#pragma unroll
            for (int r = 0; r < 16; ++r) *(float*)(lds + OFF_OB + (32 * ib + crow16(r, hi)) * OBS + (32 * vb + l31) * 4) = acc[r];
        }
        const int svb = wave >> 1;
#pragma unroll
        for (int t = 0; t < 2; ++t) { const int db = 2 * (wave & 1) + t;
#pragma unroll
            for (int g4 = 0; g4 < 4; ++g4) { const f32x4 al = *(const f32x4*)(alL + 32 * db + 8 * g4 + 4 * hi);
#pragma unroll
                for (int e = 0; e < 4; ++e) sacc[t][4 * g4 + e] *= al[e]; }
#pragma unroll
            for (int s = 0; s < 4; ++s) { const bf16x8_t af = *(const bf16x8_t*)(lds + OFF_KOT + (32 * db + l31) * RS + (16 * s + 8 * hi) * 2), bfr = *(const bf16x8_t*)(lds + OFF_VT + (32 * svb + l31) * RS + (16 * s + 8 * hi) * 2);
                sacc[t] = __builtin_amdgcn_mfma_f32_32x32x16_bf16(af, bfr, sacc[t], 0, 0, 0); } }
        LBAR();
#pragma unroll
        for (int t = 0; t < 2; ++t) { const int db = 2 * (wave & 1) + t;
#pragma unroll
            for (int g4 = 0; g4 < 4; ++g4) { u32x2 w; w.x = pk2(sacc[t][4 * g4], sacc[t][4 * g4 + 1]); w.y = pk2(sacc[t][4 * g4 + 2], sacc[t][4 * g4 + 3]);
                *(u32x2*)(lds + OFF_ST + (32 * svb + l31) * RW + (32 * db + 8 * g4 + 4 * hi) * 2) = w; } }
        { const int i = tid >> 3, part = tid & 7; const size_t row = (size_t)b * T_ + c * 64 + i;
            float o[16]; float sq = 0.f;
#pragma unroll
            for (int q4 = 0; q4 < 4; ++q4) { const f32x4 v = *(const f32x4*)(lds + OFF_OB + i * OBS + part * 64 + q4 * 16);
                o[4 * q4] = v.x; o[4 * q4 + 1] = v.y; o[4 * q4 + 2] = v.z; o[4 * q4 + 3] = v.w; sq += (v.x * v.x + v.y * v.y) + (v.z * v.z + v.w * v.w); }
            sq += __shfl_xor(sq, 1); sq += __shfl_xor(sq, 2); sq += __shfl_xor(sq, 4);
            const float rs = rsqrtf(sq * (1.f / 128.f) + EPS_);
            u32x4 w0, w1;
#pragma unroll
            for (int e = 0; e < 4; ++e) { w0[e] = pk2(o[2 * e] * rs * gw[2 * e] * siluf(bflo(rgA[e])), o[2 * e + 1] * rs * gw[2 * e + 1] * siluf(bfhi(rgA[e])));
                w1[e] = pk2(o[8 + 2 * e] * rs * gw[8 + 2 * e] * siluf(bflo(rgB[e])), o[8 + 2 * e + 1] * rs * gw[8 + 2 * e + 1] * siluf(bfhi(rgB[e]))); }
            *(u32x4*)(Y + row * D_ + h * 128 + part * 16) = w0; *(u32x4*)(Y + row * D_ + h * 128 + part * 16 + 8) = w1; }
        LBAR();
    }
#undef HG_LOAD
}

__device__ __forceinline__ void fox_unit2(ArgsP a, int bh, int qb, unsigned char* lds) {
    const int tid = tid_fresh(), lane = tid & 63, wave = tid >> 6, l31 = lane & 31, hi = lane >> 5;
    const int b = bh >> 2, h = bh & 3;
    const bf16* BIG = (const bf16*)(a->ws + WS_BIG); bf16* Y = (bf16*)(a->ws + WS_UY);
    const bf16* VT = (const bf16*)(a->ws + WS_VT) + (size_t)bh * 128 * T_;
    const float* CUMF = (const float*)(a->ws + WS_CUMF) + (size_t)bh * T_;
    const int tq = qb * 256 + wave * 32 + l31; const size_t rowq = (size_t)b * T_ + tq;
    const float Fref = CUMF[qb * 256];
    bf16x8_t qf[8];
#pragma unroll
    for (int ks = 0; ks < 8; ++ks) qf[ks] = *(const bf16x8_t*)(BIG + BIGX(rowq, 2048 + h * 128 + 16 * ks + 8 * hi));
    f32x16 oT[4];
#pragma unroll
    for (int d = 0; d < 4; ++d)
#pragma unroll
        for (int r = 0; r < 16; ++r) oT[d][r] = 0.f;
    float m = -INFINITY, lsum = 0.f, alpha = 1.f;
    const int nt = 4 * qb + 4;
    const bf16* Kg = BIG + BIGX((size_t)b * T_, 2560 + h * 128);
    const int kr0 = tid >> 4, kc = tid & 15, vd0 = tid >> 3, vc = tid & 7;
    u32x4 kreg[2], vreg[2]; float breg;
#define FY_LOAD(kt) do { kreg[0] = *(const u32x4*)(Kg + (size_t)((kt) * 64 + kr0) * 256 + kc * 8); kreg[1] = *(const u32x4*)(Kg + (size_t)((kt) * 64 + kr0 + 32) * 256 + kc * 8); \
        vreg[0] = *(const u32x4*)(VT + (size_t)vd0 * T_ + (kt) * 64 + vc * 8); vreg[1] = *(const u32x4*)(VT + (size_t)(vd0 + 64) * T_ + (kt) * 64 + vc * 8); \
        breg = (Fref - CUMF[(kt) * 64 + lane]) * 1.4426950408889634f; } while (0)
#define FY_STORE(bb) do { *(u32x4*)((bb) + kr0 * FX_KROW + kc * 16) = kreg[0]; *(u32x4*)((bb) + (kr0 + 32) * FX_KROW + kc * 16) = kreg[1]; \
        *(u32x4*)((bb) + FX_KBYTES + vd0 * FX_VROW + vc * 16) = vreg[0]; *(u32x4*)((bb) + FX_KBYTES + (vd0 + 64) * FX_VROW + vc * 16) = vreg[1]; \
        ((float*)((bb) + FX_KBYTES + FX_VBYTES))[lane] = breg; } while (0)
#define FY_QK(S, bb) do { _Pragma("unroll") for (int hf = 0; hf < 2; ++hf) { _Pragma("unroll") for (int r = 0; r < 16; ++r) S[hf][r] = 0.f; \
        _Pragma("unroll") for (int ks = 0; ks < 8; ++ks) { const bf16x8_t kf = *(const bf16x8_t*)((bb) + (32 * hf + l31) * FX_KROW + (16 * ks + 8 * hi) * 2); \
            S[hf] = __builtin_amdgcn_mfma_f32_32x32x16_bf16(kf, qf[ks], S[hf], 0, 0, 0); } } } while (0)
#define FY_BMAX(S, bb, kt, MASK) do { const float* Bs = (const float*)((bb) + FX_KBYTES + FX_VBYTES); float mx = -INFINITY; \
        _Pragma("unroll") for (int hf = 0; hf < 2; ++hf) _Pragma("unroll") for (int g = 0; g < 4; ++g) { const f32x4 bv = *(const f32x4*)(Bs + 32 * hf + 8 * g + 4 * hi); \
            _Pragma("unroll") for (int e = 0; e < 4; ++e) { const int r = 4 * g + e; float s = S[hf][r] + bv[e]; \
                if (MASK) { const int kv = (kt) * 64 + 32 * hf + 8 * g + 4 * hi + e; if (kv > tq) s = -INFINITY; } \
                S[hf][r] = s; mx = fmaxf(mx, s); } } \
        mx = fmaxf(mx, __shfl_xor(mx, 32)); const float mn = fmaxf(m, mx); alpha = __builtin_amdgcn_exp2f(m - mn); m = mn; } while (0)
#define FY_EXP(S) do { float ps = 0.f; \
        _Pragma("unroll") for (int hf = 0; hf < 2; ++hf) _Pragma("unroll") for (int r = 0; r < 16; ++r) { const float e = __builtin_amdgcn_exp2f(S[hf][r] - m); S[hf][r] = e; ps += e; } \
        lsum = lsum * alpha + ps; \
        _Pragma("unroll") for (int d = 0; d < 4; ++d) _Pragma("unroll") for (int r = 0; r < 16; ++r) oT[d][r] *= alpha; \
        _Pragma("unroll") for (int ks2 = 0; ks2 < 4; ++ks2) { const int hf = ks2 >> 1, c = ks2 & 1; u32x4 w; \
            _Pragma("unroll") for (int e = 0; e < 4; ++e) w[e] = pk2(S[hf][8 * c + 2 * e], S[hf][8 * c + 2 * e + 1]); \
            pb[ks2] = __builtin_bit_cast(bf16x8_t, w); } } while (0)
#define FY_PV(bb) do { const unsigned char* vb = (bb) + FX_KBYTES; \
        _Pragma("unroll") for (int d = 0; d < 4; ++d) _Pragma("unroll") for (int ks2 = 0; ks2 < 4; ++ks2) { const unsigned char* vp = vb + (32 * d + l31) * FX_VROW + (16 * ks2 + 8 * hi) * 2; \
            const bf16x8_t vf = *(const bf16x8_t*)vp; \
            oT[d] = __builtin_amdgcn_mfma_f32_32x32x16_bf16(vf, pb[ks2], oT[d], 0, 0, 0); } } while (0)
    __syncthreads();
    FY_LOAD(0); FY_STORE(lds);
    FY_LOAD(1); FY_STORE(lds + FX_BUF);
    __syncthreads();
    f32x16 sc[2], sn[2]; bf16x8_t pb[4];
    FY_QK(sc, lds);
    FY_BMAX(sc, lds, 0, true);
    int bc = 0, bn = FX_BUF, bs = 2 * FX_BUF;
#define FY_ITER(MASK) do { const int tl = (t + 2 < nt) ? t + 2 : nt - 1; FY_LOAD(tl); \
        const bool do_next = !(MASK) || (64 * (t + 1) <= tqw_max), do_cur = !(MASK) || (64 * t <= tqw_max);     \
        if (do_next) FY_QK(sn, lds + bn); if (do_cur) FY_EXP(sc); \
        if (do_cur) FY_PV(lds + bc); if (do_next) FY_BMAX(sn, lds + bn, t + 1, MASK); \
        sc[0] = sn[0]; sc[1] = sn[1]; \
        FY_STORE(lds + bs); \
        const int tmp_ = bc; bc = bn; bn = bs; bs = tmp_; \
        __syncthreads(); } while (0)
    const int tqw_max = qb * 256 + wave * 32 + 31;
    int t = 0;
    for (; t + 1 < 4 * qb; ++t) FY_ITER(false);
    for (; t + 1 < nt; ++t) FY_ITER(true);
    if (64 * (nt - 1) <= tqw_max) { FY_EXP(sc); FY_PV(lds + bc); }
#undef FY_ITER
#undef FY_LOAD
#undef FY_STORE
#undef FY_QK
#undef FY_BMAX
#undef FY_EXP
#undef FY_PV
    lsum += __shfl_xor(lsum, 32);
    const float il = 1.f / lsum;
    bf16* yp = Y + rowq * D_ + 512 + h * 128;
#pragma unroll
    for (int d = 0; d < 4; ++d)
#pragma unroll
        for (int g = 0; g < 4; ++g) { u32x2 w; w.x = pk2(oT[d][4 * g] * il, oT[d][4 * g + 1] * il); w.y = pk2(oT[d][4 * g + 2] * il, oT[d][4 * g + 3] * il);
            *(u32x2*)(yp + 32 * d + 8 * g + 4 * hi) = w; }
}

constexpr size_t ST_TMP = 0, ST_DSRET = 32 * MiB, ST_DSSSD = 64 * MiB, ST_ALSSD = 96 * MiB;
constexpr size_t ST_DSHG = 32 * MiB, ST_ALHG = 96 * MiB;

template <int MODE  , int PASS  >
__device__ __forceinline__ void scalar_pass(ArgsP a, int j, int bh, int c0, int c1, unsigned char* lds) {
    constexpr int DV = MODE == 0 ? 128 : 64;
    constexpr int RS = 144;
    constexpr int OFF_QN = 0, OFF_QT = 9216, OFF_KN = 18432, OFF_KOT = 27648, OFF_VT = 36864, OFF_P = OFF_VT + DV * RS, OFF_ST = OFF_P + 9216, OFF_OB = OFF_ST + DV * RS;
    constexpr int OBS = DV * 4 + 16;
    constexpr int OFF_CUM = OFF_OB + 64 * OBS, OFF_TAB = OFF_CUM + 512;
    const int tid = tid_fresh(), lane = tid & 63, wave = tid >> 6, l31 = lane & 31, hi = lane >> 5;
    const int b = MODE == 0 ? (bh >> 2) : (bh >> 3), h = MODE == 0 ? (bh & 3) : (bh & 7), g = h >> 2;
    const bf16* BIG = (const bf16*)(a->ws + WS_BIG);
    const float* rope = (const float*)(a->ws + WS_ROPE); const float* GATE = (const float*)(a->ws + WS_GATE);
    bf16* Y = (bf16*)(a->ws + WS_UY); bf16* TMP = (bf16*)(a->ws + WS_ST + ST_TMP);
    bf16* DS = (bf16*)(a->ws + WS_ST + (MODE == 0 ? ST_DSRET : ST_DSSSD)) + (size_t)bh * 64 * (DV * 64);
    float* ALS = (float*)(a->ws + WS_ST + ST_ALSSD) + bh * 64;
    const float LOG2E = 1.4426950408889634f;
    const float gamma = 1.f - exp2f(-5.f - (float)h), lg2gamma = log2f(gamma);
    float dtb = 0.f, Aneg = 0.f, Dh = 0.f;
    if (MODE == 1) { dtb = a->in[11][j * 8 + h]; Aneg = -expf(a->in[12][j * 8 + h]); Dh = a->in[13][j * 8 + h]; }
    const float* gnw = a->in[8] + (j * 4 + h) * 128;
    float* cumL = (float*)(lds + OFF_CUM); float* tab = (float*)(lds + OFF_TAB);
    float gw[16];
#pragma unroll
    for (int e = 0; e < 16; ++e) gw[e] = (MODE == 0 && PASS == 1) ? gnw[(tid & 7) * 16 + e] : 0.f;
    const int st = tid >> 3, sc8 = lane & 7;
    const int tsw = (st ^ (sc8 << 3)) * 2;
    __syncthreads();
    if (PASS == 1) { for (int i = tid; i < 9216 / 4; i += 512) ((unsigned*)(lds + OFF_P))[i] = 0u; }
    if (MODE == 1) {
        const float* cw = a->in[9] + j * 4 * 768; const float* cb = a->in[10] + j * 768;
        for (int i = tid; i < 3 * 8 * 5 * 8; i += 512) { const int e = i & 7, w = (i >> 3) % 5, c8 = (i / 40) & 7, which = i / 320;
            const int col = (which == 0 ? h * 64 : (which == 1 ? 512 + g * 64 : 640 + g * 64)) + c8 * 8 + e;
            tab[i] = (w < 4) ? cw[w * 768 + col] : cb[col]; }
    }
    u32x4 rq, rk, rv0, rv1, rs0, rs1; f32x4 rcs, rsn; u32x4 rx[3][4]; float rgate = 0.f;
    constexpr int WH0 = (PASS == 0) ? 0 : 0, WH1 = (PASS == 0) ? 2 : 3;
#define SP_LOAD(c) do { const size_t row = (size_t)b * T_ + (c) * 64 + st; \
        if (MODE == 0) { if (PASS == 1) rq = *(const u32x4*)(BIG + BIGX(row, h * 64 + sc8 * 8)); rk = *(const u32x4*)(BIG + BIGX(row, 256 + h * 64 + sc8 * 8)); \
            rcs = *(const f32x4*)(rope + ((c) * 64 + st) * 32 + sc8 * 4); rsn = *(const f32x4*)(rope + T_ * 32 + ((c) * 64 + st) * 32 + sc8 * 4); \
            rv0 = *(const u32x4*)(BIG + BIGX(row, 512 + h * 128 + sc8 * 8)); rv1 = *(const u32x4*)(BIG + BIGX(row, 512 + h * 128 + (sc8 + 8) * 8)); } \
        else { _Pragma("unroll") for (int wh = WH0; wh < WH1; ++wh) { const int col = (wh == 0 ? h * 64 : (wh == 1 ? 512 + g * 64 : 640 + g * 64)) + sc8 * 8; \
                _Pragma("unroll") for (int w = 0; w < 4; ++w) { const int tt = (c) * 64 + st - 3 + w; \
                    rx[wh][w] = (tt >= 0) ? *(const u32x4*)(BIG + BIGX((size_t)b * T_ + tt, 2048 + col)) : (u32x4){0u, 0u, 0u, 0u}; } } \
            rgate = GATE[((size_t)b * T_ + (c) * 64 + lane) * 8 + h]; } \
        if (PASS == 1) { const bf16* sp = DS + (size_t)(c) * (DV * 64); rs0 = *(const u32x4*)(sp + tid * 8); if (MODE == 0) rs1 = *(const u32x4*)(sp + (tid + 512) * 8); } } while (0)
    SP_LOAD(c0);
    __syncthreads();
    for (int c = c0; c < c1; ++c) {
        for (int rs_ = 0; rs_ < RU_STAGE; ++rs_) {
        if (MODE == 0) {
            float q[8], k[8];
#pragma unroll
            for (int e = 0; e < 4; ++e) { const float k1 = bflo(rk[e]) * 0.125f, k2 = bfhi(rk[e]) * 0.125f; const float cs = rcs[e], sn = rsn[e];
                k[2 * e] = k1 * cs - k2 * sn; k[2 * e + 1] = k1 * sn + k2 * cs;
                if (PASS == 1) { const float q1 = bflo(rq[e]), q2 = bfhi(rq[e]); q[2 * e] = q1 * cs - q2 * sn; q[2 * e + 1] = q1 * sn + q2 * cs; } }
            if (PASS == 1) {
                const float gi = __builtin_amdgcn_exp2f((float)(st + 1) * lg2gamma);
                u32x4 w0, w1, w2;
#pragma unroll
                for (int e = 0; e < 4; ++e) { w0[e] = pk2(q[2 * e], q[2 * e + 1]); w1[e] = pk2(q[2 * e] * gi, q[2 * e + 1] * gi); w2[e] = pk2(k[2 * e], k[2 * e + 1]); }
                *(u32x4*)(lds + OFF_QN + st * RS + sc8 * 16) = w0; *(u32x4*)(lds + OFF_QT + st * RS + sc8 * 16) = w1; *(u32x4*)(lds + OFF_KN + st * RS + sc8 * 16) = w2;
            } else {
                const float go = __builtin_amdgcn_exp2f((float)(63 - st) * lg2gamma);
#pragma unroll
                for (int e = 0; e < 8; ++e) *(bf16*)(lds + OFF_KOT + (sc8 * 8 + e) * RS + tsw) = (bf16)f2bf(k[e] * go);
            }
#pragma unroll
            for (int e = 0; e < 4; ++e) { *(bf16*)(lds + OFF_VT + (sc8 * 8 + 2 * e) * RS + tsw) = (bf16)(rv0[e] & 0xffffu); *(bf16*)(lds + OFF_VT + (sc8 * 8 + 2 * e + 1) * RS + tsw) = (bf16)(rv0[e] >> 16);
                *(bf16*)(lds + OFF_VT + ((sc8 + 8) * 8 + 2 * e) * RS + tsw) = (bf16)(rv1[e] & 0xffffu); *(bf16*)(lds + OFF_VT + ((sc8 + 8) * 8 + 2 * e + 1) * RS + tsw) = (bf16)(rv1[e] >> 16); }
        } else {
            const float dtv = softplusf(rgate + dtb); float cumv = dtv * Aneg;
#pragma unroll
            for (int o = 1; o < 64; o <<= 1) { const float n = __shfl_up(cumv, o); if (lane >= o) cumv += n; }
            const float cum_t = __shfl(cumv, st), dt_t = __shfl(dtv, st), cum_last = __shfl(cumv, 63);
            if (wave == 0) { cumL[lane] = cumv; if (lane == 63) { cumL[64] = cumv; if (PASS == 0) ALS[c] = __expf(cumv); } }
            float val[3][8];
#pragma unroll
            for (int wh = WH0; wh < WH1; ++wh) { const float* tb = tab + (wh * 8 + sc8) * 40;
#pragma unroll
                for (int e = 0; e < 8; ++e) val[wh][e] = tb[32 + e];
#pragma unroll
                for (int w = 0; w < 4; ++w)
#pragma unroll
                    for (int e = 0; e < 4; ++e) { val[wh][2 * e] += tb[w * 8 + 2 * e] * bflo(rx[wh][w][e]); val[wh][2 * e + 1] += tb[w * 8 + 2 * e + 1] * bfhi(rx[wh][w][e]); }
#pragma unroll
                for (int e = 0; e < 8; ++e) val[wh][e] = siluf(val[wh][e]); }
            if (PASS == 1) {
                const float ei = __expf(cum_t);
                u32x4 w0, w1, w2;
#pragma unroll
                for (int e = 0; e < 4; ++e) { w0[e] = pk2(val[2][2 * e], val[2][2 * e + 1]); w1[e] = pk2(val[2][2 * e] * ei, val[2][2 * e + 1] * ei); w2[e] = pk2(val[1][2 * e] * dt_t, val[1][2 * e + 1] * dt_t); }
                *(u32x4*)(lds + OFF_QN + st * RS + sc8 * 16) = w0; *(u32x4*)(lds + OFF_QT + st * RS + sc8 * 16) = w1; *(u32x4*)(lds + OFF_KN + st * RS + sc8 * 16) = w2;
            } else {
                const float eo = dt_t * __expf(cum_last - cum_t);
#pragma unroll
                for (int e = 0; e < 8; ++e) *(bf16*)(lds + OFF_KOT + (sc8 * 8 + e) * RS + tsw) = (bf16)f2bf(val[1][e] * eo);
            }
#pragma unroll
            for (int e = 0; e < 8; ++e) *(bf16*)(lds + OFF_VT + (sc8 * 8 + e) * RS + tsw) = (bf16)f2bf(val[0][e]);
        }
        if (PASS == 1) {
            *(u32x4*)(lds + OFF_ST + (tid >> 3) * RS + (tid & 7) * 16) = rs0;
            if (MODE == 0) *(u32x4*)(lds + OFF_ST + ((tid >> 3) + 64) * RS + (tid & 7) * 16) = rs1;
        }
        LBAR();
        }
        if (c + 1 < c1) SP_LOAD(c + 1);
        if (PASS == 0) {
            if (MODE == 0 || wave < 4) {
                const int sdb = wave & 1, svb = (MODE == 0) ? (wave >> 1) : ((wave >> 1) & 1);
                f32x16 sacc;
#pragma unroll
                for (int r = 0; r < 16; ++r) sacc[r] = 0.f;
#pragma unroll
                for (int s = 0; s < 4; ++s) { const bf16x8_t af = *(const bf16x8_t*)(lds + OFF_KOT + (32 * sdb + l31) * RS + (((2 * s + hi) ^ ((l31 >> 3) & 7) ^ ((4 * sdb) & 7)) * 16)), bfr = *(const bf16x8_t*)(lds + OFF_VT + (32 * svb + l31) * RS + (((2 * s + hi) ^ ((l31 >> 3) & 7) ^ ((4 * svb) & 7)) * 16));
                    sacc = __builtin_amdgcn_mfma_f32_32x32x16_bf16(af, bfr, sacc, 0, 0, 0); }
                bf16* dp = DS + (size_t)c * (DV * 64) + (32 * svb + l31) * 64 + 32 * sdb + 4 * hi;
#pragma unroll
                for (int g4 = 0; g4 < 4; ++g4) { u32x2 w; w.x = pk2(sacc[4 * g4], sacc[4 * g4 + 1]); w.y = pk2(sacc[4 * g4 + 2], sacc[4 * g4 + 3]); *(u32x2*)(dp + 8 * g4) = w; }
            }
            LBAR();
        } else {
            unsigned rg[4]; u32x4 rgA, rgB;
            if (MODE == 0) { const bf16* gp = BIG + BIGX((size_t)b * T_ + c * 64 + (tid >> 3), 1024 + h * 128 + (tid & 7) * 16); rgA = *(const u32x4*)gp; rgB = *(const u32x4*)(gp + 8);
            } else {
#pragma unroll
                for (int k = 0; k < 4; ++k) { const int idx = tid + 512 * k; rg[k] = *(const unsigned*)(BIG + BIGX((size_t)b * T_ + c * 64 + (idx >> 5), 1536 + h * 64 + 2 * (idx & 31))); }
            }
            for (int rg_ = 0; rg_ < RU_G; ++rg_) {
            if (wave < 3) {
                const int jb = (wave == 2) ? 1 : 0, ib = (wave == 0) ? 0 : 1;
                f32x16 acc;
#pragma unroll
                for (int r = 0; r < 16; ++r) acc[r] = 0.f;
#pragma unroll
                for (int s = 0; s < 4; ++s) { const bf16x8_t af = *(const bf16x8_t*)(lds + OFF_KN + (32 * jb + l31) * RS + (16 * s + 8 * hi) * 2), bfr = *(const bf16x8_t*)(lds + OFF_QN + (32 * ib + l31) * RS + (16 * s + 8 * hi) * 2);
                    acc = __builtin_amdgcn_mfma_f32_32x32x16_bf16(af, bfr, acc, 0, 0, 0); }
                const int i = 32 * ib + l31; const float cum_i = (MODE == 1) ? cumL[i] : 0.f;
#pragma unroll
                for (int g4 = 0; g4 < 4; ++g4) { const int j0 = 32 * jb + 8 * g4 + 4 * hi; float v[4];
                    f32x4 cj = (f32x4){0.f, 0.f, 0.f, 0.f}; if (MODE == 1) cj = *(const f32x4*)(cumL + j0);
#pragma unroll
                    for (int e = 0; e < 4; ++e) { const int jj = j0 + e; const float ex = (MODE == 0) ? (float)(i - jj) * lg2gamma : (cum_i - cj[e]) * LOG2E;
                        v[e] = (jj <= i) ? acc[4 * g4 + e] * __builtin_amdgcn_exp2f(ex) : 0.f; }
                    u32x2 w; w.x = pk2(v[0], v[1]); w.y = pk2(v[2], v[3]);
                    *(u32x2*)(lds + OFF_P + i * RS + j0 * 2) = w; }
            }
            LBAR();
            }
            for (int ro_ = 0; ro_ < RU_O; ++ro_) {
            if (MODE == 0 || wave < 4) {
                const int ib = wave & 1, vb = (wave >> 1) & 3;
                f32x16 acc;
#pragma unroll
                for (int r = 0; r < 16; ++r) acc[r] = 0.f;
#pragma unroll
                for (int s = 0; s < 4; ++s) { const bf16x8_t af = *(const bf16x8_t*)(lds + OFF_P + (32 * ib + l31) * RS + (16 * s + 8 * hi) * 2), bfr = *(const bf16x8_t*)(lds + OFF_VT + (32 * vb + l31) * RS + (((2 * s + hi) ^ ((l31 >> 3) & 7) ^ ((4 * vb) & 7)) * 16));
                    acc = __builtin_amdgcn_mfma_f32_32x32x16_bf16(af, bfr, acc, 0, 0, 0); }
#pragma unroll
                for (int s = 0; s < 4; ++s) { const bf16x8_t af = *(const bf16x8_t*)(lds + OFF_QT + (32 * ib + l31) * RS + (16 * s + 8 * hi) * 2), bfr = *(const bf16x8_t*)(lds + OFF_ST + (32 * vb + l31) * RS + (16 * s + 8 * hi) * 2);
                    acc = __builtin_amdgcn_mfma_f32_32x32x16_bf16(af, bfr, acc, 0, 0, 0); }
                if (MODE == 1) {
#pragma unroll
                    for (int g4 = 0; g4 < 4; ++g4) { const u32x2 xv = *(const u32x2*)(lds + OFF_VT + (32 * vb + l31) * RS + (((4 * ib + g4) ^ ((l31 >> 3) & 7) ^ ((4 * vb) & 7)) * 16) + 8 * hi);
                        acc[4 * g4] += Dh * bflo(xv.x); acc[4 * g4 + 1] += Dh * bfhi(xv.x); acc[4 * g4 + 2] += Dh * bflo(xv.y); acc[4 * g4 + 3] += Dh * bfhi(xv.y); }
                }
#pragma unroll
                for (int r = 0; r < 16; ++r) *(float*)(lds + OFF_OB + (32 * ib + crow16(r, hi)) * OBS + (32 * vb + l31) * 4) = acc[r];
            }
            LBAR();
            }
            for (int rf_ = 0; rf_ < RU_FIN; ++rf_) {
            if (MODE == 0) {
                const int i = tid >> 3, part = tid & 7; const size_t row = (size_t)b * T_ + c * 64 + i;
                float o[16]; float sm = 0.f, sq = 0.f;
#pragma unroll
                for (int q4 = 0; q4 < 4; ++q4) { const f32x4 v = *(const f32x4*)(lds + OFF_OB + i * OBS + part * 64 + q4 * 16);
                    o[4 * q4] = v.x; o[4 * q4 + 1] = v.y; o[4 * q4 + 2] = v.z; o[4 * q4 + 3] = v.w; sm += (v.x + v.y) + (v.z + v.w); sq += (v.x * v.x + v.y * v.y) + (v.z * v.z + v.w * v.w); }
                sm += __shfl_xor(sm, 1); sq += __shfl_xor(sq, 1); sm += __shfl_xor(sm, 2); sq += __shfl_xor(sq, 2); sm += __shfl_xor(sm, 4); sq += __shfl_xor(sq, 4);
                const float mean = sm * (1.f / 128.f); const float rs = rsqrtf(fmaxf(sq * (1.f / 128.f) - mean * mean, 0.f) + EPS_);
                u32x4 w0, w1;
#pragma unroll
                for (int e = 0; e < 4; ++e) { w0[e] = pk2((o[2 * e] - mean) * rs * gw[2 * e] * siluf(bflo(rgA[e])), (o[2 * e + 1] - mean) * rs * gw[2 * e + 1] * siluf(bfhi(rgA[e])));
                    w1[e] = pk2((o[8 + 2 * e] - mean) * rs * gw[8 + 2 * e] * siluf(bflo(rgB[e])), (o[8 + 2 * e + 1] - mean) * rs * gw[8 + 2 * e + 1] * siluf(bfhi(rgB[e]))); }
                *(u32x4*)(Y + row * D_ + h * 128 + part * 16) = w0; *(u32x4*)(Y + row * D_ + h * 128 + part * 16 + 8) = w1;
            } else {
#pragma unroll
                for (int k = 0; k < 4; ++k) { const int idx = tid + 512 * k, i = idx >> 5, p = 2 * (idx & 31); const size_t row = (size_t)b * T_ + c * 64 + i;
                    const f32x2_t y = *(const f32x2_t*)(lds + OFF_OB + i * OBS + p * 4);
                    *(unsigned*)(TMP + row * 512 + h * 64 + p) = pk2(y.x * siluf(bflo(rg[k])), y.y * siluf(bfhi(rg[k]))); }
            }
            }
        }
    }
#undef SP_LOAD
    __syncthreads();
}

template <int MODE>
__device__ __forceinline__ void scalar_scan(ArgsP a) {
    constexpr int E2 = (MODE == 0 ? 128 : 64) * 64 / 2;
    constexpr int NS = MODE == 0 ? 32 : 64;
    unsigned* DS = (unsigned*)(a->ws + WS_ST + (MODE == 0 ? ST_DSRET : ST_DSSSD));
    const float* ALS = (const float*)(a->ws + WS_ST + ST_ALSSD);
    for (int it = bid_fresh() * 512 + tid_fresh(); it < NS * E2; it += gdim_fresh() * 512) {
        const int s = it / E2, e = it % E2;
        unsigned* p = DS + (size_t)s * 64 * E2 + e;
        float al = 1.f; if (MODE == 0) { const int h = s & 3; const float gamma = 1.f - exp2f(-5.f - (float)h); al = exp2f(64.f * log2f(gamma)); }
        float r0 = 0.f, r1 = 0.f;
        unsigned wn[8]; float an[8];
#pragma unroll
        for (int k = 0; k < 8; ++k) { wn[k] = p[(size_t)k * E2]; an[k] = (MODE == 0) ? al : ALS[s * 64 + k]; }
        for (int c0 = 0; c0 < 64; c0 += 8) {
            unsigned w[8]; float av[8];
#pragma unroll
            for (int k = 0; k < 8; ++k) { w[k] = wn[k]; av[k] = an[k]; }
            if (c0 + 8 < 64) {
#pragma unroll
                for (int k = 0; k < 8; ++k) { wn[k] = p[(size_t)(c0 + 8 + k) * E2]; an[k] = (MODE == 0) ? al : ALS[s * 64 + c0 + 8 + k]; } }
#pragma unroll
            for (int k = 0; k < 8; ++k) { p[(size_t)(c0 + k) * E2] = pk2(r0, r1); r0 = av[k] * r0 + bflo(w[k]); r1 = av[k] * r1 + bfhi(w[k]); }
        }
    }
}

template <int PASS  >
__device__ __forceinline__ void hg_pass(ArgsP a, int j, int bh, int c0, int c1, unsigned char* lds) {
    constexpr int RS = 144, RW = 272;
    constexpr int OFF_QX = 0, OFF_KV = 17408, OFF_OB = 0  , OFF_QT = 43520, OFF_KOT = 60928, OFF_VT = 79360, OFF_P = 97792, OFF_ST = 107008, OFF_AL = 141824;
    constexpr int OBS = 528;
    const int tid = tid_fresh(), lane = tid & 63, wave = tid >> 6, l31 = lane & 31, hi = lane >> 5;
    const int b = bh >> 2, h = bh & 3;
    const bf16* BIG = (const bf16*)(a->ws + WS_BIG); bf16* Y = (bf16*)(a->ws + WS_UY);
    bf16* DS = (bf16*)(a->ws + WS_ST + ST_DSHG) + (size_t)bh * 64 * 16384;
    float* ALG = (float*)(a->ws + WS_ST + ST_ALHG) + (size_t)bh * 64 * 128;
    const float* nw = a->in[18] + j * 128;
    const int c8 = wave * 2 + hi, tseg = l31;
    float lbv[8];
#pragma unroll
    for (int e = 0; e < 8; ++e) { lbv[e] = 0.f; if (j == 1) { const float l0 = a->in[17][h * 128 + c8 * 8 + e], l1 = a->in[17][512 + h * 128 + c8 * 8 + e]; lbv[e] = 1.f / (1.f + expf(l0 - l1)); } }
    float gw[16];
#pragma unroll
    for (int e = 0; e < 16; ++e) gw[e] = (PASS == 1) ? nw[(tid & 7) * 16 + e] : 0.f;
    __syncthreads();
    if (PASS == 1) { for (int i = tid; i < 9216 / 4; i += 512) ((unsigned*)(lds + OFF_P))[i] = 0u; }
    u32x4 rz[2], rq[2], rv[2], rs[4];
#define HP_LOAD(c) do { _Pragma("unroll") for (int rr = 0; rr < 2; ++rr) { const size_t row = (size_t)b * T_ + (c) * 64 + 2 * tseg + rr; \
        if (PASS == 1) rq[rr] = *(const u32x4*)(BIG + BIGX(row, h * 128 + c8 * 8)); rz[rr] = *(const u32x4*)(BIG + BIGX(row, 512 + h * 128 + c8 * 8)); rv[rr] = *(const u32x4*)(BIG + BIGX(row, 1024 + h * 128 + c8 * 8)); } \
        if (PASS == 1) { const bf16* sp = DS + (size_t)(c) * 16384; _Pragma("unroll") for (int k = 0; k < 4; ++k) rs[k] = *(const u32x4*)(sp + (tid + 512 * k) * 8); } } while (0)
    HP_LOAD(c0);
    __syncthreads();
    for (int c = c0; c < c1; ++c) {
        {
            float lf[2][8], kk[2][8], qv[2][8], cum[2][8];
#pragma unroll
            for (int rr = 0; rr < 2; ++rr)
#pragma unroll
                for (int e = 0; e < 4; ++e) {
                    const float z0 = fmaxf(bflo(rz[rr][e]), -60.f), z1 = fmaxf(bfhi(rz[rr][e]), -60.f);
                    const float e0 = __builtin_amdgcn_exp2f(-1.4426950408889634f * z0), e1 = __builtin_amdgcn_exp2f(-1.4426950408889634f * z1);
                    const float s0 = __builtin_amdgcn_rcpf(1.f + e0), s1 = __builtin_amdgcn_rcpf(1.f + e1);
                    const float f0 = lbv[2 * e] + (1.f - lbv[2 * e]) * s0, f1 = lbv[2 * e + 1] + (1.f - lbv[2 * e + 1]) * s1;
                    lf[rr][2 * e] = __logf(f0); lf[rr][2 * e + 1] = __logf(f1);
                    kk[rr][2 * e] = (1.f - lbv[2 * e]) * (e0 * s0); kk[rr][2 * e + 1] = (1.f - lbv[2 * e + 1]) * (e1 * s1);
                    if (PASS == 1) { qv[rr][2 * e] = bflo(rq[rr][e]); qv[rr][2 * e + 1] = bfhi(rq[rr][e]); } }
            float ref1[8], clast[8];
#pragma unroll
            for (int e = 0; e < 8; ++e) {
                float s = lf[0][e] + lf[1][e];
#pragma unroll
                for (int o = 1; o < 32; o <<= 1) { const float n = __shfl_up(s, o, 32); if (tseg >= o) s += n; }
                cum[1][e] = s; cum[0][e] = s - lf[1][e];
                ref1[e] = __shfl(s, 15, 32); clast[e] = __shfl(s, 31, 32); }
            const bool blk1 = tseg >= 16;
            if (PASS == 1) {
#pragma unroll
                for (int rr = 0; rr < 2; ++rr) { const int t = 2 * tseg + rr;
                    float qx[8], qt[8], k0[8], k1[8];
#pragma unroll
                    for (int e = 0; e < 8; ++e) { const float cm = cum[rr][e]; const float rf = blk1 ? ref1[e] : 0.f;
                        qx[e] = qv[rr][e] * __expf(cm - rf); qt[e] = qv[rr][e] * __expf(cm);
                        k0[e] = kk[rr][e] * __expf(rf - cm); k1[e] = kk[rr][e] * __expf(ref1[e] - cm); }
                    u32x4 wqx, wqt, wk0, wk1;
#pragma unroll
                    for (int e = 0; e < 4; ++e) { wqx[e] = pk2(qx[2 * e], qx[2 * e + 1]); wqt[e] = pk2(qt[2 * e], qt[2 * e + 1]); wk0[e] = pk2(k0[2 * e], k0[2 * e + 1]); wk1[e] = pk2(k1[2 * e], k1[2 * e + 1]); }
                    *(u32x4*)(lds + OFF_QX + t * RW + c8 * 16) = wqx; *(u32x4*)(lds + OFF_QT + t * RW + c8 * 16) = wqt;
                    if (!blk1) { *(u32x4*)(lds + OFF_KV + t * RW + c8 * 16) = wk0; *(u32x4*)(lds + OFF_KV + 8704 + t * RW + c8 * 16) = wk1; }
                    else       { *(u32x4*)(lds + OFF_KV + 2 * 8704 + (t - 32) * RW + c8 * 16) = wk0; } }
#pragma unroll
                for (int k = 0; k < 4; ++k) { const int id = tid + 512 * k; *(u32x4*)(lds + OFF_ST + (id >> 4) * RW + (id & 15) * 16) = rs[k]; }
            } else {
#pragma unroll
                for (int e = 0; e < 8; ++e) { *(unsigned*)(lds + OFF_KOT + (c8 * 8 + e) * RS + tseg * 4) = pk2(kk[0][e] * __expf(clast[e] - cum[0][e]), kk[1][e] * __expf(clast[e] - cum[1][e])); }
                if (tseg == 31) {
#pragma unroll
                    for (int e = 0; e < 8; ++e) ALG[c * 128 + c8 * 8 + e] = __expf(clast[e]); }
            }
#pragma unroll
            for (int e = 0; e < 4; ++e) { *(unsigned*)(lds + OFF_VT + (c8 * 8 + 2 * e) * RS + tseg * 4) = (rv[0][e] & 0xffffu) | (rv[1][e] << 16);
                *(unsigned*)(lds + OFF_VT + (c8 * 8 + 2 * e + 1) * RS + tseg * 4) = (rv[0][e] >> 16) | (rv[1][e] & 0xffff0000u); }
        }
        LBAR();
        if (c + 1 < c1) HP_LOAD(c + 1);
        if (PASS == 0) {
            const int svb = wave >> 1;
#pragma unroll
            for (int t = 0; t < 2; ++t) { const int db = 2 * (wave & 1) + t;
                f32x16 sacc;
#pragma unroll
                for (int r = 0; r < 16; ++r) sacc[r] = 0.f;
#pragma unroll
                for (int s = 0; s < 4; ++s) { const bf16x8_t af = *(const bf16x8_t*)(lds + OFF_KOT + (32 * db + l31) * RS + (16 * s + 8 * hi) * 2), bfr = *(const bf16x8_t*)(lds + OFF_VT + (32 * svb + l31) * RS + (16 * s + 8 * hi) * 2);
                    sacc = __builtin_amdgcn_mfma_f32_32x32x16_bf16(af, bfr, sacc, 0, 0, 0); }
                bf16* dp = DS + (size_t)c * 16384 + (32 * svb + l31) * 128 + 32 * db + 4 * hi;
#pragma unroll
                for (int g4 = 0; g4 < 4; ++g4) { u32x2 w; w.x = pk2(sacc[4 * g4], sacc[4 * g4 + 1]); w.y = pk2(sacc[4 * g4 + 2], sacc[4 * g4 + 3]); *(u32x2*)(dp + 8 * g4) = w; } }
            LBAR();
        } else {
            u32x4 rgA, rgB;
            { const bf16* gp = BIG + BIGX((size_t)b * T_ + c * 64 + (tid >> 3), 1536 + h * 128 + (tid & 7) * 16); rgA = *(const u32x4*)gp; rgB = *(const u32x4*)(gp + 8); }
            if (wave < 3) {
                const int ib = (wave == 0) ? 0 : 1, jb = (wave == 2) ? 1 : 0;
                f32x16 acc;
#pragma unroll
                for (int r = 0; r < 16; ++r) acc[r] = 0.f;
#pragma unroll
                for (int s = 0; s < 8; ++s) { const bf16x8_t af = *(const bf16x8_t*)(lds + OFF_KV + wave * 8704 + l31 * RW + (16 * s + 8 * hi) * 2), bfr = *(const bf16x8_t*)(lds + OFF_QX + (32 * ib + l31) * RW + (16 * s + 8 * hi) * 2);
                    acc = __builtin_amdgcn_mfma_f32_32x32x16_bf16(af, bfr, acc, 0, 0, 0); }
                const int i = 32 * ib + l31;
#pragma unroll
                for (int g4 = 0; g4 < 4; ++g4) { const int j0 = 32 * jb + 8 * g4 + 4 * hi; float v[4];
#pragma unroll
                    for (int e = 0; e < 4; ++e) v[e] = (j0 + e <= i) ? acc[4 * g4 + e] : 0.f;
                    u32x2 w; w.x = pk2(v[0], v[1]); w.y = pk2(v[2], v[3]);
                    *(u32x2*)(lds + OFF_P + i * RS + j0 * 2) = w; }
            }
            LBAR();
            {
                const int ib = wave & 1, vb = wave >> 1;
                f32x16 acc;
#pragma unroll
                for (int r = 0; r < 16; ++r) acc[r] = 0.f;
#pragma unroll
                for (int s = 0; s < 4; ++s) { const bf16x8_t af = *(const bf16x8_t*)(lds + OFF_P + (32 * ib + l31) * RS + (16 * s + 8 * hi) * 2), bfr = *(const bf16x8_t*)(lds + OFF_VT + (32 * vb + l31) * RS + (16 * s + 8 * hi) * 2);
                    acc = __builtin_amdgcn_mfma_f32_32x32x16_bf16(af, bfr, acc, 0, 0, 0); }
#pragma unroll
                for (int s = 0; s < 8; ++s) { const bf16x8_t af = *(const bf16x8_t*)(lds + OFF_QT + (32 * ib + l31) * RW + (16 * s + 8 * hi) * 2), bfr = *(const bf16x8_t*)(lds + OFF_ST + (32 * vb + l31) * RW + (16 * s + 8 * hi) * 2);
                    acc = __builtin_amdgcn_mfma_f32_32x32x16_bf16(af, bfr, acc, 0, 0, 0); }
#pragma unroll
                for (int r = 0; r < 16; ++r) *(float*)(lds + OFF_OB + (32 * ib + crow16(r, hi)) * OBS + (32 * vb + l31) * 4) = acc[r];
            }
            LBAR();
            { const int i = tid >> 3, part = tid & 7; const size_t row = (size_t)b * T_ + c * 64 + i;
                float o[16]; float sq = 0.f;
#pragma unroll
                for (int q4 = 0; q4 < 4; ++q4) { const f32x4 v = *(const f32x4*)(lds + OFF_OB + i * OBS + part * 64 + q4 * 16);
                    o[4 * q4] = v.x; o[4 * q4 + 1] = v.y; o[4 * q4 + 2] = v.z; o[4 * q4 + 3] = v.w; sq += (v.x * v.x + v.y * v.y) + (v.z * v.z + v.w * v.w); }
                sq += __shfl_xor(sq, 1); sq += __shfl_xor(sq, 2); sq += __shfl_xor(sq, 4);
                const float rsn = rsqrtf(sq * (1.f / 128.f) + EPS_);
                u32x4 w0, w1;
#pragma unroll
                for (int e = 0; e < 4; ++e) { w0[e] = pk2(o[2 * e] * rsn * gw[2 * e] * siluf(bflo(rgA[e])), o[2 * e + 1] * rsn * gw[2 * e + 1] * siluf(bfhi(rgA[e])));
                    w1[e] = pk2(o[8 + 2 * e] * rsn * gw[8 + 2 * e] * siluf(bflo(rgB[e])), o[8 + 2 * e + 1] * rsn * gw[8 + 2 * e + 1] * siluf(bfhi(rgB[e]))); }
                *(u32x4*)(Y + row * D_ + h * 128 + part * 16) = w0; *(u32x4*)(Y + row * D_ + h * 128 + part * 16 + 8) = w1; }
            LBAR();
        }
    }
#undef HP_LOAD
    __syncthreads();
}

__device__ __forceinline__ void hg_scan(ArgsP a) {
    constexpr int E2 = 8192;
    unsigned* DS = (unsigned*)(a->ws + WS_ST + ST_DSHG);
    const float* ALG = (const float*)(a->ws + WS_ST + ST_ALHG);
    for (int it = bid_fresh() * 512 + tid_fresh(); it < 32 * E2; it += gdim_fresh() * 512) {
        const int s = it / E2, e = it % E2; const int d = (2 * e) & 127;
        unsigned* p = DS + (size_t)s * 64 * E2 + e;
        const float* al = ALG + (size_t)s * 64 * 128 + d;
        float r0 = 0.f, r1 = 0.f;
        unsigned wn[8]; f32x2_t an[8];
#pragma unroll
        for (int k = 0; k < 8; ++k) { wn[k] = p[(size_t)k * E2]; an[k] = *(const f32x2_t*)(al + k * 128); }
        for (int c0 = 0; c0 < 64; c0 += 8) {
            unsigned w[8]; f32x2_t av[8];
#pragma unroll
            for (int k = 0; k < 8; ++k) { w[k] = wn[k]; av[k] = an[k]; }
            if (c0 + 8 < 64) {
#pragma unroll
                for (int k = 0; k < 8; ++k) { wn[k] = p[(size_t)(c0 + 8 + k) * E2]; an[k] = *(const f32x2_t*)(al + (c0 + 8 + k) * 128); } }
#pragma unroll
            for (int k = 0; k < 8; ++k) { p[(size_t)(c0 + k) * E2] = pk2(r0, r1); r0 = av[k].x * r0 + bflo(w[k]); r1 = av[k].y * r1 + bfhi(w[k]); }
        }
    }
}

#ifndef REP_PROLOGUE
#define REP_PROLOGUE 1
#endif
#ifndef REP_NORM
#define REP_NORM 1
#endif
#ifndef REP_INPROJ
#define REP_INPROJ 1
#endif
#ifndef REP_EVENMIX
#define REP_EVENMIX 1
#endif
#ifndef REP_ODDMIX
#define REP_ODDMIX 1
#endif
#ifndef REP_SYNC
#define REP_SYNC 1
#endif
#ifndef REP_FOX
#define REP_FOX 1
#endif
#ifndef REP_UP
#define REP_UP 1
#endif
__global__ void __launch_bounds__(512, 2) fwd_kernel(Args a_unused) {
    extern __shared__ __attribute__((aligned(16))) unsigned char lds[];
    cg::grid_group grid = cg::this_grid();
    PG8_LAS unsigned char* lds3 = (PG8_LAS unsigned char*)lds;
    volatile int* s_nextp = (volatile int*)(lds + 141 * 1024);
    volatile LAS unsigned* xmisc = (volatile LAS unsigned*)((LAS unsigned char*)lds + 145920);
    if (tid_fresh() < 2) xmisc[tid_fresh()] = 0u;
    __syncthreads();
    { ArgsP a = fresh_args(); (void)xcd_barrier_post((unsigned*)(a->ws + WS_CTL) + 4096, xmisc); }
#define XSYNC() do { ArgsP a_ = fresh_args(); XcdBarrier xb_; xb_.bar = (unsigned*)(a_->ws + WS_CTL) + 4096; xb_.x = xb_xcc_id(); xb_.st = (volatile LAS unsigned*)((LAS unsigned char*)lds + 145920); xcd_barrier(xb_); } while (0)

    for (int rep = 0; rep < REP_PROLOGUE; ++rep) { { ArgsP a = fresh_args(); prologue(a, lds); }
    XSYNC(); }
    { ArgsP a = fresh_args(); if (a->ws == nullptr) grid.sync(); }

#pragma unroll 1
    for (int L = 0; L < 4; ++L) {
        const int j = L >> 1; const bool even = (L & 1) == 0;
        for (int rep = 0; rep < REP_NORM; ++rep) {
        { ArgsP a = fresh_args(); unsigned char* ws = a->ws;
          const float* Wg = even ? a->in[6] + (size_t)j * D_ * AB_LD : a->in[15] + (size_t)j * D_ * CD_LD; const int ldw = even ? AB_LD : CD_LD, goff = even ? AB_N : CD_N, ng = even ? 8 : 4;
          if (L == 0) norm_phase<false, true>(a->in[0], a->in[1] + L * D_, (bf16*)(ws + WS_UY), Wg, ldw, goff, ng, (float*)(ws + WS_GATE), (float*)(ws + WS_RSTD1), lds);
          else        norm_phase<true, false>(a->out, a->in[1] + L * D_, nullptr, Wg, ldw, goff, ng, (float*)(ws + WS_GATE), (float*)(ws + WS_RSTD1), lds); }
        XSYNC(); }
        for (int rep = 0; rep < REP_INPROJ; ++rep) {
        { const int bx = bid_fresh(); if (!even && bx < 32) { ArgsP a = fresh_args(); cumf_seq(a, j, bx, lds); } }
#ifndef NO_INPROJ
        if (even) { ArgsP a = fresh_args(); unsigned char* ws = a->ws;
            pg8::Gemm g{(L == 0) ? (const bf16*)(ws + WS_UY) : (const bf16*)a->out, (const bf16*)(ws + WS_WABIN) + (size_t)j * AB_N * D_, M_, AB_N, D_}; pg8::StaticOrder S; S.init(M_, AB_N, gdim_fresh(), bid_fresh());
            pg8::EpiBf16BlkR E{(bf16*)(ws + WS_BIG), M_, (const float*)(ws + WS_RSTD1)};
            pg8::gemm_phase<pg8::EpiBf16BlkR, pg8::StaticOrder, true, true>(lds3, g, S, E);
        } else { ArgsP a = fresh_args(); unsigned char* ws = a->ws;
            pg8::Gemm g{(const bf16*)a->out, (const bf16*)(ws + WS_WCDIN) + (size_t)j * CD_N * D_, M_, CD_N, D_}; pg8::StaticOrder S; S.init(M_, CD_N, gdim_fresh(), bid_fresh());
            pg8::EpiBf16BlkR E{(bf16*)(ws + WS_BIG), M_, (const float*)(ws + WS_RSTD1)};
            pg8::gemm_phase<pg8::EpiBf16BlkR, pg8::StaticOrder, true, true>(lds3, g, S, E);
        }
#endif
        XSYNC(); }
        if (even) {
          for (int rep = 0; rep < REP_EVENMIX; ++rep) {
            if (rep) XSYNC();
#define EVEN_PASS(PASS) do { ArgsP a = fresh_args(); const int G_ = gdim_fresh(), bx = bid_fresh(); const int perr = (2048 + G_ - 1) / G_, pers = (4096 + G_ - 1) / G_;     \
              { int u = bx * perr; const int end = min(u + perr, 2048); while (u < end) { const int bh = u >> 6, ce = min(end, (bh + 1) * 64); scalar_pass<0, PASS>(a, j, bh, u & 63, ce - bh * 64, lds); u = ce; } } \
              { int u = bx * pers; const int end = min(u + pers, 4096); while (u < end) { const int bh = u >> 6, ce = min(end, (bh + 1) * 64); scalar_pass<1, PASS>(a, j, bh, u & 63, ce - bh * 64, lds); u = ce; } } } while (0)
            EVEN_PASS(0);
            XSYNC();
            { ArgsP a = fresh_args(); scalar_scan<0>(a); scalar_scan<1>(a); }
            XSYNC();
            EVEN_PASS(1);
            XSYNC();
            { ArgsP a = fresh_args(); ssd_norm_phase(a, j); }
          }
        } else {
          for (int rep = 0; rep < REP_ODDMIX; ++rep) {
            if (rep) XSYNC();
#define HG_PASS(PASS) do { ArgsP a = fresh_args(); const int G_ = gdim_fresh(), bx = bid_fresh(); const int per = (2048 + G_ - 1) / G_; int u = bx * per; const int end = min(u + per, 2048); \
              while (u < end) { const int bh = u >> 6, ce = min(end, (bh + 1) * 64); hg_pass<PASS>(a, j, bh, u & 63, ce - bh * 64, lds); u = ce; } } while (0)
            if (rep == 0) { { ArgsP a = fresh_args(); fox_prep(a, j, lds); } }
            HG_PASS(0);
            XSYNC();
            { ArgsP a = fresh_args(); hg_scan(a); }
            for (int rf = 0; rf < REP_FOX; ++rf) { ArgsP a = fresh_args(); unsigned* ctl = (unsigned*)(a->ws + WS_CTL) + 64 * 8 * rf;
              for (;;) {
                __syncthreads();
                if (tid_fresh() == 0) *s_nextp = (int)atomicAdd(ctl + 64 * (1 + L + 4 * rep), 1u);
                __syncthreads();
                const int u = *s_nextp;
                if (u >= 512) break;
                fox_unit2(a, u & 31, 15 - (u >> 5), lds);
              } }
            XSYNC();
            HG_PASS(1);
          }
        }
        for (int rep = 0; rep < REP_SYNC; ++rep) XSYNC();
#ifndef NO_OUTPROJ
        { ArgsP a = fresh_args(); unsigned char* ws = a->ws;
            const bf16* Wt = even ? (const bf16*)(ws + WS_WABOUT) + (size_t)j * D_ * D_ : (const bf16*)(ws + WS_WCDOUT) + (size_t)j * D_ * D_;
            pg8::Gemm g{(const bf16*)(ws + WS_UY), Wt, M_, D_, D_}; pg8::StaticOrder S; S.init(M_, D_, gdim_fresh(), bid_fresh());
            if (L == 0) { pg8::EpiResidT<false, true> E{a->in[0], a->out, D_, (float*)(ws + WS_RSP)}; pg8::gemm_phase<pg8::EpiResidT<false, true>, pg8::StaticOrder, true, true>(lds3, g, S, E); }
            else { pg8::EpiResidT<true, true> E{a->out, (L == 3) ? (void*)(ws + WS_ST) : (void*)a->out, D_, (float*)(ws + WS_RSP)}; pg8::gemm_phase<pg8::EpiResidT<true, true>, pg8::StaticOrder, true, true>(lds3, g, S, E); }
        }
#endif
        XSYNC();
        { ArgsP a = fresh_args(); rstd_phase(a); }
        XSYNC();
        for (int rep = 0; rep < REP_UP; ++rep) {
#ifndef NO_UP
        { ArgsP a = fresh_args(); unsigned char* ws = a->ws;
            pg8::Gemm g{(L == 3) ? (const bf16*)(ws + WS_ST) : (const bf16*)a->out, (const bf16*)(ws + WS_WGU) + (size_t)L * 2 * FF_ * D_, M_, 2 * FF_, D_}; pg8::StaticOrder S; S.init(M_, 2 * FF_, gdim_fresh(), bid_fresh());
            pg8::EpiSwigluR E{(bf16*)(ws + WS_BIG), FF_, (const float*)(ws + WS_RSTD)};
            pg8::gemm_phase<pg8::EpiSwigluR, pg8::StaticOrder, true, true>(lds3, g, S, E);
        }
#endif
        XSYNC(); }
#ifndef NO_DOWN
        { ArgsP a = fresh_args(); unsigned char* ws = a->ws;
            pg8::Gemm g{(const bf16*)(ws + WS_BIG), (const bf16*)(ws + WS_WDN) + (size_t)L * D_ * FF_, M_, D_, FF_}; pg8::StaticOrder S; S.init(M_, D_, gdim_fresh(), bid_fresh());
            if (L == 3) { pg8::EpiResidT<true, false> E{ws + WS_ST, a->out, D_, nullptr}; pg8::gemm_phase<pg8::EpiResidT<true, false>, pg8::StaticOrder, true, true>(lds3, g, S, E); }
            else { pg8::EpiResidT<true, true> E{a->out, a->out, D_, nullptr}; pg8::gemm_phase<pg8::EpiResidT<true, true>, pg8::StaticOrder, true, true>(lds3, g, S, E); }
        }
#endif
        XSYNC();
    }
}

extern "C" void kernel_launch(void* const* d_in, const int* in_sizes, int n_in, void* d_out, int out_size, void* d_ws, size_t ws_size, hipStream_t stream) {
    static int grid = 0;
    if (grid == 0) {
        if (n_in != 22 || ws_size < WS_END) { fprintf(stderr, "kernel_launch: unexpected n_in %d / ws %zu\n", n_in, ws_size); grid = -1; return; }
        int dev = 0, cus = 0, per_cu = 0;
        (void)hipGetDevice(&dev); (void)hipDeviceGetAttribute(&cus, hipDeviceAttributeMultiprocessorCount, dev);
        (void)hipFuncSetAttribute((const void*)fwd_kernel, hipFuncAttributeMaxDynamicSharedMemorySize, LDS_BYTES);
        (void)hipOccupancyMaxActiveBlocksPerMultiprocessor(&per_cu, (const void*)fwd_kernel, 512, LDS_BYTES);
        (void)hipGetLastError();
        if (per_cu < 1) per_cu = 1;
        grid = cus * per_cu;
        fprintf(stderr, "kernel_launch: cus %d per_cu %d grid %d\n", cus, per_cu, grid);
    }
    if (grid < 0) return;
    (void)hipMemsetAsync((char*)d_ws + WS_CTL, 0, 65536, stream);
    Args a{};
    for (int i = 0; i < 22; ++i) a.in[i] = (const float*)d_in[i];
    a.out = (float*)d_out; a.ws = (unsigned char*)d_ws;
    void* args[] = {&a};
    hipError_t e = hipLaunchCooperativeKernel((const void*)fwd_kernel, dim3(grid), dim3(512), args, LDS_BYTES, stream);
    if (e != hipSuccess) fprintf(stderr, "cooperative launch failed: %s (grid %d)\n", hipGetErrorString(e), grid);
}
```

```cpp
#include <hip/hip_runtime.h>
#include <hip/hip_cooperative_groups.h>
#include <cstdio>
#include <cstdint>
#include <cmath>
namespace cg = cooperative_groups;
#ifndef RU_STAGE
#define RU_STAGE 1
#endif
#ifndef RU_G
#define RU_G 1
#endif
#ifndef RU_O
#define RU_O 1
#endif
#ifndef RU_FIN
#define RU_FIN 1
#endif
__device__ __forceinline__ int tid_fresh() { int t = threadIdx.x; asm volatile("" : "+v"(t)); return t; }
__device__ __forceinline__ int bid_fresh() { int t = blockIdx.x; asm volatile("" : "+s"(t)); return t; }
__device__ __forceinline__ int gdim_fresh() { int t = gridDim.x; asm volatile("" : "+s"(t)); return t; }
namespace pg8 {
#define PG8_LAS __attribute__((address_space(3)))
typedef unsigned short bf16_t;
typedef short bf16x8 __attribute__((ext_vector_type(8)));
typedef float f32x4 __attribute__((ext_vector_type(4)));
typedef unsigned u32x4 __attribute__((ext_vector_type(4)));
constexpr int BM = 256, BK = 64, HALF = 128, HTB = HALF * BK * 2  , STAGE_BYTES = 8 * HTB, NXCD = 8, WGM = 8;

__host__ __device__ __forceinline__ int lds_byte(int r, int c) { const int st = (r >> 4) * 2 + (c >> 5), rr = r & 15, cc = c & 31, ob = rr * 64 + cc * 2; return st * 1024 + (ob ^ (((ob >> 9) & 1) << 5)); }
__host__ __device__ __forceinline__ void stage_rc(int b, int& R, int& C) { const int st = b / 1024, sb = b % 1024, swz = sb ^ (((sb >> 9) & 1) << 5); R = (st >> 1) * 16 + swz / 64; C = (st & 1) * 32 + (swz % 64) / 2; }
__host__ __device__ __forceinline__ int perm32(int rho) { const int n = rho >> 4, i = rho & 15; return 8 * (i >> 2) + 4 * n + (i & 3); }

struct Unit { int pm, pn; };
struct Gemm { const bf16_t* A; const bf16_t* Bt; int M, N, K; };

struct StaticOrder {
    int nM, nN, nwg, G, c;
    __host__ __device__ void init(int M, int N, int G_, int c_) { nM = M / BM; nN = N / BM; nwg = nM * nN; G = G_; c = c_; }
    __host__ __device__ bool next(int i, Unit& u) const {
        const long L = (long)i * G + c; if (L >= nwg) return false;
        int wgid = (int)L; { const int q = nwg / NXCD, r = nwg % NXCD, xcd = wgid % NXCD, off = wgid / NXCD; wgid = (xcd < r ? xcd * (q + 1) : r * (q + 1) + (xcd - r) * q) + off; }
        const int nig = WGM * nN, gid = wgid / nig, fm = gid * WGM, gsz = (nM - fm) < WGM ? (nM - fm) : WGM;
        u.pm = fm + ((wgid % nig) % gsz); u.pn = (wgid % nig) / gsz; return true;
    }
    __device__ __forceinline__ void a_ready(const Unit&) const {}
    __device__ __forceinline__ void done(const Unit&) const {}
};

__device__ __forceinline__ unsigned cvt_pk_bf16(float lo, float hi) { unsigned r; asm volatile("v_cvt_pk_bf16_f32 %0, %1, %2" : "=v"(r) : "v"(lo), "v"(hi)); return r; }
typedef float f32x2 __attribute__((ext_vector_type(2)));
__device__ __forceinline__ f32x2 gelu_pk(f32x2 v) {
    const f32x2 av = __builtin_elementwise_abs(v), d = av * 0.2316418882f + 1.0f;
    f32x2 t; t.x = __builtin_amdgcn_rcpf(d.x); t.y = __builtin_amdgcn_rcpf(d.y);
    f32x2 q = t * 0.5307027145f + (-0.7265760135f); q = q * t + 0.7107068705f; q = q * t + (-0.142248368f); q = q * t + 0.127414796f; q = q * t;
    const f32x2 s = (v * v) * (-0.72134752044f);
    f32x2 e; e.x = __builtin_amdgcn_exp2f(s.x); e.y = __builtin_amdgcn_exp2f(s.y);
    const f32x2 m = v * (q * e), r = v - m;
    f32x2 o; o.x = v.x < 0.f ? m.x : r.x; o.y = v.y < 0.f ? m.y : r.y; return o;
}

template <int ACT  > struct EpiBf16 {
    static constexpr bool PERM = true, AFTER_DRAIN = false; static_assert(ACT == 0 || ACT == 1, "EpiBf16: ACT is 0 (none) or 1 (gelu_pk)");
    bf16_t* O; int ldc; const float* bias; int split_cols; size_t split_stride; float scale0;
    __device__ __forceinline__ void operator()(const f32x4 (&acc)[2][2][4][2], const Unit& u, int wr, int wc, int fr, int fq) const {
        const int row0 = u.pm * BM + wr * 64 + fr; int colt = u.pn * BM; bf16_t* base = O;
        float sc = 1.f; if (split_cols) { const int t = colt / split_cols; base += (size_t)t * split_stride; colt -= t * split_cols; if (t == 0) sc = scale0; }
        const int col0 = colt + wc * 32 + 8 * fq, bcol0 = u.pn * BM + wc * 32 + 8 * fq;
        f32x4 bv[2][2];
#pragma unroll
        for (int bj = 0; bj < 2; ++bj)
#pragma unroll
            for (int n = 0; n < 2; ++n) bv[bj][n] = bias ? *(const f32x4*)(bias + bcol0 + bj * HALF + 4 * n) : (f32x4){0.f, 0.f, 0.f, 0.f};
#pragma unroll
        for (int ai = 0; ai < 2; ++ai)
#pragma unroll
            for (int m = 0; m < 4; ++m) { bf16_t* rowp = base + (size_t)(row0 + ai * HALF + m * 16) * ldc + col0;
#pragma unroll
                for (int bj = 0; bj < 2; ++bj) { f32x4 v0 = acc[ai][bj][m][0] + bv[bj][0], v1 = acc[ai][bj][m][1] + bv[bj][1];
                    if (ACT == 1) { f32x2 a = gelu_pk((f32x2){v0[0], v0[1]}), b = gelu_pk((f32x2){v0[2], v0[3]}), c = gelu_pk((f32x2){v1[0], v1[1]}), d = gelu_pk((f32x2){v1[2], v1[3]});
                        v0 = (f32x4){a.x, a.y, b.x, b.y}; v1 = (f32x4){c.x, c.y, d.x, d.y}; }
                    v0 = v0 * sc; v1 = v1 * sc; u32x4 w; w.x = cvt_pk_bf16(v0[0], v0[1]); w.y = cvt_pk_bf16(v0[2], v0[3]); w.z = cvt_pk_bf16(v1[0], v1[1]); w.w = cvt_pk_bf16(v1[2], v1[3]);
                    *(u32x4*)(rowp + bj * HALF) = w; } }
    }
};

template <class Epi, class Sched, bool ALIGN_EPI = false, bool SP2 = false>
__device__ __forceinline__ void gemm_phase(PG8_LAS unsigned char* lds, const Gemm g, const Sched& S, const Epi& E) {
    const int tid = tid_fresh(), wid = __builtin_amdgcn_readfirstlane(tid >> 6), lane = tid & 63, wr = wid >> 2, wc = wid & 3, fr = lane & 15, fq = lane >> 4;
    const int K = g.K, nt = K / BK;
    unsigned voffA[2], voffB[2];
#pragma unroll
    for (int i = 0; i < 2; ++i) { int R, C; stage_rc(tid * 16 + i * 8192, R, C); const int Rb = Epi::PERM ? ((R & ~31) + perm32(R & 31)) : R;
        voffA[i] = (unsigned)(R * K + C) * 2u; voffB[i] = (unsigned)(Rb * K + C) * 2u; }
    const size_t kstep = (size_t)(BK * 2);
    const size_t hstep = (size_t)HALF * K * 2;
    const size_t tstep = 2 * hstep;
    const unsigned ldsw = (unsigned)wid * 1024u;
    const int aoff = lds_byte(wr * 64 + fr, fq * 8), boff = lds_byte(wc * 32 + fr, fq * 8);
#define PG8_SA(b, h) (((b) * 2 + (h)) * HTB)
#define PG8_SB(b, h) ((4 + (b) * 2 + (h)) * HTB)
#define PG8_STAGE(bufoff, gbase, voff) do { _Pragma("unroll") for (int _i = 0; _i < 2; ++_i) \
        __builtin_amdgcn_global_load_lds((const unsigned*)((const char*)(gbase) + (voff)[_i]), (PG8_LAS unsigned*)(lds + (bufoff) + ldsw + _i * 8192), 16, 0, 0); } while (0)
#define PG8_LDA(dst, b, h) do { _Pragma("unroll") for (int m = 0; m < 4; ++m) _Pragma("unroll") for (int k = 0; k < 2; ++k) dst[m][k] = *(const PG8_LAS bf16x8*)(lds + PG8_SA(b, h) + aoff + m * 2048 + k * 1024); } while (0)
#define PG8_LDB(dst, b, h) do { _Pragma("unroll") for (int n = 0; n < 2; ++n) _Pragma("unroll") for (int k = 0; k < 2; ++k) dst[n][k] = *(const PG8_LAS bf16x8*)(lds + PG8_SB(b, h) + boff + n * 2048 + k * 1024); } while (0)
#define PG8_MMA(ai, bj, At, Bt) do { __builtin_amdgcn_s_setprio(1); _Pragma("unroll") for (int m = 0; m < 4; ++m) _Pragma("unroll") for (int n = 0; n < 2; ++n) _Pragma("unroll") for (int k = 0; k < 2; ++k) \
        acc[ai][bj][m][n] = __builtin_amdgcn_mfma_f32_16x16x32_bf16(Bt[n][k], At[m][k], acc[ai][bj][m][n], 0, 0, 0); __builtin_amdgcn_s_setprio(0); } while (0)
#define PG8_WAIT_V(n) asm volatile("s_waitcnt vmcnt(" #n ")" ::: "memory")
#define PG8_WAIT_L(n) asm volatile("s_waitcnt lgkmcnt(" #n ")" ::: "memory")
#define PG8_BAR __builtin_amdgcn_s_barrier()
#define PG8_SCHED __builtin_amdgcn_sched_barrier(0)
    Unit cur, nxt; int ui = 0;
    if (!S.next(0, cur)) return;
    f32x4 acc[2][2][4][2];
#pragma unroll
    for (int a = 0; a < 2; ++a)
#pragma unroll
        for (int b = 0; b < 2; ++b)
#pragma unroll
            for (int m = 0; m < 4; ++m)
#pragma unroll
                for (int n = 0; n < 2; ++n) acc[a][b][m][n] = (f32x4){0.f, 0.f, 0.f, 0.f};
    bf16x8 At[4][2], B0[2][2], B1[2][2];
    const char* cA = (const char*)g.A + (size_t)cur.pm * tstep; const char* cB = (const char*)g.Bt + (size_t)cur.pn * tstep;
    S.a_ready(cur);
    if constexpr (SP2) {
        PG8_STAGE(PG8_SB(0, 0), cB, voffB); PG8_STAGE(PG8_SB(0, 1), cB + hstep, voffB); PG8_STAGE(PG8_SA(0, 0), cA, voffA); PG8_STAGE(PG8_SA(0, 1), cA + hstep, voffA);
        if (wr == 1) PG8_BAR;
        PG8_WAIT_V(2); PG8_BAR;
        PG8_STAGE(PG8_SB(1, 0), cB + kstep, voffB); PG8_STAGE(PG8_SA(1, 0), cA + kstep, voffA); PG8_STAGE(PG8_SB(1, 1), cB + hstep + kstep, voffB);
        PG8_WAIT_V(6); PG8_BAR;
    } else {
        PG8_STAGE(PG8_SB(0, 0), cB, voffB); PG8_STAGE(PG8_SA(0, 0), cA, voffA); PG8_STAGE(PG8_SB(0, 1), cB + hstep, voffB); PG8_STAGE(PG8_SA(0, 1), cA + hstep, voffA);
        if (wr == 1) PG8_BAR;
        PG8_WAIT_V(4); PG8_BAR;
        PG8_STAGE(PG8_SB(1, 0), cB + kstep, voffB); PG8_STAGE(PG8_SA(1, 0), cA + kstep, voffA); PG8_STAGE(PG8_SB(1, 1), cB + hstep + kstep, voffB);
        PG8_WAIT_V(6); PG8_BAR;
    }
    for (;;) {
        const bool has_next = S.next(ui + 1, nxt);
        const char* nA = has_next ? (const char*)g.A + (size_t)nxt.pm * tstep : cA; const char* nB = has_next ? (const char*)g.Bt + (size_t)nxt.pn * tstep : cB;
        for (int t = 0; t < nt; t += 2) {
            const bool last = (t == nt - 2);
            const char* a1 = cA + (size_t)(t + 1) * kstep;
            const char* a2 = last ? nA : cA + (size_t)(t + 2) * kstep; const char* b2 = last ? nB : cB + (size_t)(t + 2) * kstep;
            const char* a3 = a2 + kstep; const char* b3 = b2 + kstep;
            if (last && has_next) S.a_ready(nxt);
            if constexpr (SP2) {
            PG8_LDB(B0, 0, 0); PG8_LDB(B1, 0, 1); PG8_SCHED; PG8_LDA(At, 0, 0); PG8_STAGE(PG8_SA(1, 1), a1 + hstep, voffA);
            PG8_WAIT_V(8); PG8_WAIT_L(0); PG8_BAR; PG8_MMA(0, 0, At, B0); PG8_MMA(0, 1, At, B1); PG8_BAR; PG8_SCHED;
            PG8_LDA(At, 0, 1); PG8_STAGE(PG8_SB(0, 0), b2, voffB); PG8_STAGE(PG8_SB(0, 1), b2 + hstep, voffB); PG8_STAGE(PG8_SA(0, 0), a2, voffA);
            PG8_WAIT_V(8); PG8_WAIT_L(0); PG8_BAR; PG8_MMA(1, 0, At, B0); PG8_MMA(1, 1, At, B1); PG8_BAR; PG8_SCHED;
            PG8_LDB(B0, 1, 0); PG8_LDB(B1, 1, 1); PG8_SCHED; PG8_LDA(At, 1, 0); PG8_STAGE(PG8_SA(0, 1), a2 + hstep, voffA);
            PG8_WAIT_V(8); PG8_WAIT_L(0); PG8_BAR; PG8_MMA(0, 0, At, B0); PG8_MMA(0, 1, At, B1); PG8_BAR; PG8_SCHED;
            PG8_LDA(At, 1, 1); PG8_STAGE(PG8_SB(1, 0), b3, voffB); PG8_STAGE(PG8_SB(1, 1), b3 + hstep, voffB); PG8_STAGE(PG8_SA(1, 0), a3, voffA);
            PG8_WAIT_V(8); PG8_WAIT_L(0); PG8_BAR; PG8_MMA(1, 0, At, B0); PG8_MMA(1, 1, At, B1); PG8_BAR; PG8_SCHED;
            } else {
            PG8_LDB(B0, 0, 0); PG8_SCHED; PG8_LDA(At, 0, 0); PG8_STAGE(PG8_SA(1, 1), a1 + hstep, voffA);
            PG8_WAIT_L(8); PG8_BAR; PG8_WAIT_L(0); PG8_MMA(0, 0, At, B0); PG8_BAR; PG8_SCHED;
            PG8_LDB(B1, 0, 1); PG8_STAGE(PG8_SB(0, 0), b2, voffB);
            PG8_BAR; PG8_WAIT_L(0); PG8_MMA(0, 1, At, B1); PG8_BAR;
            PG8_LDA(At, 0, 1); PG8_STAGE(PG8_SA(0, 0), a2, voffA);
            PG8_BAR; PG8_WAIT_L(0); PG8_MMA(1, 0, At, B0); PG8_BAR; PG8_SCHED;
            PG8_STAGE(PG8_SB(0, 1), b2 + hstep, voffB);
            PG8_WAIT_V(6); PG8_BAR; PG8_MMA(1, 1, At, B1); PG8_BAR;
            PG8_LDB(B0, 1, 0); PG8_SCHED; PG8_LDA(At, 1, 0); PG8_STAGE(PG8_SA(0, 1), a2 + hstep, voffA);
            PG8_WAIT_L(8); PG8_BAR; PG8_WAIT_L(0); PG8_MMA(0, 0, At, B0); PG8_BAR; PG8_SCHED;
            PG8_LDB(B1, 1, 1); PG8_STAGE(PG8_SB(1, 0), b3, voffB);
            PG8_BAR; PG8_WAIT_L(0); PG8_MMA(0, 1, At, B1); PG8_BAR;
            PG8_LDA(At, 1, 1); PG8_STAGE(PG8_SA(1, 0), a3, voffA);
            PG8_BAR; PG8_WAIT_L(0); PG8_MMA(1, 0, At, B0); PG8_BAR; PG8_SCHED;
            PG8_STAGE(PG8_SB(1, 1), b3 + hstep, voffB);
            PG8_WAIT_V(6); PG8_BAR; PG8_MMA(1, 1, At, B1); PG8_BAR;
            }
        }
        if constexpr (ALIGN_EPI) { if (wr == 0) PG8_BAR; }
        if constexpr (!Epi::AFTER_DRAIN) { E(acc, cur, wr, wc, fr, fq); S.done(cur); }
        if (!has_next) break;
#pragma unroll
        for (int a = 0; a < 2; ++a)
#pragma unroll
            for (int b = 0; b < 2; ++b)
#pragma unroll
                for (int m = 0; m < 4; ++m)
#pragma unroll
                    for (int n = 0; n < 2; ++n) acc[a][b][m][n] = (f32x4){0.f, 0.f, 0.f, 0.f};
        cur = nxt; cA = nA; cB = nB; ++ui;
        if constexpr (ALIGN_EPI) { if (wr == 1) PG8_BAR; }
    }
    PG8_WAIT_V(0);
    if constexpr (!ALIGN_EPI) { if (wr == 0) PG8_BAR; }
    PG8_BAR;
    if constexpr (Epi::AFTER_DRAIN) { E.fused(acc, cur, wr, wc, fr, fq, lds, wid, lane); S.done(cur); }
#undef PG8_SA
#undef PG8_SB
#undef PG8_STAGE
#undef PG8_LDA
#undef PG8_LDB
#undef PG8_MMA
#undef PG8_WAIT_V
#undef PG8_WAIT_L
#undef PG8_BAR
#undef PG8_SCHED
}
}

namespace pg8 {
__device__ __forceinline__ float silu_f(float x) { return x * __builtin_amdgcn_rcpf(1.0f + __builtin_amdgcn_exp2f(-1.4426950408889634f * x)); }
struct EpiSwiglu {
    static constexpr bool PERM = true, AFTER_DRAIN = false;
    bf16_t* O; int ldc;
    __device__ __forceinline__ void operator()(const f32x4 (&acc)[2][2][4][2], const Unit& u, int wr, int wc, int fr, int fq) const {
        const int row0 = u.pm * BM + wr * 64 + fr; const int col0 = u.pn * HALF + wc * 32 + 8 * fq;
#pragma unroll
        for (int ai = 0; ai < 2; ++ai)
#pragma unroll
            for (int m = 0; m < 4; ++m) { bf16_t* rowp = O + (size_t)(row0 + ai * HALF + m * 16) * ldc + col0;
                const f32x4 g0 = acc[ai][0][m][0], g1 = acc[ai][0][m][1], u0 = acc[ai][1][m][0], u1 = acc[ai][1][m][1];
                f32x4 v0, v1;
#pragma unroll
                for (int i = 0; i < 4; ++i) { v0[i] = silu_f(g0[i]) * u0[i]; v1[i] = silu_f(g1[i]) * u1[i]; }
                u32x4 w; w.x = cvt_pk_bf16(v0[0], v0[1]); w.y = cvt_pk_bf16(v0[2], v0[3]); w.z = cvt_pk_bf16(v1[0], v1[1]); w.w = cvt_pk_bf16(v1[2], v1[3]);
                *(u32x4*)rowp = w; }
    }
};
struct EpiSwigluR {
    static constexpr bool PERM = true, AFTER_DRAIN = false;
    bf16_t* O; int ldc; const float* rstd;
    __device__ __forceinline__ void operator()(const f32x4 (&acc)[2][2][4][2], const Unit& u, int wr, int wc, int fr, int fq) const {
        const int row0 = u.pm * BM + wr * 64 + fr; const int col0 = u.pn * HALF + wc * 32 + 8 * fq;
        float rs[2][4];
        { const f32x4 r0 = *(const f32x4*)(rstd + u.pm * BM + (wr * 16 + fr) * 8), r1 = *(const f32x4*)(rstd + u.pm * BM + (wr * 16 + fr) * 8 + 4);
#pragma unroll
          for (int m = 0; m < 4; ++m) { rs[0][m] = r0[m]; rs[1][m] = r1[m]; } }
#pragma unroll
        for (int ai = 0; ai < 2; ++ai)
#pragma unroll
            for (int m = 0; m < 4; ++m) { bf16_t* rowp = O + (size_t)(row0 + ai * HALF + m * 16) * ldc + col0; const float r = rs[ai][m];
                const f32x4 g0 = acc[ai][0][m][0] * r, g1 = acc[ai][0][m][1] * r, u0 = acc[ai][1][m][0] * r, u1 = acc[ai][1][m][1] * r;
                f32x4 v0, v1;
#pragma unroll
                for (int i = 0; i < 4; ++i) { v0[i] = silu_f(g0[i]) * u0[i]; v1[i] = silu_f(g1[i]) * u1[i]; }
                u32x4 w; w.x = cvt_pk_bf16(v0[0], v0[1]); w.y = cvt_pk_bf16(v0[2], v0[3]); w.z = cvt_pk_bf16(v1[0], v1[1]); w.w = cvt_pk_bf16(v1[2], v1[3]);
                *(u32x4*)rowp = w; }
    }
};
struct EpiBf16BlkR {
    static constexpr bool PERM = true, AFTER_DRAIN = false;
    bf16_t* O; int Mrows; const float* rstd;
    __device__ __forceinline__ void operator()(const f32x4 (&acc)[2][2][4][2], const Unit& u, int wr, int wc, int fr, int fq) const {
        const int row0 = u.pm * BM + wr * 64 + fr; const int col0 = wc * 32 + 8 * fq;
        float rs[2][4];
        { const f32x4 r0 = *(const f32x4*)(rstd + u.pm * BM + (wr * 16 + fr) * 8), r1 = *(const f32x4*)(rstd + u.pm * BM + (wr * 16 + fr) * 8 + 4);
#pragma unroll
          for (int m = 0; m < 4; ++m) { rs[0][m] = r0[m]; rs[1][m] = r1[m]; } }
#pragma unroll
        for (int ai = 0; ai < 2; ++ai)
#pragma unroll
            for (int m = 0; m < 4; ++m) { const int row = row0 + ai * HALF + m * 16; const float r = rs[ai][m];
#pragma unroll
                for (int bj = 0; bj < 2; ++bj) { const f32x4 v0 = acc[ai][bj][m][0] * r, v1 = acc[ai][bj][m][1] * r;
                    u32x4 w; w.x = cvt_pk_bf16(v0[0], v0[1]); w.y = cvt_pk_bf16(v0[2], v0[3]); w.z = cvt_pk_bf16(v1[0], v1[1]); w.w = cvt_pk_bf16(v1[2], v1[3]);
                    *(u32x4*)(O + ((size_t)u.pn * Mrows + row) * 256 + bj * HALF + col0) = w; } }
    }
};
template <bool BIN, bool BOUT> struct EpiResidT {
    static constexpr bool PERM = true, AFTER_DRAIN = false;
    const void* base; void* out; int ldc; float* rsp;
    __device__ __forceinline__ void operator()(const f32x4 (&acc)[2][2][4][2], const Unit& u, int wr, int wc, int fr, int fq) const {
        const int row0 = u.pm * BM + wr * 64 + fr; const int col0 = u.pn * BM + wc * 32 + 8 * fq;
#pragma unroll
        for (int ai = 0; ai < 2; ++ai) {
            f32x4 bs[4][2][2];
#pragma unroll
            for (int m = 0; m < 4; ++m) { const size_t off = (size_t)(row0 + ai * HALF + m * 16) * ldc + col0;
#pragma unroll
                for (int bj = 0; bj < 2; ++bj) {
                    if (BIN) { const u32x4 w = *(const u32x4*)((const bf16_t*)base + off + bj * HALF);
                        bs[m][bj][0] = (f32x4){__uint_as_float(w.x << 16), __uint_as_float(w.x & 0xffff0000u), __uint_as_float(w.y << 16), __uint_as_float(w.y & 0xffff0000u)};
                        bs[m][bj][1] = (f32x4){__uint_as_float(w.z << 16), __uint_as_float(w.z & 0xffff0000u), __uint_as_float(w.w << 16), __uint_as_float(w.w & 0xffff0000u)}; }
                    else { bs[m][bj][0] = *(const f32x4*)((const float*)base + off + bj * HALF); bs[m][bj][1] = *(const f32x4*)((const float*)base + off + bj * HALF + 4); } } }
#pragma unroll
            for (int m = 0; m < 4; ++m) { const size_t off = (size_t)(row0 + ai * HALF + m * 16) * ldc + col0; float ss = 0.f;
#pragma unroll
                for (int bj = 0; bj < 2; ++bj) { const f32x4 o0 = bs[m][bj][0] + acc[ai][bj][m][0], o1 = bs[m][bj][1] + acc[ai][bj][m][1];
                    ss += ((o0[0] * o0[0] + o0[1] * o0[1]) + (o0[2] * o0[2] + o0[3] * o0[3])) + ((o1[0] * o1[0] + o1[1] * o1[1]) + (o1[2] * o1[2] + o1[3] * o1[3]));
                    if (BOUT) { u32x4 w; w.x = cvt_pk_bf16(o0[0], o0[1]); w.y = cvt_pk_bf16(o0[2], o0[3]); w.z = cvt_pk_bf16(o1[0], o1[1]); w.w = cvt_pk_bf16(o1[2], o1[3]); *(u32x4*)((bf16_t*)out + off + bj * HALF) = w; }
                    else { *(f32x4*)((float*)out + off + bj * HALF) = o0; *(f32x4*)((float*)out + off + bj * HALF + 4) = o1; } }
                if (rsp) { ss += __shfl_xor(ss, 16); ss += __shfl_xor(ss, 32); if (fq == 0) rsp[(size_t)(row0 + ai * HALF + m * 16) * 16 + u.pn * 4 + wc] = ss; } }
            asm volatile("" ::: "memory");
        }
    }
};
}

#define LAS __attribute__((address_space(3)))
typedef unsigned short bf16;
typedef unsigned u32x4 __attribute__((ext_vector_type(4)));
typedef unsigned u32x2 __attribute__((ext_vector_type(2)));
typedef float f32x4 __attribute__((ext_vector_type(4)));
typedef float f32x2_t __attribute__((ext_vector_type(2)));

constexpr int M_ = 32768, D_ = 1024, T_ = 4096, FF_ = 2816;
constexpr int AB_N = 2816, AB_LD = 2824, CD_N = 3584, CD_LD = 3588;
constexpr float EPS_ = 1e-6f;
constexpr size_t MiB = 1u << 20;
constexpr size_t WS_CTL = 0, WS_ROPE = 1 * MiB, WS_GATE = 2 * MiB, WS_CUMF = 3 * MiB,
    WS_WABIN = 4 * MiB, WS_WABOUT = 15 * MiB, WS_WCDIN = 19 * MiB, WS_WCDOUT = 33 * MiB, WS_WGU = 37 * MiB, WS_WDN = 81 * MiB,
    WS_UY = 104 * MiB, WS_BIG = 168 * MiB, WS_ST = 392 * MiB, WS_END = 512 * MiB;
#define BIGX(row, col) ((((size_t)((col) >> 8)) * M_ + (size_t)(row)) * 256 + ((col) & 255))
constexpr size_t WS_RSTD1 = WS_CUMF + 512 * 1024;
constexpr size_t WS_RSP = WS_ST + 100 * MiB, WS_RSTD = WS_ST + 103 * MiB;
constexpr int LDS_BYTES = 147456;

struct Args { const float* in[22]; float* out; unsigned char* ws; };
typedef const Args __attribute__((address_space(4)))* ArgsP;
__device__ __forceinline__ ArgsP fresh_args() { auto p = __builtin_amdgcn_kernarg_segment_ptr(); asm volatile("" : "+s"(p)); return (ArgsP)p; }

typedef __bf16 bf16x2_hw __attribute__((ext_vector_type(2)));
__device__ __forceinline__ unsigned pk2(float lo, float hi) { f32x2_t v = {lo, hi}; bf16x2_hw b = __builtin_convertvector(v, bf16x2_hw); return __builtin_bit_cast(unsigned, b); }
__device__ __forceinline__ unsigned f2bf(float f) { return pk2(f, 0.f) & 0xffffu; }
__device__ __forceinline__ float bflo(unsigned u) { return __uint_as_float(u << 16); }
__device__ __forceinline__ float bfhi(unsigned u) { return __uint_as_float(u & 0xffff0000u); }
__device__ __forceinline__ float bf2f(bf16 v) { return __uint_as_float(((unsigned)v) << 16); }
__device__ __forceinline__ float siluf(float x) { return x * __builtin_amdgcn_rcpf(1.f + __builtin_amdgcn_exp2f(-1.4426950408889634f * x)); }
__device__ __forceinline__ float sigmf(float x) { return __builtin_amdgcn_rcpf(1.f + __builtin_amdgcn_exp2f(-1.4426950408889634f * x)); }
__device__ __forceinline__ float softplusf(float x) { return x > 20.f ? x : log1pf(expf(x)); }
__device__ __forceinline__ float logsigf(float x) { return fminf(x, 0.f) - log1pf(expf(-fabsf(x))); }
__device__ __forceinline__ float wave_sum(float v) {
#pragma unroll
    for (int o = 1; o < 64; o <<= 1) v += __shfl_xor(v, o);
    return v;
}
#define LDS_WAIT() asm volatile("s_waitcnt lgkmcnt(0)" ::: "memory")
#define LBAR() do { asm volatile("s_waitcnt lgkmcnt(0)" ::: "memory"); __builtin_amdgcn_s_barrier(); asm volatile("" ::: "memory"); } while (0)

#define XB_TMO      128
#define XB_XCNT(j)  (256  + 64 * (j))
#define XB_XSUB(j)  (1280 + 64 * (j))
#define XB_XGEN(j)  (2304 + 64 * (j))
#define XB_TOP      3328
#define XB_TOPGEN   3392
#define XCD_BAR_WORDS 3456
#define XB_SPIN_CAP (1u << 18)

__device__ __forceinline__ unsigned xb_ld(unsigned* p)              { return __hip_atomic_load(p, __ATOMIC_RELAXED, __HIP_MEMORY_SCOPE_AGENT); }
__device__ __forceinline__ unsigned xb_add(unsigned* p, unsigned v) { return __hip_atomic_fetch_add(p, v, __ATOMIC_RELAXED, __HIP_MEMORY_SCOPE_AGENT); }
__device__ __forceinline__ unsigned xb_xcc_id() { return (unsigned)__builtin_amdgcn_s_getreg((3 << 11) | 20) & 0xFu; }
#define XB_SPIN(cond, bar) do { unsigned _sp = 0; while (cond) { __builtin_amdgcn_s_sleep(1); \
    if ((++_sp & 255u) == 0u) { if (xb_ld(&(bar)[XB_TMO])) break; if (_sp > XB_SPIN_CAP) { atomicAdd(&(bar)[XB_TMO], 1u); break; } } } } while (0)

struct XcdBarrier {
    unsigned* bar; unsigned x;
    volatile LAS unsigned* st;
};

__device__ __forceinline__ XcdBarrier xcd_barrier_post(unsigned* bar, volatile LAS unsigned* st) {
    XcdBarrier b; b.bar = bar; b.x = xb_xcc_id(); b.st = st;
    if (threadIdx.x == 0) (void)xb_add(&bar[XB_XCNT(b.x)], 1u);
    return b;
}
__device__ __forceinline__ void xcd_barrier_complete(unsigned* bar, unsigned x, unsigned& nloc, unsigned& nx) {
    const unsigned G = gridDim.x * gridDim.y * gridDim.z;
    unsigned sum, cnt, mine, sp = 0u;
    for (;;) {
        sum = 0u; cnt = 0u; mine = 0u;
#pragma unroll
        for (unsigned j = 0; j < 16; ++j) { const unsigned c = xb_ld(&bar[XB_XCNT(j)]); sum += c; cnt += (c > 0u) ? 1u : 0u; mine = (j == x) ? c : mine; }
        if (sum == G) break;
        __builtin_amdgcn_s_sleep(1);
        if ((++sp & 255u) == 0u) { if (xb_ld(&bar[XB_TMO])) break; if (sp > XB_SPIN_CAP) { atomicAdd(&bar[XB_TMO], 1u); break; } }
    }
    nloc = mine > 0u ? mine : 1u; nx = cnt > 0u ? cnt : 1u;
}

__device__ __forceinline__ void xcd_barrier(const XcdBarrier& b) {
    asm volatile("s_waitcnt vmcnt(0)" ::: "memory");
    __syncthreads();
    if (threadIdx.x == 0) {
        unsigned* bar = b.bar;
        __builtin_amdgcn_s_waitcnt(0);
        unsigned nloc = b.st[0], nx = b.st[1];
        if (nloc == 0u) { xcd_barrier_complete(bar, b.x, nloc, nx); b.st[0] = nloc; b.st[1] = nx; }
        const unsigned old = xb_add(&bar[XB_XSUB(b.x)], 1u);
        const unsigned gen = old / nloc;
        if (old + 1u == (gen + 1u) * nloc) {
            __builtin_amdgcn_fence(__ATOMIC_RELEASE, "agent");
            asm volatile("s_waitcnt vmcnt(0)" ::: "memory");
            const unsigned og = xb_add(&bar[XB_TOP], 1u);
            const unsigned tg = og / nx;
            if (og + 1u == (tg + 1u) * nx) xb_add(&bar[XB_TOPGEN], 1u);
            else XB_SPIN(xb_ld(&bar[XB_TOPGEN]) == tg, bar);
            __builtin_amdgcn_fence(__ATOMIC_ACQUIRE, "agent");
            xb_add(&bar[XB_XGEN(b.x)], 1u);
            asm volatile("s_waitcnt vmcnt(0)" ::: "memory");
        } else {
            XB_SPIN(xb_ld(&bar[XB_XGEN(b.x)]) == gen, bar);
            __builtin_amdgcn_fence(__ATOMIC_ACQUIRE, "agent");
            asm volatile("s_waitcnt vmcnt(0)" ::: "memory");
        }
    }
    __syncthreads();
}

__device__ __forceinline__ void tr_matrix(const float* W, int ldw, int K, int N, bf16* WT, int mode, const float* kscale, float* scr, int gw, int NGW, int lane) {
    const int nblk = N / 32, nitems = (K / 64) * nblk;
    float nx[32];
    if (gw < nitems) { const int kb = gw / nblk, nb = gw % nblk;
#pragma unroll
        for (int i = 0; i < 32; ++i) { const int kk = 2 * i + (lane >> 5); nx[i] = W[(size_t)(64 * kb + kk) * ldw + 32 * nb + (lane & 31)]; } }
    for (int it = gw; it < nitems; it += NGW) {
        const int kb = it / nblk, nb = it % nblk, k0 = 64 * kb, n0 = 32 * nb;
#pragma unroll
        for (int i = 0; i < 32; ++i) { const int kk = 2 * i + (lane >> 5); scr[kk * 33 + (lane & 31)] = kscale ? nx[i] * kscale[k0 + kk] : nx[i]; }
        if (it + NGW < nitems) { const int kb2 = (it + NGW) / nblk, nb2 = (it + NGW) % nblk;
#pragma unroll
            for (int i = 0; i < 32; ++i) { const int kk = 2 * i + (lane >> 5); nx[i] = W[(size_t)(64 * kb2 + kk) * ldw + 32 * nb2 + (lane & 31)]; } }
        LDS_WAIT();
        const int c = lane & 7;
#pragma unroll
        for (int j = 0; j < 4; ++j) { const int nn = (lane >> 3) + 8 * j; const float* s = scr + (8 * c) * 33 + nn;
            u32x4 o; o.x = pk2(s[0 * 33], s[1 * 33]); o.y = pk2(s[2 * 33], s[3 * 33]); o.z = pk2(s[4 * 33], s[5 * 33]); o.w = pk2(s[6 * 33], s[7 * 33]);
            const int n = n0 + nn; const int r = (mode == 0) ? n : ((n >> 7) * 256 + (n & 127) + (mode == 2 ? 128 : 0));
            *(u32x4*)(WT + (size_t)r * K + k0 + 8 * c) = o; }
        LDS_WAIT();
    }
}

__device__ __forceinline__ void prologue(ArgsP a, unsigned char* lds) {
    const int tid = tid_fresh(), lane = tid & 63, wave = tid >> 6;
    const int gw = bid_fresh() * 8 + wave, NGW = gdim_fresh() * 8;
    float* scr = (float*)(lds + wave * 16384);
    unsigned char* ws = a->ws;
#pragma unroll 1
    for (int mi = 0; mi < 20; ++mi) {
        const float* W; int ldw, K, N, mode; bf16* WT; const float* ksc = nullptr;
        if (mi < 8) { const int jj = mi >> 2, t = mi & 3;
            if (t == 0)      { W = a->in[6] + (size_t)jj * D_ * AB_LD; ldw = AB_LD; K = D_; N = AB_N; WT = (bf16*)(ws + WS_WABIN) + (size_t)jj * AB_N * D_; ksc = a->in[1] + (2 * jj) * D_; }
            else if (t == 1) { W = a->in[7] + (size_t)jj * D_ * D_; ldw = D_; K = D_; N = D_; WT = (bf16*)(ws + WS_WABOUT) + (size_t)jj * D_ * D_; }
            else if (t == 2) { W = a->in[15] + (size_t)jj * D_ * CD_LD; ldw = CD_LD; K = D_; N = CD_N; WT = (bf16*)(ws + WS_WCDIN) + (size_t)jj * CD_N * D_; ksc = a->in[1] + (2 * jj + 1) * D_; }
            else             { W = a->in[16] + (size_t)jj * D_ * D_; ldw = D_; K = D_; N = D_; WT = (bf16*)(ws + WS_WCDOUT) + (size_t)jj * D_ * D_; }
            mode = 0;
        } else { const int L = (mi - 8) / 3, t = (mi - 8) % 3; bf16* gu = (bf16*)(ws + WS_WGU) + (size_t)L * 2 * FF_ * D_;
            if (t == 0)      { W = a->in[3] + (size_t)L * D_ * FF_; ldw = FF_; K = D_; N = FF_; WT = gu; mode = 1; ksc = a->in[2] + L * D_; }
            else if (t == 1) { W = a->in[4] + (size_t)L * D_ * FF_; ldw = FF_; K = D_; N = FF_; WT = gu; mode = 2; ksc = a->in[2] + L * D_; }
            else             { W = a->in[5] + (size_t)L * FF_ * D_; ldw = D_; K = FF_; N = D_; WT = (bf16*)(ws + WS_WDN) + (size_t)L * D_ * FF_; mode = 0; }
        }
        tr_matrix(W, ldw, K, N, WT, mode, ksc, scr, gw, NGW, lane);
    }
    float* rope = (float*)(ws + WS_ROPE);
    for (int idx = bid_fresh() * 512 + tid; idx < T_ * 32; idx += gdim_fresh() * 512) {
        const int t = idx >> 5, i = idx & 31;
        const float freq = powf(10000.0f, -(float)i / 31.0f);
        const float ang = (float)t * freq;
        rope[idx] = cosf(ang); rope[T_ * 32 + idx] = sinf(ang);
    }
}

__device__ __forceinline__ int rstd_slot(int row) { const int rr = row & 255; return (row & ~255) + ((((rr >> 6) & 1) * 16 + (rr & 15)) * 8 + (rr >> 7) * 4 + ((rr >> 4) & 3)); }
template <bool BIN, bool WRITE_U> __device__ __forceinline__ void norm_phase(const void* hin_, const float* gain, bf16* U, const float* Wg, int ldw, int goff, int ng, float* GATE, float* RSTD, unsigned char* lds) {
    const int tid = tid_fresh(), lane = tid & 63, wave = tid >> 6;
    float* wl = (float*)lds;
    if (ng > 0) {
        for (int idx = tid; idx < 1024 * 8; idx += 512) { const int k = idx >> 3, g = idx & 7; wl[idx] = (g < ng) ? Wg[(size_t)k * ldw + goff + g] * gain[k] : 0.f; }
    }
    __syncthreads();
    const int gw = bid_fresh() * 8 + wave, NGW = gdim_fresh() * 8;
    f32x4 gn[4];
#pragma unroll
    for (int j = 0; j < 4; ++j) gn[j] = ((const f32x4*)gain)[lane + 64 * j];
    f32x4 nxt[4], nx2[4];
#define NP_LOADROW(dst, r) do { if (BIN) { const u32x2* xr = (const u32x2*)((const bf16*)hin_ + (size_t)(r) * D_) + lane; \
            _Pragma("unroll") for (int j = 0; j < 4; ++j) { const u32x2 w = xr[64 * j]; dst[j] = (f32x4){bflo(w.x), bfhi(w.x), bflo(w.y), bfhi(w.y)}; } } \
        else { const f32x4* xr = (const f32x4*)((const float*)hin_ + (size_t)(r) * D_) + lane; _Pragma("unroll") for (int j = 0; j < 4; ++j) dst[j] = xr[64 * j]; } } while (0)
    if (gw < M_) NP_LOADROW(nxt, gw);
    if (gw + NGW < M_) NP_LOADROW(nx2, gw + NGW);
#pragma unroll 2
    for (int row = gw; row < M_; row += NGW) {
        f32x4 v[4]; float ss = 0.f;
#pragma unroll
        for (int j = 0; j < 4; ++j) { v[j] = nxt[j]; nxt[j] = nx2[j]; ss += (v[j].x * v[j].x + v[j].y * v[j].y) + (v[j].z * v[j].z + v[j].w * v[j].w); }
        if (row + 2 * NGW < M_) NP_LOADROW(nx2, row + 2 * NGW);
        const float rstd = rsqrtf(wave_sum(ss) * (1.f / D_) + EPS_);
        if (lane == 0) RSTD[rstd_slot(row)] = rstd;
        if (WRITE_U) { unsigned long long* o8 = (unsigned long long*)(U + (size_t)row * D_) + lane;
#pragma unroll
            for (int j = 0; j < 4; ++j) o8[64 * j] = (unsigned long long)pk2(v[j].x, v[j].y) | ((unsigned long long)pk2(v[j].z, v[j].w) << 32); }
        if (ng > 0) {
            float acc[8];
#pragma unroll
            for (int g = 0; g < 8; ++g) acc[g] = 0.f;
#pragma unroll
            for (int j = 0; j < 4; ++j)
#pragma unroll
                for (int e = 0; e < 4; ++e) { const int k = 4 * (lane + 64 * j) + e; const f32x4 w0 = *(const f32x4*)(wl + k * 8), w1 = *(const f32x4*)(wl + k * 8 + 4); const float x = v[j][e];
                    acc[0] += x * w0.x; acc[1] += x * w0.y; acc[2] += x * w0.z; acc[3] += x * w0.w; acc[4] += x * w1.x; acc[5] += x * w1.y; acc[6] += x * w1.z; acc[7] += x * w1.w; }
            float mine = 0.f;
#pragma unroll
            for (int g = 0; g < 8; ++g) { const float s = wave_sum(acc[g]) * rstd; if (lane == g) mine = s; }
            if (lane < 8) GATE[(size_t)row * 8 + lane] = mine;
        }
    }
}

__device__ __forceinline__ void rstd_phase(ArgsP a) {
    const float* rsp = (const float*)(a->ws + WS_RSP); float* rstd = (float*)(a->ws + WS_RSTD);
    for (int row = bid_fresh() * 512 + tid_fresh(); row < M_; row += gdim_fresh() * 512) {
        const f32x4 s0 = *(const f32x4*)(rsp + (size_t)row * 16), s1 = *(const f32x4*)(rsp + (size_t)row * 16 + 4), s2 = *(const f32x4*)(rsp + (size_t)row * 16 + 8), s3 = *(const f32x4*)(rsp + (size_t)row * 16 + 12);
        const float t = (((s0[0] + s0[1]) + (s0[2] + s0[3])) + ((s1[0] + s1[1]) + (s1[2] + s1[3]))) + (((s2[0] + s2[1]) + (s2[2] + s2[3])) + ((s3[0] + s3[1]) + (s3[2] + s3[3])));
        rstd[rstd_slot(row)] = rsqrtf(t * (1.f / D_) + EPS_); }
}

__device__ __forceinline__ void cumf_seq(ArgsP a, int j, int bh, unsigned char* lds) {
    const int tid = tid_fresh(), lane = tid & 63, wave = tid >> 6, b = bh >> 2, h = bh & 3;
    const float* GATE = (const float*)(a->ws + WS_GATE); float* CUMF = (float*)(a->ws + WS_CUMF);
    const float fb = a->in[19][j * 4 + h];
    float* tot = (float*)(lds + 140 * 1024);
    float loc[8]; float run = 0.f;
#pragma unroll
    for (int i = 0; i < 8; ++i) { run += logsigf(GATE[((size_t)b * T_ + tid * 8 + i) * 8 + h] + fb); loc[i] = run; }
    float inc = run;
#pragma unroll
    for (int o = 1; o < 64; o <<= 1) { const float n = __shfl_up(inc, o); if (lane >= o) inc += n; }
    if (lane == 63) tot[wave] = inc;
    __syncthreads();
    float off = inc - run;
    for (int w = 0; w < wave; ++w) off += tot[w];
#pragma unroll
    for (int i = 0; i < 8; ++i) CUMF[(size_t)bh * T_ + tid * 8 + i] = off + loc[i];
    __syncthreads();
}

__device__ __forceinline__ void ret_naive(ArgsP a, int j, int bh, unsigned char* lds) {
    const int b = bh >> 2, h = bh & 3, tid = tid_fresh(), lane = tid & 63, wave = tid >> 6;
    const bf16* BIG = (const bf16*)(a->ws + WS_BIG); const float* rope = (const float*)(a->ws + WS_ROPE); bf16* Y = (bf16*)(a->ws + WS_UY);
    float* qs = (float*)lds; float* ks = qs + 32 * 64; float* vs = ks + 32 * 64; float* op = vs + 32 * 128;
    const int v = tid & 127, dg = tid >> 7;
    float S[16];
#pragma unroll
    for (int d = 0; d < 16; ++d) S[d] = 0.f;
    const float gamma = 1.f - exp2f(-5.f - (float)h);
    const float* gnw = a->in[8] + (j * 4 + h) * 128;
    for (int blk = 0; blk < T_ / 32; ++blk) {
        const int t0 = blk * 32;
        __syncthreads();
#pragma unroll
        for (int r = 0; r < 2; ++r) { const int idx = tid + 512 * r, t = idx >> 5, i = idx & 31; const size_t row = (size_t)b * T_ + t0 + t;
            const unsigned qq = *(const unsigned*)(BIG + row * AB_N + h * 64 + 2 * i), kk = *(const unsigned*)(BIG + row * AB_N + 256 + h * 64 + 2 * i);
            const float c = rope[(t0 + t) * 32 + i], s = rope[T_ * 32 + (t0 + t) * 32 + i];
            const float q1 = bflo(qq), q2 = bfhi(qq), k1 = bflo(kk) * 0.125f, k2 = bfhi(kk) * 0.125f;
            qs[t * 64 + 2 * i] = q1 * c - q2 * s; qs[t * 64 + 2 * i + 1] = q1 * s + q2 * c;
            ks[t * 64 + 2 * i] = k1 * c - k2 * s; ks[t * 64 + 2 * i + 1] = k1 * s + k2 * c; }
#pragma unroll
        for (int r = 0; r < 8; ++r) { const int idx = tid + 512 * r, t = idx >> 7, c = idx & 127; vs[idx] = bf2f(BIG[((size_t)b * T_ + t0 + t) * AB_N + 512 + h * 128 + c]); }
        __syncthreads();
        for (int t = 0; t < 32; ++t) { const float vt = vs[t * 128 + v]; float o = 0.f;
#pragma unroll
            for (int d = 0; d < 16; ++d) { S[d] = S[d] * gamma + ks[t * 64 + dg * 16 + d] * vt; o += qs[t * 64 + dg * 16 + d] * S[d]; }
            op[(dg * 32 + t) * 128 + v] = o; }
        __syncthreads();
#pragma unroll
        for (int tt = 0; tt < 4; ++tt) { const int t = wave * 4 + tt; const size_t row = (size_t)b * T_ + t0 + t;
            float o0 = 0.f, o1 = 0.f;
#pragma unroll
            for (int g = 0; g < 4; ++g) { o0 += op[(g * 32 + t) * 128 + lane]; o1 += op[(g * 32 + t) * 128 + lane + 64]; }
            const float mean = wave_sum(o0 + o1) * (1.f / 128.f); const float d0 = o0 - mean, d1 = o1 - mean;
            const float rs = rsqrtf(wave_sum(d0 * d0 + d1 * d1) * (1.f / 128.f) + EPS_);
            const float g0 = bf2f(BIG[row * AB_N + 1024 + h * 128 + lane]), g1 = bf2f(BIG[row * AB_N + 1024 + h * 128 + lane + 64]);
            Y[row * D_ + h * 128 + lane] = (bf16)f2bf(d0 * rs * gnw[lane] * siluf(g0));
            Y[row * D_ + h * 128 + lane + 64] = (bf16)f2bf(d1 * rs * gnw[lane + 64] * siluf(g1)); }
    }
}

__device__ __forceinline__ void ssd_naive(ArgsP a, int j, int bh, unsigned char* lds) {
    const int b = bh >> 3, h = bh & 7, g = h >> 2, tid = tid_fresh();
    const bf16* BIG = (const bf16*)(a->ws + WS_BIG); const float* GATE = (const float*)(a->ws + WS_GATE); float* TMP = (float*)(a->ws + WS_ST);
    float* xs = (float*)lds; float* Bs = xs + 2048; float* Cs = Bs + 2048; float* dts = Cs + 2048; float* yp = dts + 64;
    const int p = tid & 63, ng = tid >> 6;
    float S[8];
#pragma unroll
    for (int i = 0; i < 8; ++i) S[i] = 0.f;
    const float* cw = a->in[9] + j * 4 * 768; const float* cb = a->in[10] + j * 768;
    const float dtb = a->in[11][j * 8 + h], A = -expf(a->in[12][j * 8 + h]), Dh = a->in[13][j * 8 + h];
    for (int blk = 0; blk < T_ / 32; ++blk) {
        const int t0 = blk * 32;
        __syncthreads();
        for (int r = 0; r < 12; ++r) { const int idx = tid + 512 * r, t = idx / 192, e = idx % 192, which = e >> 6, cc = e & 63;
            const int col = (which == 0) ? (h * 64 + cc) : (which == 1 ? 512 + g * 64 + cc : 640 + g * 64 + cc);
            float acc = cb[col];
#pragma unroll
            for (int w = 0; w < 4; ++w) { const int tt = t0 + t - 3 + w; if (tt >= 0) acc += cw[w * 768 + col] * bf2f(BIG[((size_t)b * T_ + tt) * AB_N + 2048 + col]); }
            const float val = siluf(acc);
            float* dst = (which == 0) ? xs : (which == 1 ? Bs : Cs); dst[t * 64 + cc] = val; }
        if (tid < 32) { const float dtv = softplusf(GATE[((size_t)b * T_ + t0 + tid) * 8 + h] + dtb); dts[tid] = dtv; dts[32 + tid] = expf(dtv * A); }
        __syncthreads();
        for (int t = 0; t < 32; ++t) { const float dtx = dts[t] * xs[t * 64 + p], at = dts[32 + t]; float y = 0.f;
#pragma unroll
            for (int i = 0; i < 8; ++i) { S[i] = at * S[i] + Bs[t * 64 + ng * 8 + i] * dtx; y += Cs[t * 64 + ng * 8 + i] * S[i]; }
            yp[(ng * 32 + t) * 64 + p] = y; }
        __syncthreads();
#pragma unroll
        for (int r = 0; r < 4; ++r) { const int idx = tid + 512 * r, t = idx >> 6, pp = idx & 63; const size_t row = (size_t)b * T_ + t0 + t;
            float y = Dh * xs[t * 64 + pp];
#pragma unroll
            for (int q = 0; q < 8; ++q) y += yp[(q * 32 + t) * 64 + pp];
            const float z = bf2f(BIG[row * AB_N + 1536 + h * 64 + pp]);
            TMP[row * 512 + h * 64 + pp] = y * siluf(z); }
    }
}

__device__ __forceinline__ void ssd_norm_phase(ArgsP a, int j) {
    const int tid = tid_fresh(), lane = tid & 63, wave = tid >> 6;
    const bf16* TMP = (const bf16*)(a->ws + WS_ST); bf16* Y = (bf16*)(a->ws + WS_UY);
    const float* nw = a->in[14] + j * 512;
    const int gw = bid_fresh() * 8 + wave, NGW = gdim_fresh() * 8;
#pragma unroll 4
    for (int it = gw; it < M_ * 2; it += NGW) { const int tok = it >> 1, grp = it & 1;
        const u32x2 t2 = *(const u32x2*)(TMP + (size_t)tok * 512 + grp * 256 + lane * 4);
        const f32x4 v = (f32x4){bflo(t2.x), bfhi(t2.x), bflo(t2.y), bfhi(t2.y)};
        const float rs = rsqrtf(wave_sum((v.x * v.x + v.y * v.y) + (v.z * v.z + v.w * v.w)) * (1.f / 256.f) + EPS_);
        const f32x4 w = *(const f32x4*)(nw + grp * 256 + lane * 4);
        u32x2 o; o.x = pk2(v.x * rs * w.x, v.y * rs * w.y); o.y = pk2(v.z * rs * w.z, v.w * rs * w.w);
        *(u32x2*)(Y + (size_t)tok * D_ + 512 + grp * 256 + lane * 4) = o; }
}

__device__ __forceinline__ void hg_naive(ArgsP a, int j, int bh, unsigned char* lds) {
    const int b = bh >> 2, h = bh & 3, tid = tid_fresh(), lane = tid & 63, wave = tid >> 6;
    const bf16* BIG = (const bf16*)(a->ws + WS_BIG); bf16* Y = (bf16*)(a->ws + WS_UY);
    float* qs = (float*)lds; float* fs = qs + 2048; float* ks = fs + 2048; float* is = ks + 2048; float* op = is + 2048;
    const int v = tid & 127, dg = tid >> 7;
    float S[32];
#pragma unroll
    for (int i = 0; i < 32; ++i) S[i] = 0.f;
    const float* nw = a->in[18] + j * 128;
    for (int blk = 0; blk < T_ / 16; ++blk) {
        const int t0 = blk * 16;
        __syncthreads();
#pragma unroll
        for (int r = 0; r < 4; ++r) { const int idx = tid + 512 * r, t = idx >> 7, c = idx & 127; const size_t row = (size_t)b * T_ + t0 + t;
            const float zf = bf2f(BIG[row * CD_N + 512 + h * 128 + c]);
            float lbv = 0.f; if (j == 1) { const float l0 = a->in[17][h * 128 + c], l1 = a->in[17][512 + h * 128 + c]; lbv = 1.f / (1.f + expf(l0 - l1)); }
            fs[idx] = lbv + (1.f - lbv) * sigmf(zf); ks[idx] = (1.f - lbv) * sigmf(-zf);
            qs[idx] = bf2f(BIG[row * CD_N + h * 128 + c]); is[idx] = bf2f(BIG[row * CD_N + 1024 + h * 128 + c]); }
        __syncthreads();
        for (int t = 0; t < 16; ++t) { const float iv = is[t * 128 + v]; float o = 0.f;
#pragma unroll
            for (int i = 0; i < 32; ++i) { const int d = dg * 32 + i; S[i] = fs[t * 128 + d] * S[i] + ks[t * 128 + d] * iv; o += qs[t * 128 + d] * S[i]; }
            op[(dg * 16 + t) * 128 + v] = o; }
        __syncthreads();
#pragma unroll
        for (int tt = 0; tt < 2; ++tt) { const int t = wave * 2 + tt; const size_t row = (size_t)b * T_ + t0 + t;
            float o0 = 0.f, o1 = 0.f;
#pragma unroll
            for (int g = 0; g < 4; ++g) { o0 += op[(g * 16 + t) * 128 + lane]; o1 += op[(g * 16 + t) * 128 + lane + 64]; }
            const float rs = rsqrtf(wave_sum(o0 * o0 + o1 * o1) * (1.f / 128.f) + EPS_);
            const float g0 = bf2f(BIG[row * CD_N + 1536 + h * 128 + lane]), g1 = bf2f(BIG[row * CD_N + 1536 + h * 128 + lane + 64]);
            Y[row * D_ + h * 128 + lane] = (bf16)f2bf(o0 * rs * nw[lane] * siluf(g0));
            Y[row * D_ + h * 128 + lane + 64] = (bf16)f2bf(o1 * rs * nw[lane + 64] * siluf(g1)); }
    }
}

__device__ __forceinline__ void fox_naive(ArgsP a, int j, int bh, int qb, unsigned char* lds) {
    const int b = bh >> 2, h = bh & 3, tid = tid_fresh();
    const bf16* BIG = (const bf16*)(a->ws + WS_BIG); bf16* Y = (bf16*)(a->ws + WS_UY); const float* CUMF = (const float*)(a->ws + WS_CUMF) + (size_t)bh * T_;
    float* Ks = (float*)lds; float* Vs = Ks + 64 * 128; float* Fs = Vs + 64 * 128;
    const float* qnw = a->in[20] + j * 128; const float* knw = a->in[21] + j * 128;
    const int qi = tid >> 2, part = tid & 3, tq = qb * 128 + qi;
    const size_t rowq = (size_t)b * T_ + tq;
    float q[32], o[32];
    { const u32x4* qp = (const u32x4*)(BIG + rowq * CD_N + 2048 + h * 128 + part * 32); float ss = 0.f;
#pragma unroll
      for (int i = 0; i < 4; ++i) { const u32x4 w = qp[i];
#pragma unroll
          for (int e = 0; e < 4; ++e) { q[i * 8 + 2 * e] = bflo(w[e]); q[i * 8 + 2 * e + 1] = bfhi(w[e]); } }
#pragma unroll
      for (int i = 0; i < 32; ++i) ss += q[i] * q[i];
      ss += __shfl_xor(ss, 1); ss += __shfl_xor(ss, 2);
      const float rs = rsqrtf(ss * (1.f / 128.f) + EPS_) * 0.08838834764831845f;
#pragma unroll
      for (int i = 0; i < 32; ++i) { q[i] *= rs * qnw[part * 32 + i]; o[i] = 0.f; } }
    const float Fq = CUMF[tq];
    float m = -INFINITY, l = 0.f;
    const int ntiles = 2 * qb + 2;
    for (int kt = 0; kt < ntiles; ++kt) {
        __syncthreads();
        { const int r = tid >> 3, seg = tid & 7; const size_t krow = (size_t)b * T_ + kt * 64 + r;
          const u32x4* kp = (const u32x4*)(BIG + krow * CD_N + 2560 + h * 128 + seg * 16); const u32x4* vp = (const u32x4*)(BIG + krow * CD_N + 3072 + h * 128 + seg * 16);
          float kv[16], vv[16]; float ss = 0.f;
#pragma unroll
          for (int i = 0; i < 2; ++i) { const u32x4 w = kp[i], x = vp[i];
#pragma unroll
              for (int e = 0; e < 4; ++e) { kv[i * 8 + 2 * e] = bflo(w[e]); kv[i * 8 + 2 * e + 1] = bfhi(w[e]); vv[i * 8 + 2 * e] = bflo(x[e]); vv[i * 8 + 2 * e + 1] = bfhi(x[e]); } }
#pragma unroll
          for (int i = 0; i < 16; ++i) ss += kv[i] * kv[i];
          ss += __shfl_xor(ss, 1); ss += __shfl_xor(ss, 2); ss += __shfl_xor(ss, 4);
          const float rs = rsqrtf(ss * (1.f / 128.f) + EPS_);
#pragma unroll
          for (int i = 0; i < 16; ++i) { Ks[r * 128 + seg * 16 + i] = kv[i] * rs * knw[seg * 16 + i]; Vs[r * 128 + seg * 16 + i] = vv[i]; }
          if (seg == 0) Fs[r] = CUMF[kt * 64 + r]; }
        __syncthreads();
        for (int s = 0; s < 64; ++s) {
            const int ksi = kt * 64 + s;
            const f32x4* kr = (const f32x4*)(Ks + s * 128 + part * 32); float dot = 0.f;
#pragma unroll
            for (int i = 0; i < 8; ++i) { const f32x4 w = kr[i]; dot += q[4 * i] * w.x + q[4 * i + 1] * w.y + q[4 * i + 2] * w.z + q[4 * i + 3] * w.w; }
            dot += __shfl_xor(dot, 1); dot += __shfl_xor(dot, 2);
            float logit = dot + (Fq - Fs[s]);
            if (ksi > tq) logit = -INFINITY;
            const float mn = fmaxf(m, logit); const float p = __expf(logit - mn), c = __expf(m - mn);
            m = mn; l = l * c + p;
            const f32x4* vr = (const f32x4*)(Vs + s * 128 + part * 32);
#pragma unroll
            for (int i = 0; i < 8; ++i) { const f32x4 w = vr[i]; o[4 * i] = o[4 * i] * c + p * w.x; o[4 * i + 1] = o[4 * i + 1] * c + p * w.y; o[4 * i + 2] = o[4 * i + 2] * c + p * w.z; o[4 * i + 3] = o[4 * i + 3] * c + p * w.w; }
        }
    }
    const float il = 1.f / l;
    u32x4* yp = (u32x4*)(Y + rowq * D_ + 512 + h * 128 + part * 32);
#pragma unroll
    for (int i = 0; i < 4; ++i) { u32x4 w; w.x = pk2(o[8 * i] * il, o[8 * i + 1] * il); w.y = pk2(o[8 * i + 2] * il, o[8 * i + 3] * il); w.z = pk2(o[8 * i + 4] * il, o[8 * i + 5] * il); w.w = pk2(o[8 * i + 6] * il, o[8 * i + 7] * il); yp[i] = w; }
}

constexpr size_t WS_VT = WS_ST;
__device__ __forceinline__ void fox_prep(ArgsP a, int j, unsigned char* lds) {
    const int tid = tid_fresh();
    bf16* BIG = (bf16*)(a->ws + WS_BIG); bf16* VT = (bf16*)(a->ws + WS_VT);
    const float* qnw = a->in[20] + j * 128; const float* knw = a->in[21] + j * 128;
    for (int tile = bid_fresh(); tile < 512; tile += gdim_fresh()) {
        const int b = tile >> 6, tb = tile & 63; const size_t r0 = (size_t)b * T_ + tb * 64;
        __syncthreads();
#pragma unroll
        for (int k = 0; k < 8; ++k) { const int id = tid + 512 * k, r = id >> 6, c = id & 63;
            const u32x4 w = *(const u32x4*)(BIG + BIGX(r0 + r, 3072 + c * 8));
            unsigned* dst = (unsigned*)(lds + r * 1028 + c * 16); dst[0] = w.x; dst[1] = w.y; dst[2] = w.z; dst[3] = w.w; }
#pragma unroll 2
        for (int p = 0; p < 16; ++p) { const int grp = p * 32 + (tid >> 4), sub = tid & 15; const int r = grp >> 3, which = (grp >> 2) & 1, h = grp & 3;
            bf16* ptr = BIG + BIGX(r0 + r, 2048 + which * 512 + h * 128 + sub * 8);
            const u32x4 w = *(const u32x4*)ptr; float v[8];
#pragma unroll
            for (int e = 0; e < 4; ++e) { v[2 * e] = bflo(w[e]); v[2 * e + 1] = bfhi(w[e]); }
            float ss = 0.f;
#pragma unroll
            for (int e = 0; e < 8; ++e) ss += v[e] * v[e];
            ss += __shfl_xor(ss, 1); ss += __shfl_xor(ss, 2); ss += __shfl_xor(ss, 4); ss += __shfl_xor(ss, 8);
            const float rs = rsqrtf(ss * (1.f / 128.f) + EPS_) * (which == 0 ? 0.12751743f : 1.f);
            const float* nw = (which == 0 ? qnw : knw) + sub * 8;
            u32x4 o;
#pragma unroll
            for (int e = 0; e < 4; ++e) o[e] = pk2(v[2 * e] * rs * nw[2 * e], v[2 * e + 1] * rs * nw[2 * e + 1]);
            *(u32x4*)ptr = o; }
        __syncthreads();
#pragma unroll 2
        for (int k = 0; k < 8; ++k) { const int id = tid + 512 * k, c8 = id & 7, d = (id >> 3) & 127, h = id >> 10;
            const bf16* src = (const bf16*)(lds + (8 * c8) * 1028) + h * 128 + d;
            u32x4 o;
#pragma unroll
            for (int e = 0; e < 4; ++e) { const int i0 = 2 * e, i1 = 2 * e + 1;
                const int r0 = 16 * (c8 >> 1) + 4 * (c8 & 1) + (i0 & 3) + 8 * (i0 >> 2) - 8 * c8, r1 = 16 * (c8 >> 1) + 4 * (c8 & 1) + (i1 & 3) + 8 * (i1 >> 2) - 8 * c8;
                o[e] = (unsigned)src[r0 * 514] | ((unsigned)src[r1 * 514] << 16); }
            *(u32x4*)(VT + ((size_t)(b * 4 + h) * 128 + d) * T_ + tb * 64 + c8 * 8) = o; }
    }
}

typedef short bf16x8_t __attribute__((ext_vector_type(8)));
typedef float f32x16 __attribute__((ext_vector_type(16)));
typedef short s16x4_t __attribute__((ext_vector_type(4)));
constexpr int FX_KROW = 272, FX_VROW = 144, FX_KBYTES = 64 * FX_KROW, FX_VBYTES = 128 * FX_VROW, FX_BUF = FX_KBYTES + FX_VBYTES + 256;
__device__ __forceinline__ int crow16(int r, int hi) { return (r & 3) + 8 * (r >> 2) + 4 * hi; }

__device__ __forceinline__ void fox_unit(ArgsP a, int bh, int qb, unsigned char* lds) {
    const int tid = tid_fresh(), lane = tid & 63, wave = tid >> 6, l31 = lane & 31, hi = lane >> 5;
    const int b = bh >> 2, h = bh & 3;
    const bf16* BIG = (const bf16*)(a->ws + WS_BIG); bf16* Y = (bf16*)(a->ws + WS_UY);
    const bf16* VT = (const bf16*)(a->ws + WS_VT) + (size_t)bh * 128 * T_;
    const float* CUMF = (const float*)(a->ws + WS_CUMF) + (size_t)bh * T_;
    const int tq = qb * 256 + wave * 32 + l31; const size_t rowq = (size_t)b * T_ + tq;
    const float Fref = CUMF[qb * 256];
    bf16x8_t qf[8];
#pragma unroll
    for (int ks = 0; ks < 8; ++ks) qf[ks] = *(const bf16x8_t*)(BIG + rowq * CD_N + 2048 + h * 128 + 16 * ks + 8 * hi);
    f32x16 oT[4];
#pragma unroll
    for (int d = 0; d < 4; ++d)
#pragma unroll
        for (int r = 0; r < 16; ++r) oT[d][r] = 0.f;
    float m = -INFINITY, lsum = 0.f;
    const int nt = 4 * qb + 4;
    const bf16* Kg = BIG + ((size_t)b * T_) * CD_N + 2560 + h * 128;
    const int kr0 = tid >> 4, kc = tid & 15;
    const int vd0 = tid >> 3, vc = tid & 7;
    u32x4 kreg[2], vreg[2]; float breg = 0.f;
#define FX_LOAD(kt) do { kreg[0] = *(const u32x4*)(Kg + (size_t)((kt) * 64 + kr0) * CD_N + kc * 8); kreg[1] = *(const u32x4*)(Kg + (size_t)((kt) * 64 + kr0 + 32) * CD_N + kc * 8); \
        vreg[0] = *(const u32x4*)(VT + (size_t)vd0 * T_ + (kt) * 64 + vc * 8); vreg[1] = *(const u32x4*)(VT + (size_t)(vd0 + 64) * T_ + (kt) * 64 + vc * 8); \
        if (tid < 64) breg = (Fref - CUMF[(kt) * 64 + tid]) * 1.4426950408889634f; } while (0)
#define FX_STORE(buf) do { unsigned char* bb = lds + (buf) * FX_BUF; *(u32x4*)(bb + kr0 * FX_KROW + kc * 16) = kreg[0]; *(u32x4*)(bb + (kr0 + 32) * FX_KROW + kc * 16) = kreg[1]; \
        *(u32x4*)(bb + FX_KBYTES + vd0 * FX_VROW + vc * 16) = vreg[0]; *(u32x4*)(bb + FX_KBYTES + (vd0 + 64) * FX_VROW + vc * 16) = vreg[1]; \
        if (tid < 64) ((float*)(bb + FX_KBYTES + FX_VBYTES))[tid] = breg; } while (0)
    __syncthreads();
    FX_LOAD(0); FX_STORE(0);
    __syncthreads();
    for (int kt = 0; kt < nt; ++kt) {
        const int cur = kt & 1;
        if (kt + 1 < nt) FX_LOAD(kt + 1);
        const unsigned char* bb = lds + cur * FX_BUF;
        if (kt * 64 <= qb * 256 + wave * 32 + 31) {
            f32x16 p[2];
#pragma unroll
            for (int hf = 0; hf < 2; ++hf) {
#pragma unroll
                for (int r = 0; r < 16; ++r) p[hf][r] = 0.f;
#pragma unroll
                for (int ks = 0; ks < 8; ++ks) { const bf16x8_t kf = *(const bf16x8_t*)(bb + (32 * hf + l31) * FX_KROW + (16 * ks + 8 * hi) * 2);
                    p[hf] = __builtin_amdgcn_mfma_f32_32x32x16_bf16(kf, qf[ks], p[hf], 0, 0, 0); }
            }
            const float* Bs = (const float*)(bb + FX_KBYTES + FX_VBYTES);
            const bool band = (kt >= 4 * qb);
            float mx = -INFINITY;
#pragma unroll
            for (int hf = 0; hf < 2; ++hf)
#pragma unroll
                for (int g = 0; g < 4; ++g) { const f32x4 bv = *(const f32x4*)(Bs + 32 * hf + 8 * g + 4 * hi);
#pragma unroll
                    for (int e = 0; e < 4; ++e) { const int r = 4 * g + e; float s = p[hf][r] + bv[e];
                        if (band) { const int kv = kt * 64 + 32 * hf + 8 * g + 4 * hi + e; if (kv > tq) s = -INFINITY; }
                        p[hf][r] = s; mx = fmaxf(mx, s); } }
            mx = fmaxf(mx, __shfl_xor(mx, 32));
            const float mn = fmaxf(m, mx); const float alpha = __builtin_amdgcn_exp2f(m - mn); m = mn;
            float ps = 0.f;
#pragma unroll
            for (int hf = 0; hf < 2; ++hf)
#pragma unroll
                for (int r = 0; r < 16; ++r) { const float e = __builtin_amdgcn_exp2f(p[hf][r] - mn); p[hf][r] = e; ps += e; }
            lsum = lsum * alpha + ps;
#pragma unroll
            for (int d = 0; d < 4; ++d)
#pragma unroll
                for (int r = 0; r < 16; ++r) oT[d][r] *= alpha;
            bf16x8_t pb[4];
#pragma unroll
            for (int ks2 = 0; ks2 < 4; ++ks2) { const int hf = ks2 >> 1, c = ks2 & 1; u32x4 w;
#pragma unroll
                for (int e = 0; e < 4; ++e) w[e] = pg8::cvt_pk_bf16(p[hf][8 * c + 2 * e], p[hf][8 * c + 2 * e + 1]);
                pb[ks2] = __builtin_bit_cast(bf16x8_t, w); }
            const unsigned char* vb = bb + FX_KBYTES;
#pragma unroll
            for (int d = 0; d < 4; ++d)
#pragma unroll
                for (int ks2 = 0; ks2 < 4; ++ks2) { const unsigned char* vp = vb + (32 * d + l31) * FX_VROW + (16 * ks2 + 4 * hi) * 2;
                    const s16x4_t lo = *(const s16x4_t*)vp, hi4 = *(const s16x4_t*)(vp + 16);
                    const bf16x8_t vf = (bf16x8_t){lo[0], lo[1], lo[2], lo[3], hi4[0], hi4[1], hi4[2], hi4[3]};
                    oT[d] = __builtin_amdgcn_mfma_f32_32x32x16_bf16(vf, pb[ks2], oT[d], 0, 0, 0); }
        }
        if (kt + 1 < nt) FX_STORE(cur ^ 1);
        __syncthreads();
    }
#undef FX_LOAD
#undef FX_STORE
    lsum += __shfl_xor(lsum, 32);
    const float il = 1.f / lsum;
    bf16* yp = Y + rowq * D_ + 512 + h * 128;
#pragma unroll
    for (int d = 0; d < 4; ++d)
#pragma unroll
        for (int g = 0; g < 4; ++g) { u32x2 w; w.x = pk2(oT[d][4 * g] * il, oT[d][4 * g + 1] * il); w.y = pk2(oT[d][4 * g + 2] * il, oT[d][4 * g + 3] * il);
            *(u32x2*)(yp + 32 * d + 8 * g + 4 * hi) = w; }
}

template <int MODE  >
__device__ __forceinline__ void scalar_stream(ArgsP a, int j, int bh, unsigned char* lds) {
    constexpr int DV = MODE == 0 ? 128 : 64;
    constexpr int RS = 144;
    constexpr int OFF_QN = 0, OFF_QT = 9216, OFF_KN = 18432, OFF_KOT = 27648, OFF_VT = 36864, OFF_P = OFF_VT + DV * RS, OFF_ST = OFF_P + 9216, OFF_OB = OFF_ST + DV * RS;
    constexpr int OBS = DV * 4 + 16;
    constexpr int OFF_CUM = OFF_OB + 64 * OBS, OFF_TAB = OFF_CUM + 512;
    const int tid = tid_fresh(), lane = tid & 63, wave = tid >> 6, l31 = lane & 31, hi = lane >> 5;
    const int b = MODE == 0 ? (bh >> 2) : (bh >> 3), h = MODE == 0 ? (bh & 3) : (bh & 7), g = h >> 2;
    const bf16* BIG = (const bf16*)(a->ws + WS_BIG);
    const float* rope = (const float*)(a->ws + WS_ROPE); const float* GATE = (const float*)(a->ws + WS_GATE);
    bf16* Y = (bf16*)(a->ws + WS_UY); float* TMP = (float*)(a->ws + WS_ST);
    const float LOG2E = 1.4426950408889634f;
    const float gamma = 1.f - exp2f(-5.f - (float)h), lg2gamma = log2f(gamma);
    float dtb = 0.f, Aneg = 0.f, Dh = 0.f;
    if (MODE == 1) { dtb = a->in[11][j * 8 + h]; Aneg = -expf(a->in[12][j * 8 + h]); Dh = a->in[13][j * 8 + h]; }
    const float* gnw = a->in[8] + (j * 4 + h) * 128;
    float* cumL = (float*)(lds + OFF_CUM); float* tab = (float*)(lds + OFF_TAB);
    float gw[16];
#pragma unroll
    for (int e = 0; e < 16; ++e) gw[e] = (MODE == 0) ? gnw[(tid & 7) * 16 + e] : 0.f;
    const int st = lane, sc8 = wave;
    __syncthreads();
    for (int i = tid; i < (DV * RS + 9216) / 4; i += 512) ((unsigned*)(lds + OFF_P))[i] = 0u;
    if (MODE == 1) {
        const float* cw = a->in[9] + j * 4 * 768; const float* cb = a->in[10] + j * 768;
        for (int i = tid; i < 3 * 8 * 5 * 8; i += 512) { const int e = i & 7, w = (i >> 3) % 5, c8 = (i / 40) & 7, which = i / 320;
            const int col = (which == 0 ? h * 64 : (which == 1 ? 512 + g * 64 : 640 + g * 64)) + c8 * 8 + e;
            tab[i] = (w < 4) ? cw[w * 768 + col] : cb[col]; }
    }
    f32x16 sacc;
#pragma unroll
    for (int r = 0; r < 16; ++r) sacc[r] = 0.f;
    u32x4 rq, rk, rv0, rv1; f32x4 rcs, rsn; u32x4 rx[3][4]; float rgate = 0.f;
#define ST_LOAD(c) do { const size_t row = (size_t)b * T_ + (c) * 64 + st; \
        if (MODE == 0) { rq = *(const u32x4*)(BIG + row * AB_N + h * 64 + sc8 * 8); rk = *(const u32x4*)(BIG + row * AB_N + 256 + h * 64 + sc8 * 8); \
            rcs = *(const f32x4*)(rope + ((c) * 64 + st) * 32 + sc8 * 4); rsn = *(const f32x4*)(rope + T_ * 32 + ((c) * 64 + st) * 32 + sc8 * 4); \
            rv0 = *(const u32x4*)(BIG + row * AB_N + 512 + h * 128 + sc8 * 8); rv1 = *(const u32x4*)(BIG + row * AB_N + 512 + h * 128 + (sc8 + 8) * 8); } \
        else { _Pragma("unroll") for (int wh = 0; wh < 3; ++wh) { const int col = (wh == 0 ? h * 64 : (wh == 1 ? 512 + g * 64 : 640 + g * 64)) + sc8 * 8; \
                _Pragma("unroll") for (int w = 0; w < 4; ++w) { const int tt = (c) * 64 + st - 3 + w; \
                    rx[wh][w] = (tt >= 0) ? *(const u32x4*)(BIG + ((size_t)b * T_ + tt) * AB_N + 2048 + col) : (u32x4){0u, 0u, 0u, 0u}; } } \
            rgate = GATE[((size_t)b * T_ + (c) * 64 + lane) * 8 + h]; } } while (0)
    ST_LOAD(0);
    __syncthreads();
    for (int c = 0; c < T_ / 64; ++c) {
        if (MODE == 0) {
            float q[8], k[8];
#pragma unroll
            for (int e = 0; e < 4; ++e) { const float q1 = bflo(rq[e]), q2 = bfhi(rq[e]), k1 = bflo(rk[e]) * 0.125f, k2 = bfhi(rk[e]) * 0.125f; const float cs = rcs[e], sn = rsn[e];
                q[2 * e] = q1 * cs - q2 * sn; q[2 * e + 1] = q1 * sn + q2 * cs; k[2 * e] = k1 * cs - k2 * sn; k[2 * e + 1] = k1 * sn + k2 * cs; }
            const float gi = __builtin_amdgcn_exp2f((float)(st + 1) * lg2gamma), go = __builtin_amdgcn_exp2f((float)(63 - st) * lg2gamma);
            u32x4 w0, w1, w2;
#pragma unroll
            for (int e = 0; e < 4; ++e) { w0[e] = pk2(q[2 * e], q[2 * e + 1]); w1[e] = pk2(q[2 * e] * gi, q[2 * e + 1] * gi); w2[e] = pk2(k[2 * e], k[2 * e + 1]); }
            *(u32x4*)(lds + OFF_QN + st * RS + sc8 * 16) = w0; *(u32x4*)(lds + OFF_QT + st * RS + sc8 * 16) = w1; *(u32x4*)(lds + OFF_KN + st * RS + sc8 * 16) = w2;
#pragma unroll
            for (int e = 0; e < 8; ++e) *(bf16*)(lds + OFF_KOT + (sc8 * 8 + e) * RS + st * 2) = (bf16)f2bf(k[e] * go);
#pragma unroll
            for (int e = 0; e < 4; ++e) { *(bf16*)(lds + OFF_VT + (sc8 * 8 + 2 * e) * RS + st * 2) = (bf16)(rv0[e] & 0xffffu); *(bf16*)(lds + OFF_VT + (sc8 * 8 + 2 * e + 1) * RS + st * 2) = (bf16)(rv0[e] >> 16);
                *(bf16*)(lds + OFF_VT + ((sc8 + 8) * 8 + 2 * e) * RS + st * 2) = (bf16)(rv1[e] & 0xffffu); *(bf16*)(lds + OFF_VT + ((sc8 + 8) * 8 + 2 * e + 1) * RS + st * 2) = (bf16)(rv1[e] >> 16); }
        } else {
            const float dtv = softplusf(rgate + dtb); float cumv = dtv * Aneg;
#pragma unroll
            for (int o = 1; o < 64; o <<= 1) { const float n = __shfl_up(cumv, o); if (lane >= o) cumv += n; }
            const float cum_t = cumv, dt_t = dtv, cum_last = __shfl(cumv, 63);
            if (wave == 0) { cumL[lane] = cumv; if (lane == 63) cumL[64] = cumv; }
            float val[3][8];
#pragma unroll
            for (int wh = 0; wh < 3; ++wh) { const float* tb = tab + (wh * 8 + sc8) * 40;
#pragma unroll
                for (int e = 0; e < 8; ++e) val[wh][e] = tb[32 + e];
#pragma unroll
                for (int w = 0; w < 4; ++w)
#pragma unroll
                    for (int e = 0; e < 4; ++e) { val[wh][2 * e] += tb[w * 8 + 2 * e] * bflo(rx[wh][w][e]); val[wh][2 * e + 1] += tb[w * 8 + 2 * e + 1] * bfhi(rx[wh][w][e]); }
#pragma unroll
                for (int e = 0; e < 8; ++e) val[wh][e] = siluf(val[wh][e]); }
            const float ei = __expf(cum_t), eo = dt_t * __expf(cum_last - cum_t);
            u32x4 w0, w1, w2;
#pragma unroll
            for (int e = 0; e < 4; ++e) { w0[e] = pk2(val[2][2 * e], val[2][2 * e + 1]); w1[e] = pk2(val[2][2 * e] * ei, val[2][2 * e + 1] * ei); w2[e] = pk2(val[1][2 * e] * dt_t, val[1][2 * e + 1] * dt_t); }
            *(u32x4*)(lds + OFF_QN + st * RS + sc8 * 16) = w0; *(u32x4*)(lds + OFF_QT + st * RS + sc8 * 16) = w1; *(u32x4*)(lds + OFF_KN + st * RS + sc8 * 16) = w2;
#pragma unroll
            for (int e = 0; e < 8; ++e) { *(bf16*)(lds + OFF_KOT + (sc8 * 8 + e) * RS + st * 2) = (bf16)f2bf(val[1][e] * eo); *(bf16*)(lds + OFF_VT + (sc8 * 8 + e) * RS + st * 2) = (bf16)f2bf(val[0][e]); }
        }
        LBAR();
        if (c + 1 < T_ / 64) ST_LOAD(c + 1);
        unsigned rg[8];
        u32x4 rgA, rgB;
        if (MODE == 0) { const bf16* gp = BIG + ((size_t)b * T_ + c * 64 + (tid >> 3)) * AB_N + 1024 + h * 128 + (tid & 7) * 16; rgA = *(const u32x4*)gp; rgB = *(const u32x4*)(gp + 8);
        } else {
#pragma unroll
            for (int k = 0; k < 4; ++k) { const int idx = tid + 512 * k; rg[k] = *(const unsigned*)(BIG + ((size_t)b * T_ + c * 64 + (idx >> 5)) * AB_N + 1536 + h * 64 + 2 * (idx & 31)); }
        }
        if (wave < 3) {
            const int jb = (wave == 2) ? 1 : 0, ib = (wave == 0) ? 0 : 1;
            f32x16 acc;
#pragma unroll
            for (int r = 0; r < 16; ++r) acc[r] = 0.f;
#pragma unroll
            for (int s = 0; s < 4; ++s) { const bf16x8_t af = *(const bf16x8_t*)(lds + OFF_KN + (32 * jb + l31) * RS + (16 * s + 8 * hi) * 2), bfr = *(const bf16x8_t*)(lds + OFF_QN + (32 * ib + l31) * RS + (16 * s + 8 * hi) * 2);
                acc = __builtin_amdgcn_mfma_f32_32x32x16_bf16(af, bfr, acc, 0, 0, 0); }
            const int i = 32 * ib + l31; const float cum_i = (MODE == 1) ? cumL[i] : 0.f;
#pragma unroll
            for (int g4 = 0; g4 < 4; ++g4) { const int j0 = 32 * jb + 8 * g4 + 4 * hi; float v[4];
                f32x4 cj = (f32x4){0.f, 0.f, 0.f, 0.f}; if (MODE == 1) cj = *(const f32x4*)(cumL + j0);
#pragma unroll
                for (int e = 0; e < 4; ++e) { const int jj = j0 + e; const float ex = (MODE == 0) ? (float)(i - jj) * lg2gamma : (cum_i - cj[e]) * LOG2E;
                    v[e] = (jj <= i) ? acc[4 * g4 + e] * __builtin_amdgcn_exp2f(ex) : 0.f; }
                u32x2 w; w.x = pk2(v[0], v[1]); w.y = pk2(v[2], v[3]);
                *(u32x2*)(lds + OFF_P + i * RS + j0 * 2) = w; }
        }
        LBAR();
        if (MODE == 0 || wave < 4) {
            const int ib = wave & 1, vb = (wave >> 1) & 3;
            f32x16 acc;
#pragma unroll
            for (int r = 0; r < 16; ++r) acc[r] = 0.f;
#pragma unroll
            for (int s = 0; s < 4; ++s) { const bf16x8_t af = *(const bf16x8_t*)(lds + OFF_P + (32 * ib + l31) * RS + (16 * s + 8 * hi) * 2), bfr = *(const bf16x8_t*)(lds + OFF_VT + (32 * vb + l31) * RS + (16 * s + 8 * hi) * 2);
                acc = __builtin_amdgcn_mfma_f32_32x32x16_bf16(af, bfr, acc, 0, 0, 0); }
#pragma unroll
            for (int s = 0; s < 4; ++s) { const bf16x8_t af = *(const bf16x8_t*)(lds + OFF_QT + (32 * ib + l31) * RS + (16 * s + 8 * hi) * 2), bfr = *(const bf16x8_t*)(lds + OFF_ST + (32 * vb + l31) * RS + (16 * s + 8 * hi) * 2);
                acc = __builtin_amdgcn_mfma_f32_32x32x16_bf16(af, bfr, acc, 0, 0, 0); }
            if (MODE == 1) {
#pragma unroll
                for (int g4 = 0; g4 < 4; ++g4) { const u32x2 xv = *(const u32x2*)(lds + OFF_VT + (32 * vb + l31) * RS + (32 * ib + 8 * g4 + 4 * hi) * 2);
                    acc[4 * g4] += Dh * bflo(xv.x); acc[4 * g4 + 1] += Dh * bfhi(xv.x); acc[4 * g4 + 2] += Dh * bflo(xv.y); acc[4 * g4 + 3] += Dh * bfhi(xv.y); }
            }
#pragma unroll
            for (int r = 0; r < 16; ++r) *(float*)(lds + OFF_OB + (32 * ib + crow16(r, hi)) * OBS + (32 * vb + l31) * 4) = acc[r];
        }
        const int sdb = wave & 1, svb = (MODE == 0) ? (wave >> 1) : ((wave >> 1) & 1);
        if (MODE == 0 || wave >= 4) {
            const float alast = (MODE == 0) ? exp2f(64.f * lg2gamma) : __expf(cumL[64]);
#pragma unroll
            for (int r = 0; r < 16; ++r) sacc[r] *= alast;
#pragma unroll
            for (int s = 0; s < 4; ++s) { const bf16x8_t af = *(const bf16x8_t*)(lds + OFF_KOT + (32 * sdb + l31) * RS + (16 * s + 8 * hi) * 2), bfr = *(const bf16x8_t*)(lds + OFF_VT + (32 * svb + l31) * RS + (16 * s + 8 * hi) * 2);
                sacc = __builtin_amdgcn_mfma_f32_32x32x16_bf16(af, bfr, sacc, 0, 0, 0); }
        }
        LBAR();
        if (MODE == 0 || wave >= 4) {
#pragma unroll
            for (int g4 = 0; g4 < 4; ++g4) { u32x2 w; w.x = pk2(sacc[4 * g4], sacc[4 * g4 + 1]); w.y = pk2(sacc[4 * g4 + 2], sacc[4 * g4 + 3]);
                *(u32x2*)(lds + OFF_ST + (32 * svb + l31) * RS + (32 * sdb + 8 * g4 + 4 * hi) * 2) = w; }
        }
        if (MODE == 0) {
            const int i = tid >> 3, part = tid & 7; const size_t row = (size_t)b * T_ + c * 64 + i;
            float o[16]; float sm = 0.f, sq = 0.f;
#pragma unroll
            for (int q4 = 0; q4 < 4; ++q4) { const f32x4 v = *(const f32x4*)(lds + OFF_OB + i * OBS + part * 64 + q4 * 16);
                o[4 * q4] = v.x; o[4 * q4 + 1] = v.y; o[4 * q4 + 2] = v.z; o[4 * q4 + 3] = v.w; sm += (v.x + v.y) + (v.z + v.w); sq += (v.x * v.x + v.y * v.y) + (v.z * v.z + v.w * v.w); }
            sm += __shfl_xor(sm, 1); sq += __shfl_xor(sq, 1); sm += __shfl_xor(sm, 2); sq += __shfl_xor(sq, 2); sm += __shfl_xor(sm, 4); sq += __shfl_xor(sq, 4);
            const float mean = sm * (1.f / 128.f); const float rs = rsqrtf(fmaxf(sq * (1.f / 128.f) - mean * mean, 0.f) + EPS_);
            u32x4 w0, w1;
#pragma unroll
            for (int e = 0; e < 4; ++e) { w0[e] = pk2((o[2 * e] - mean) * rs * gw[2 * e] * siluf(bflo(rgA[e])), (o[2 * e + 1] - mean) * rs * gw[2 * e + 1] * siluf(bfhi(rgA[e])));
                w1[e] = pk2((o[8 + 2 * e] - mean) * rs * gw[8 + 2 * e] * siluf(bflo(rgB[e])), (o[8 + 2 * e + 1] - mean) * rs * gw[8 + 2 * e + 1] * siluf(bfhi(rgB[e]))); }
            *(u32x4*)(Y + row * D_ + h * 128 + part * 16) = w0; *(u32x4*)(Y + row * D_ + h * 128 + part * 16 + 8) = w1;
        } else {
#pragma unroll
            for (int k = 0; k < 4; ++k) { const int idx = tid + 512 * k, i = idx >> 5, p = 2 * (idx & 31); const size_t row = (size_t)b * T_ + c * 64 + i;
                const f32x2_t y = *(const f32x2_t*)(lds + OFF_OB + i * OBS + p * 4);
                f32x2_t o; o.x = y.x * siluf(bflo(rg[k])); o.y = y.y * siluf(bfhi(rg[k]));
                *(f32x2_t*)(TMP + row * 512 + h * 64 + p) = o; }
        }
    }
#undef ST_LOAD
    __syncthreads();
}

__device__ __forceinline__ void hg_stream(ArgsP a, int j, int bh, unsigned char* lds) {
    constexpr int RS = 144, RW = 272;
    constexpr int OFF_QX = 0, OFF_KV = 17408, OFF_OB = 0  , OFF_QT = 43520, OFF_KOT = 60928, OFF_VT = 79360, OFF_P = 97792, OFF_ST = 107008, OFF_AL = 141824;
    constexpr int OBS = 528;
    const int tid = tid_fresh(), lane = tid & 63, wave = tid >> 6, l31 = lane & 31, hi = lane >> 5;
    const int b = bh >> 2, h = bh & 3;
    const bf16* BIG = (const bf16*)(a->ws + WS_BIG); bf16* Y = (bf16*)(a->ws + WS_UY);
    const float* nw = a->in[18] + j * 128;
    const int c8 = wave * 2 + hi, tseg = l31;
    float lbv[8];
#pragma unroll
    for (int e = 0; e < 8; ++e) { lbv[e] = 0.f; if (j == 1) { const float l0 = a->in[17][h * 128 + c8 * 8 + e], l1 = a->in[17][512 + h * 128 + c8 * 8 + e]; lbv[e] = 1.f / (1.f + expf(l0 - l1)); } }
    float* alL = (float*)(lds + OFF_AL);
    float gw[16];
#pragma unroll
    for (int e = 0; e < 16; ++e) gw[e] = nw[(tid & 7) * 16 + e];
    __syncthreads();
    for (int i = tid; i < (9216 + 34816) / 4; i += 512) ((unsigned*)(lds + OFF_P))[i] = 0u;
    f32x16 sacc[2];
#pragma unroll
    for (int t = 0; t < 2; ++t)
#pragma unroll
        for (int r = 0; r < 16; ++r) sacc[t][r] = 0.f;
    u32x4 rz[2], rq[2], rv[2];
#define HG_LOAD(c) do { _Pragma("unroll") for (int rr = 0; rr < 2; ++rr) { const size_t row = (size_t)b * T_ + (c) * 64 + 2 * tseg + rr; const bf16* p = BIG + row * CD_N + h * 128 + c8 * 8; \
        rq[rr] = *(const u32x4*)p; rz[rr] = *(const u32x4*)(p + 512); rv[rr] = *(const u32x4*)(p + 1024); } } while (0)
    HG_LOAD(0);
    __syncthreads();
    for (int c = 0; c < T_ / 64; ++c) {
        {
            float lf[2][8], kk[2][8], qv[2][8], cum[2][8];
#pragma unroll
            for (int rr = 0; rr < 2; ++rr)
#pragma unroll
                for (int e = 0; e < 4; ++e) {
                    const float z0 = fmaxf(bflo(rz[rr][e]), -60.f), z1 = fmaxf(bfhi(rz[rr][e]), -60.f);
                    const float e0 = __builtin_amdgcn_exp2f(-1.4426950408889634f * z0), e1 = __builtin_amdgcn_exp2f(-1.4426950408889634f * z1);
                    const float s0 = __builtin_amdgcn_rcpf(1.f + e0), s1 = __builtin_amdgcn_rcpf(1.f + e1);
                    const float f0 = lbv[2 * e] + (1.f - lbv[2 * e]) * s0, f1 = lbv[2 * e + 1] + (1.f - lbv[2 * e + 1]) * s1;
                    lf[rr][2 * e] = __logf(f0); lf[rr][2 * e + 1] = __logf(f1);
                    kk[rr][2 * e] = (1.f - lbv[2 * e]) * (e0 * s0); kk[rr][2 * e + 1] = (1.f - lbv[2 * e + 1]) * (e1 * s1);
                    qv[rr][2 * e] = bflo(rq[rr][e]); qv[rr][2 * e + 1] = bfhi(rq[rr][e]); }
            float ref1[8], clast[8];
#pragma unroll
            for (int e = 0; e < 8; ++e) {
                float s = lf[0][e] + lf[1][e];
#pragma unroll
                for (int o = 1; o < 32; o <<= 1) { const float n = __shfl_up(s, o, 32); if (tseg >= o) s += n; }
                cum[1][e] = s; cum[0][e] = s - lf[1][e];
                ref1[e] = __shfl(s, 15, 32); clast[e] = __shfl(s, 31, 32); }
            const bool blk1 = tseg >= 16;
            u32x4 wqx[2], wqt[2], wk0[2], wk1[2];
            float ko[2][8];
#pragma unroll
            for (int rr = 0; rr < 2; ++rr) {
                float qx[8], qt[8], k0[8], k1[8];
#pragma unroll
                for (int e = 0; e < 8; ++e) { const float cm = cum[rr][e]; const float rf = blk1 ? ref1[e] : 0.f;
                    qx[e] = qv[rr][e] * __expf(cm - rf); qt[e] = qv[rr][e] * __expf(cm);
                    k0[e] = kk[rr][e] * __expf(rf - cm);
                    k1[e] = kk[rr][e] * __expf(ref1[e] - cm);
                    ko[rr][e] = kk[rr][e] * __expf(clast[e] - cm); }
#pragma unroll
                for (int e = 0; e < 4; ++e) { wqx[rr][e] = pk2(qx[2 * e], qx[2 * e + 1]); wqt[rr][e] = pk2(qt[2 * e], qt[2 * e + 1]); wk0[rr][e] = pk2(k0[2 * e], k0[2 * e + 1]); wk1[rr][e] = pk2(k1[2 * e], k1[2 * e + 1]); }
            }
#pragma unroll
            for (int rr = 0; rr < 2; ++rr) { const int t = 2 * tseg + rr;
                *(u32x4*)(lds + OFF_QX + t * RW + c8 * 16) = wqx[rr]; *(u32x4*)(lds + OFF_QT + t * RW + c8 * 16) = wqt[rr];
                if (!blk1) { *(u32x4*)(lds + OFF_KV + t * RW + c8 * 16) = wk0[rr]; *(u32x4*)(lds + OFF_KV + 8704 + t * RW + c8 * 16) = wk1[rr]; }
                else       { *(u32x4*)(lds + OFF_KV + 2 * 8704 + (t - 32) * RW + c8 * 16) = wk0[rr]; } }
#pragma unroll
            for (int e = 0; e < 8; ++e) { *(unsigned*)(lds + OFF_KOT + (c8 * 8 + e) * RS + tseg * 4) = pk2(ko[0][e], ko[1][e]); }
#pragma unroll
            for (int e = 0; e < 4; ++e) { *(unsigned*)(lds + OFF_VT + (c8 * 8 + 2 * e) * RS + tseg * 4) = (rv[0][e] & 0xffffu) | (rv[1][e] << 16);
                *(unsigned*)(lds + OFF_VT + (c8 * 8 + 2 * e + 1) * RS + tseg * 4) = (rv[0][e] >> 16) | (rv[1][e] & 0xffff0000u); }
            if (tseg == 31) {
#pragma unroll
                for (int e = 0; e < 8; ++e) alL[c8 * 8 + e] = __expf(clast[e]); }
        }
        LBAR();
        if (c + 1 < T_ / 64) HG_LOAD(c + 1);
        u32x4 rgA, rgB;
        { const bf16* gp = BIG + ((size_t)b * T_ + c * 64 + (tid >> 3)) * CD_N + 1536 + h * 128 + (tid & 7) * 16; rgA = *(const u32x4*)gp; rgB = *(const u32x4*)(gp + 8); }
        if (wave < 3) {
            const int ib = (wave == 0) ? 0 : 1, jb = (wave == 2) ? 1 : 0;
            f32x16 acc;
#pragma unroll
            for (int r = 0; r < 16; ++r) acc[r] = 0.f;
#pragma unroll
            for (int s = 0; s < 8; ++s) { const bf16x8_t af = *(const bf16x8_t*)(lds + OFF_KV + wave * 8704 + l31 * RW + (16 * s + 8 * hi) * 2), bfr = *(const bf16x8_t*)(lds + OFF_QX + (32 * ib + l31) * RW + (16 * s + 8 * hi) * 2);
                acc = __builtin_amdgcn_mfma_f32_32x32x16_bf16(af, bfr, acc, 0, 0, 0); }
            const int i = 32 * ib + l31;
#pragma unroll
            for (int g4 = 0; g4 < 4; ++g4) { const int j0 = 32 * jb + 8 * g4 + 4 * hi; float v[4];
#pragma unroll
                for (int e = 0; e < 4; ++e) v[e] = (j0 + e <= i) ? acc[4 * g4 + e] : 0.f;
                u32x2 w; w.x = pk2(v[0], v[1]); w.y = pk2(v[2], v[3]);
                *(u32x2*)(lds + OFF_P + i * RS + j0 * 2) = w; }
        }
        LBAR();
        {
            const int ib = wave & 1, vb = wave >> 1;
            f32x16 acc;
#pragma unroll
            for (int r = 0; r < 16; ++r) acc[r] = 0.f;
#pragma unroll
            for (int s = 0; s < 4; ++s) { const bf16x8_t af = *(const bf16x8_t*)(lds + OFF_P + (32 * ib + l31) * RS + (16 * s + 8 * hi) * 2), bfr = *(const bf16x8_t*)(lds + OFF_VT + (32 * vb + l31) * RS + (16 * s + 8 * hi) * 2);
                acc = __builtin_amdgcn_mfma_f32_32x32x16_bf16(af, bfr, acc, 0, 0, 0); }
#pragma unroll
            for (int s = 0; s < 8; ++s) { const bf16x8_t af = *(const bf16x8_t*)(lds + OFF_QT + (32 * ib + l31) * RW + (16 * s + 8 * hi) * 2), bfr = *(const bf16x8_t*)(lds + OFF_ST + (32 * vb + l31) * RW + (16 * s + 8 * hi) * 2);
                acc = __builtin_amdgcn_mfma_f32_32x32x16_bf16(af, bfr, acc, 0, 0, 0); }
#pragma unroll
            for (int r = 0; r < 16; ++r) *(float*)(lds + OFF_OB + (32 * ib + crow16(r, hi)) * OBS + (32 * vb + l31) * 4) = acc[r];
        }
        const int svb = wave >> 1;
#pragma unroll
        for (int t = 0; t < 2; ++t) { const int db = 2 * (wave & 1) + t;
#pragma unroll
            for (int g4 = 0; g4 < 4; ++g4) { const f32x4 al = *(const f32x4*)(alL + 32 * db + 8 * g4 + 4 * hi);
#pragma unroll
                for (int e = 0; e < 4; ++e) sacc[t][4 * g4 + e] *= al[e]; }
#pragma unroll
            for (int s = 0; s < 4; ++s) { const bf16x8_t af = *(const bf16x8_t*)(lds + OFF_KOT + (32 * db + l31) * RS + (16 * s + 8 * hi) * 2), bfr = *(const bf16x8_t*)(lds + OFF_VT + (32 * svb + l31) * RS + (16 * s + 8 * hi) * 2);
                sacc[t] = __builtin_amdgcn_mfma_f32_32x32x16_bf16(af, bfr, sacc[t], 0, 0, 0); } }
        LBAR();
#pragma unroll
        for (int t = 0; t < 2; ++t) { const int db = 2 * (wave & 1) + t;
#pragma unroll
            for (int g4 = 0; g4 < 4; ++g4) { u32x2 w; w.x = pk2(sacc[t][4 * g4], sacc[t][4 * g4 + 1]); w.y = pk2(sacc[t][4 * g4 + 2], sacc[t][4 * g4 + 3]);
                *(u32x2*)(lds + OFF_ST + (32 * svb + l31) * RW + (32 * db + 8 * g4 + 4 * hi) * 2) = w; } }
        { const int i = tid >> 3, part = tid & 7; const size_t row = (size_t)b * T_ + c * 64 + i;
            float o[16]; float sq = 0.f;
#pragma unroll
            for (int q4 = 0; q4 < 4; ++q4) { const f32x4 v = *(const f32x4*)(lds + OFF_OB + i * OBS + part * 64 + q4 * 16);
                o[4 * q4] = v.x; o[4 * q4 + 1] = v.y; o[4 * q4 + 2] = v.z; o[4 * q4 + 3] = v.w; sq += (v.x * v.x + v.y * v.y) + (v.z * v.z + v.w * v.w); }
            sq += __shfl_xor(sq, 1); sq += __shfl_xor(sq, 2); sq += __shfl_xor(sq, 4);
            const float rs = rsqrtf(sq * (1.f / 128.f) + EPS_);
            u32x4 w0, w1;
#pragma unroll
            for (int e = 0; e < 4; ++e) { w0[e] = pk2(o[2 * e] * rs * gw[2 * e] * siluf(bflo(rgA[e])), o[2 * e + 1] * rs * gw[2 * e + 1] * siluf(bfhi(rgA[e])));
                w1[e] = pk2(o[8 + 2 * e] * rs * gw[8 + 2 * e] * siluf(bflo(rgB[e])), o[8 + 2 * e + 1] * rs * gw[8 + 2 * e + 1] * siluf(bfhi(rgB[e]))); }
            *(u32x4*)(Y + row * D_ + h * 128 + part * 16) = w0; *(u32x4*)(Y + row * D_ + h * 128 + part * 16 + 8) = w1; }
        LBAR();
    }
#undef HG_LOAD
}

__device__ __forceinline__ void fox_unit2(ArgsP a, int bh, int qb, unsigned char* lds) {
    const int tid = tid_fresh(), lane = tid & 63, wave = tid >> 6, l31 = lane & 31, hi = lane >> 5;
    const int b = bh >> 2, h = bh & 3;
    const bf16* BIG = (const bf16*)(a->ws + WS_BIG); bf16* Y = (bf16*)(a->ws + WS_UY);
    const bf16* VT = (const bf16*)(a->ws + WS_VT) + (size_t)bh * 128 * T_;
    const float* CUMF = (const float*)(a->ws + WS_CUMF) + (size_t)bh * T_;
    const int tq = qb * 256 + wave * 32 + l31; const size_t rowq = (size_t)b * T_ + tq;
    const float Fref = CUMF[qb * 256];
    bf16x8_t qf[8];
#pragma unroll
    for (int ks = 0; ks < 8; ++ks) qf[ks] = *(const bf16x8_t*)(BIG + BIGX(rowq, 2048 + h * 128 + 16 * ks + 8 * hi));
    f32x16 oT[4];
#pragma unroll
    for (int d = 0; d < 4; ++d)
#pragma unroll
        for (int r = 0; r < 16; ++r) oT[d][r] = 0.f;
    float m = -INFINITY, lsum = 0.f, alpha = 1.f;
    const int nt = 4 * qb + 4;
    const bf16* Kg = BIG + BIGX((size_t)b * T_, 2560 + h * 128);
    const int kr0 = tid >> 4, kc = tid & 15, vd0 = tid >> 3, vc = tid & 7;
    u32x4 kreg[2], vreg[2]; float breg;
#define FY_LOAD(kt) do { kreg[0] = *(const u32x4*)(Kg + (size_t)((kt) * 64 + kr0) * 256 + kc * 8); kreg[1] = *(const u32x4*)(Kg + (size_t)((kt) * 64 + kr0 + 32) * 256 + kc * 8); \
        vreg[0] = *(const u32x4*)(VT + (size_t)vd0 * T_ + (kt) * 64 + vc * 8); vreg[1] = *(const u32x4*)(VT + (size_t)(vd0 + 64) * T_ + (kt) * 64 + vc * 8); \
        breg = (Fref - CUMF[(kt) * 64 + lane]) * 1.4426950408889634f; } while (0)
#define FY_STORE(bb) do { *(u32x4*)((bb) + kr0 * FX_KROW + kc * 16) = kreg[0]; *(u32x4*)((bb) + (kr0 + 32) * FX_KROW + kc * 16) = kreg[1]; \
        *(u32x4*)((bb) + FX_KBYTES + vd0 * FX_VROW + vc * 16) = vreg[0]; *(u32x4*)((bb) + FX_KBYTES + (vd0 + 64) * FX_VROW + vc * 16) = vreg[1]; \
        ((float*)((bb) + FX_KBYTES + FX_VBYTES))[lane] = breg; } while (0)
#define FY_QK(S, bb) do { _Pragma("unroll") for (int hf = 0; hf < 2; ++hf) { _Pragma("unroll") for (int r = 0; r < 16; ++r) S[hf][r] = 0.f; \
        _Pragma("unroll") for (int ks = 0; ks < 8; ++ks) { const bf16x8_t kf = *(const bf16x8_t*)((bb) + (32 * hf + l31) * FX_KROW + (16 * ks + 8 * hi) * 2); \
            S[hf] = __builtin_amdgcn_mfma_f32_32x32x16_bf16(kf, qf[ks], S[hf], 0, 0, 0); } } } while (0)
#define FY_BMAX(S, bb, kt, MASK) do { const float* Bs = (const float*)((bb) + FX_KBYTES + FX_VBYTES); float mx = -INFINITY; \
        _Pragma("unroll") for (int hf = 0; hf < 2; ++hf) _Pragma("unroll") for (int g = 0; g < 4; ++g) { const f32x4 bv = *(const f32x4*)(Bs + 32 * hf + 8 * g + 4 * hi); \
            _Pragma("unroll") for (int e = 0; e < 4; ++e) { const int r = 4 * g + e; float s = S[hf][r] + bv[e]; \
                if (MASK) { const int kv = (kt) * 64 + 32 * hf + 8 * g + 4 * hi + e; if (kv > tq) s = -INFINITY; } \
                S[hf][r] = s; mx = fmaxf(mx, s); } } \
        mx = fmaxf(mx, __shfl_xor(mx, 32)); const float mn = fmaxf(m, mx); alpha = __builtin_amdgcn_exp2f(m - mn); m = mn; } while (0)
#define FY_EXP(S) do { float ps = 0.f; \
        _Pragma("unroll") for (int hf = 0; hf < 2; ++hf) _Pragma("unroll") for (int r = 0; r < 16; ++r) { const float e = __builtin_amdgcn_exp2f(S[hf][r] - m); S[hf][r] = e; ps += e; } \
        lsum = lsum * alpha + ps; \
        _Pragma("unroll") for (int d = 0; d < 4; ++d) _Pragma("unroll") for (int r = 0; r < 16; ++r) oT[d][r] *= alpha; \
        _Pragma("unroll") for (int ks2 = 0; ks2 < 4; ++ks2) { const int hf = ks2 >> 1, c = ks2 & 1; u32x4 w; \
            _Pragma("unroll") for (int e = 0; e < 4; ++e) w[e] = pk2(S[hf][8 * c + 2 * e], S[hf][8 * c + 2 * e + 1]); \
            pb[ks2] = __builtin_bit_cast(bf16x8_t, w); } } while (0)
#define FY_PV(bb) do { const unsigned char* vb = (bb) + FX_KBYTES; \
        _Pragma("unroll") for (int d = 0; d < 4; ++d) _Pragma("unroll") for (int ks2 = 0; ks2 < 4; ++ks2) { const unsigned char* vp = vb + (32 * d + l31) * FX_VROW + (16 * ks2 + 8 * hi) * 2; \
            const bf16x8_t vf = *(const bf16x8_t*)vp; \
            oT[d] = __builtin_amdgcn_mfma_f32_32x32x16_bf16(vf, pb[ks2], oT[d], 0, 0, 0); } } while (0)
    __syncthreads();
    FY_LOAD(0); FY_STORE(lds);
    FY_LOAD(1); FY_STORE(lds + FX_BUF);
    __syncthreads();
    f32x16 sc[2], sn[2]; bf16x8_t pb[4];
    FY_QK(sc, lds);
    FY_BMAX(sc, lds, 0, true);
    int bc = 0, bn = FX_BUF, bs = 2 * FX_BUF;
#define FY_ITER(MASK) do { const int tl = (t + 2 < nt) ? t + 2 : nt - 1; FY_LOAD(tl); \
        const bool do_next = !(MASK) || (64 * (t + 1) <= tqw_max), do_cur = !(MASK) || (64 * t <= tqw_max);     \
        if (do_next) FY_QK(sn, lds + bn); if (do_cur) FY_EXP(sc); \
        if (do_cur) FY_PV(lds + bc); if (do_next) FY_BMAX(sn, lds + bn, t + 1, MASK); \
        sc[0] = sn[0]; sc[1] = sn[1]; \
        FY_STORE(lds + bs); \
        const int tmp_ = bc; bc = bn; bn = bs; bs = tmp_; \
        __syncthreads(); } while (0)
    const int tqw_max = qb * 256 + wave * 32 + 31;
    int t = 0;
    for (; t + 1 < 4 * qb; ++t) FY_ITER(false);
    for (; t + 1 < nt; ++t) FY_ITER(true);
    if (64 * (nt - 1) <= tqw_max) { FY_EXP(sc); FY_PV(lds + bc); }
#undef FY_ITER
#undef FY_LOAD
#undef FY_STORE
#undef FY_QK
#undef FY_BMAX
#undef FY_EXP
#undef FY_PV
    lsum += __shfl_xor(lsum, 32);
    const float il = 1.f / lsum;
    bf16* yp = Y + rowq * D_ + 512 + h * 128;
#pragma unroll
    for (int d = 0; d < 4; ++d)
#pragma unroll
        for (int g = 0; g < 4; ++g) { u32x2 w; w.x = pk2(oT[d][4 * g] * il, oT[d][4 * g + 1] * il); w.y = pk2(oT[d][4 * g + 2] * il, oT[d][4 * g + 3] * il);
            *(u32x2*)(yp + 32 * d + 8 * g + 4 * hi) = w; }
}

constexpr size_t ST_TMP = 0, ST_DSRET = 32 * MiB, ST_DSSSD = 64 * MiB, ST_ALSSD = 96 * MiB;
constexpr size_t ST_DSHG = 32 * MiB, ST_ALHG = 96 * MiB;

template <int MODE  , int PASS  >
__device__ __forceinline__ void scalar_pass(ArgsP a, int j, int bh, int c0, int c1, unsigned char* lds) {
    constexpr int DV = MODE == 0 ? 128 : 64;
    constexpr int RS = 144;
    constexpr int OFF_QN = 0, OFF_QT = 9216, OFF_KN = 18432, OFF_KOT = 27648, OFF_VT = 36864, OFF_P = OFF_VT + DV * RS, OFF_ST = OFF_P + 9216, OFF_OB = OFF_ST + DV * RS;
    constexpr int OBS = DV * 4 + 16;
    constexpr int OFF_CUM = OFF_OB + 64 * OBS, OFF_TAB = OFF_CUM + 512;
    const int tid = tid_fresh(), lane = tid & 63, wave = tid >> 6, l31 = lane & 31, hi = lane >> 5;
    const int b = MODE == 0 ? (bh >> 2) : (bh >> 3), h = MODE == 0 ? (bh & 3) : (bh & 7), g = h >> 2;
    const bf16* BIG = (const bf16*)(a->ws + WS_BIG);
    const float* rope = (const float*)(a->ws + WS_ROPE); const float* GATE = (const float*)(a->ws + WS_GATE);
    bf16* Y = (bf16*)(a->ws + WS_UY); bf16* TMP = (bf16*)(a->ws + WS_ST + ST_TMP);
    bf16* DS = (bf16*)(a->ws + WS_ST + (MODE == 0 ? ST_DSRET : ST_DSSSD)) + (size_t)bh * 64 * (DV * 64);
    float* ALS = (float*)(a->ws + WS_ST + ST_ALSSD) + bh * 64;
    const float LOG2E = 1.4426950408889634f;
    const float gamma = 1.f - exp2f(-5.f - (float)h), lg2gamma = log2f(gamma);
    float dtb = 0.f, Aneg = 0.f, Dh = 0.f;
    if (MODE == 1) { dtb = a->in[11][j * 8 + h]; Aneg = -expf(a->in[12][j * 8 + h]); Dh = a->in[13][j * 8 + h]; }
    const float* gnw = a->in[8] + (j * 4 + h) * 128;
    float* cumL = (float*)(lds + OFF_CUM); float* tab = (float*)(lds + OFF_TAB);
    float gw[16];
#pragma unroll
    for (int e = 0; e < 16; ++e) gw[e] = (MODE == 0 && PASS == 1) ? gnw[(tid & 7) * 16 + e] : 0.f;
    const int st = tid >> 3, sc8 = lane & 7;
    const int tsw = (st ^ (sc8 << 3)) * 2;
    __syncthreads();
    if (PASS == 1) { for (int i = tid; i < 9216 / 4; i += 512) ((unsigned*)(lds + OFF_P))[i] = 0u; }
    if (MODE == 1) {
        const float* cw = a->in[9] + j * 4 * 768; const float* cb = a->in[10] + j * 768;
        for (int i = tid; i < 3 * 8 * 5 * 8; i += 512) { const int e = i & 7, w = (i >> 3) % 5, c8 = (i / 40) & 7, which = i / 320;
            const int col = (which == 0 ? h * 64 : (which == 1 ? 512 + g * 64 : 640 + g * 64)) + c8 * 8 + e;
            tab[i] = (w < 4) ? cw[w * 768 + col] : cb[col]; }
    }
    u32x4 rq, rk, rv0, rv1, rs0, rs1; f32x4 rcs, rsn; u32x4 rx[3][4]; float rgate = 0.f;
    constexpr int WH0 = (PASS == 0) ? 0 : 0, WH1 = (PASS == 0) ? 2 : 3;
#define SP_LOAD(c) do { const size_t row = (size_t)b * T_ + (c) * 64 + st; \
        if (MODE == 0) { if (PASS == 1) rq = *(const u32x4*)(BIG + BIGX(row, h * 64 + sc8 * 8)); rk = *(const u32x4*)(BIG + BIGX(row, 256 + h * 64 + sc8 * 8)); \
            rcs = *(const f32x4*)(rope + ((c) * 64 + st) * 32 + sc8 * 4); rsn = *(const f32x4*)(rope + T_ * 32 + ((c) * 64 + st) * 32 + sc8 * 4); \
            rv0 = *(const u32x4*)(BIG + BIGX(row, 512 + h * 128 + sc8 * 8)); rv1 = *(const u32x4*)(BIG + BIGX(row, 512 + h * 128 + (sc8 + 8) * 8)); } \
        else { _Pragma("unroll") for (int wh = WH0; wh < WH1; ++wh) { const int col = (wh == 0 ? h * 64 : (wh == 1 ? 512 + g * 64 : 640 + g * 64)) + sc8 * 8; \
                _Pragma("unroll") for (int w = 0; w < 4; ++w) { const int tt = (c) * 64 + st - 3 + w; \
                    rx[wh][w] = (tt >= 0) ? *(const u32x4*)(BIG + BIGX((size_t)b * T_ + tt, 2048 + col)) : (u32x4){0u, 0u, 0u, 0u}; } } \
            rgate = GATE[((size_t)b * T_ + (c) * 64 + lane) * 8 + h]; } \
        if (PASS == 1) { const bf16* sp = DS + (size_t)(c) * (DV * 64); rs0 = *(const u32x4*)(sp + tid * 8); if (MODE == 0) rs1 = *(const u32x4*)(sp + (tid + 512) * 8); } } while (0)
    SP_LOAD(c0);
    __syncthreads();
    for (int c = c0; c < c1; ++c) {
        for (int rs_ = 0; rs_ < RU_STAGE; ++rs_) {
        if (MODE == 0) {
            float q[8], k[8];
#pragma unroll
            for (int e = 0; e < 4; ++e) { const float k1 = bflo(rk[e]) * 0.125f, k2 = bfhi(rk[e]) * 0.125f; const float cs = rcs[e], sn = rsn[e];
                k[2 * e] = k1 * cs - k2 * sn; k[2 * e + 1] = k1 * sn + k2 * cs;
                if (PASS == 1) { const float q1 = bflo(rq[e]), q2 = bfhi(rq[e]); q[2 * e] = q1 * cs - q2 * sn; q[2 * e + 1] = q1 * sn + q2 * cs; } }
            if (PASS == 1) {
                const float gi = __builtin_amdgcn_exp2f((float)(st + 1) * lg2gamma);
                u32x4 w0, w1, w2;
#pragma unroll
                for (int e = 0; e < 4; ++e) { w0[e] = pk2(q[2 * e], q[2 * e + 1]); w1[e] = pk2(q[2 * e] * gi, q[2 * e + 1] * gi); w2[e] = pk2(k[2 * e], k[2 * e + 1]); }
                *(u32x4*)(lds + OFF_QN + st * RS + sc8 * 16) = w0; *(u32x4*)(lds + OFF_QT + st * RS + sc8 * 16) = w1; *(u32x4*)(lds + OFF_KN + st * RS + sc8 * 16) = w2;
            } else {
                const float go = __builtin_amdgcn_exp2f((float)(63 - st) * lg2gamma);
#pragma unroll
                for (int e = 0; e < 8; ++e) *(bf16*)(lds + OFF_KOT + (sc8 * 8 + e) * RS + tsw) = (bf16)f2bf(k[e] * go);
            }
#pragma unroll
            for (int e = 0; e < 4; ++e) { *(bf16*)(lds + OFF_VT + (sc8 * 8 + 2 * e) * RS + tsw) = (bf16)(rv0[e] & 0xffffu); *(bf16*)(lds + OFF_VT + (sc8 * 8 + 2 * e + 1) * RS + tsw) = (bf16)(rv0[e] >> 16);
                *(bf16*)(lds + OFF_VT + ((sc8 + 8) * 8 + 2 * e) * RS + tsw) = (bf16)(rv1[e] & 0xffffu); *(bf16*)(lds + OFF_VT + ((sc8 + 8) * 8 + 2 * e + 1) * RS + tsw) = (bf16)(rv1[e] >> 16); }
        } else {
            const float dtv = softplusf(rgate + dtb); float cumv = dtv * Aneg;
#pragma unroll
            for (int o = 1; o < 64; o <<= 1) { const float n = __shfl_up(cumv, o); if (lane >= o) cumv += n; }
            const float cum_t = __shfl(cumv, st), dt_t = __shfl(dtv, st), cum_last = __shfl(cumv, 63);
            if (wave == 0) { cumL[lane] = cumv; if (lane == 63) { cumL[64] = cumv; if (PASS == 0) ALS[c] = __expf(cumv); } }
            float val[3][8];
#pragma unroll
            for (int wh = WH0; wh < WH1; ++wh) { const float* tb = tab + (wh * 8 + sc8) * 40;
#pragma unroll
                for (int e = 0; e < 8; ++e) val[wh][e] = tb[32 + e];
#pragma unroll
                for (int w = 0; w < 4; ++w)
#pragma unroll
                    for (int e = 0; e < 4; ++e) { val[wh][2 * e] += tb[w * 8 + 2 * e] * bflo(rx[wh][w][e]); val[wh][2 * e + 1] += tb[w * 8 + 2 * e + 1] * bfhi(rx[wh][w][e]); }
#pragma unroll
                for (int e = 0; e < 8; ++e) val[wh][e] = siluf(val[wh][e]); }
            if (PASS == 1) {
                const float ei = __expf(cum_t);
                u32x4 w0, w1, w2;
#pragma unroll
                for (int e = 0; e < 4; ++e) { w0[e] = pk2(val[2][2 * e], val[2][2 * e + 1]); w1[e] = pk2(val[2][2 * e] * ei, val[2][2 * e + 1] * ei); w2[e] = pk2(val[1][2 * e] * dt_t, val[1][2 * e + 1] * dt_t); }
                *(u32x4*)(lds + OFF_QN + st * RS + sc8 * 16) = w0; *(u32x4*)(lds + OFF_QT + st * RS + sc8 * 16) = w1; *(u32x4*)(lds + OFF_KN + st * RS + sc8 * 16) = w2;
            } else {
                const float eo = dt_t * __expf(cum_last - cum_t);
#pragma unroll
                for (int e = 0; e < 8; ++e) *(bf16*)(lds + OFF_KOT + (sc8 * 8 + e) * RS + tsw) = (bf16)f2bf(val[1][e] * eo);
            }
#pragma unroll
            for (int e = 0; e < 8; ++e) *(bf16*)(lds + OFF_VT + (sc8 * 8 + e) * RS + tsw) = (bf16)f2bf(val[0][e]);
        }
        if (PASS == 1) {
            *(u32x4*)(lds + OFF_ST + (tid >> 3) * RS + (tid & 7) * 16) = rs0;
            if (MODE == 0) *(u32x4*)(lds + OFF_ST + ((tid >> 3) + 64) * RS + (tid & 7) * 16) = rs1;
        }
        LBAR();
        }
        if (c + 1 < c1) SP_LOAD(c + 1);
        if (PASS == 0) {
            if (MODE == 0 || wave < 4) {
                const int sdb = wave & 1, svb = (MODE == 0) ? (wave >> 1) : ((wave >> 1) & 1);
                f32x16 sacc;
#pragma unroll
                for (int r = 0; r < 16; ++r) sacc[r] = 0.f;
#pragma unroll
                for (int s = 0; s < 4; ++s) { const bf16x8_t af = *(const bf16x8_t*)(lds + OFF_KOT + (32 * sdb + l31) * RS + (((2 * s + hi) ^ ((l31 >> 3) & 7) ^ ((4 * sdb) & 7)) * 16)), bfr = *(const bf16x8_t*)(lds + OFF_VT + (32 * svb + l31) * RS + (((2 * s + hi) ^ ((l31 >> 3) & 7) ^ ((4 * svb) & 7)) * 16));
                    sacc = __builtin_amdgcn_mfma_f32_32x32x16_bf16(af, bfr, sacc, 0, 0, 0); }
                bf16* dp = DS + (size_t)c * (DV * 64) + (32 * svb + l31) * 64 + 32 * sdb + 4 * hi;
#pragma unroll
                for (int g4 = 0; g4 < 4; ++g4) { u32x2 w; w.x = pk2(sacc[4 * g4], sacc[4 * g4 + 1]); w.y = pk2(sacc[4 * g4 + 2], sacc[4 * g4 + 3]); *(u32x2*)(dp + 8 * g4) = w; }
            }
            LBAR();
        } else {
            unsigned rg[4]; u32x4 rgA, rgB;
            if (MODE == 0) { const bf16* gp = BIG + BIGX((size_t)b * T_ + c * 64 + (tid >> 3), 1024 + h * 128 + (tid & 7) * 16); rgA = *(const u32x4*)gp; rgB = *(const u32x4*)(gp + 8);
            } else {
#pragma unroll
                for (int k = 0; k < 4; ++k) { const int idx = tid + 512 * k; rg[k] = *(const unsigned*)(BIG + BIGX((size_t)b * T_ + c * 64 + (idx >> 5), 1536 + h * 64 + 2 * (idx & 31))); }
            }
            for (int rg_ = 0; rg_ < RU_G; ++rg_) {
            if (wave < 3) {
                const int jb = (wave == 2) ? 1 : 0, ib = (wave == 0) ? 0 : 1;
                f32x16 acc;
#pragma unroll
                for (int r = 0; r < 16; ++r) acc[r] = 0.f;
#pragma unroll
                for (int s = 0; s < 4; ++s) { const bf16x8_t af = *(const bf16x8_t*)(lds + OFF_KN + (32 * jb + l31) * RS + (16 * s + 8 * hi) * 2), bfr = *(const bf16x8_t*)(lds + OFF_QN + (32 * ib + l31) * RS + (16 * s + 8 * hi) * 2);
                    acc = __builtin_amdgcn_mfma_f32_32x32x16_bf16(af, bfr, acc, 0, 0, 0); }
                const int i = 32 * ib + l31; const float cum_i = (MODE == 1) ? cumL[i] : 0.f;
#pragma unroll
                for (int g4 = 0; g4 < 4; ++g4) { const int j0 = 32 * jb + 8 * g4 + 4 * hi; float v[4];
                    f32x4 cj = (f32x4){0.f, 0.f, 0.f, 0.f}; if (MODE == 1) cj = *(const f32x4*)(cumL + j0);
#pragma unroll
                    for (int e = 0; e < 4; ++e) { const int jj = j0 + e; const float ex = (MODE == 0) ? (float)(i - jj) * lg2gamma : (cum_i - cj[e]) * LOG2E;
                        v[e] = (jj <= i) ? acc[4 * g4 + e] * __builtin_amdgcn_exp2f(ex) : 0.f; }
                    u32x2 w; w.x = pk2(v[0], v[1]); w.y = pk2(v[2], v[3]);
                    *(u32x2*)(lds + OFF_P + i * RS + j0 * 2) = w; }
            }
            LBAR();
            }
            for (int ro_ = 0; ro_ < RU_O; ++ro_) {
            if (MODE == 0 || wave < 4) {
                const int ib = wave & 1, vb = (wave >> 1) & 3;
                f32x16 acc;
#pragma unroll
                for (int r = 0; r < 16; ++r) acc[r] = 0.f;
#pragma unroll
                for (int s = 0; s < 4; ++s) { const bf16x8_t af = *(const bf16x8_t*)(lds + OFF_P + (32 * ib + l31) * RS + (16 * s + 8 * hi) * 2), bfr = *(const bf16x8_t*)(lds + OFF_VT + (32 * vb + l31) * RS + (((2 * s + hi) ^ ((l31 >> 3) & 7) ^ ((4 * vb) & 7)) * 16));
                    acc = __builtin_amdgcn_mfma_f32_32x32x16_bf16(af, bfr, acc, 0, 0, 0); }
#pragma unroll
                for (int s = 0; s < 4; ++s) { const bf16x8_t af = *(const bf16x8_t*)(lds + OFF_QT + (32 * ib + l31) * RS + (16 * s + 8 * hi) * 2), bfr = *(const bf16x8_t*)(lds + OFF_ST + (32 * vb + l31) * RS + (16 * s + 8 * hi) * 2);
                    acc = __builtin_amdgcn_mfma_f32_32x32x16_bf16(af, bfr, acc, 0, 0, 0); }
                if (MODE == 1) {
#pragma unroll
                    for (int g4 = 0; g4 < 4; ++g4) { const u32x2 xv = *(const u32x2*)(lds + OFF_VT + (32 * vb + l31) * RS + (((4 * ib + g4) ^ ((l31 >> 3) & 7) ^ ((4 * vb) & 7)) * 16) + 8 * hi);
                        acc[4 * g4] += Dh * bflo(xv.x); acc[4 * g4 + 1] += Dh * bfhi(xv.x); acc[4 * g4 + 2] += Dh * bflo(xv.y); acc[4 * g4 + 3] += Dh * bfhi(xv.y); }
                }
#pragma unroll
                for (int r = 0; r < 16; ++r) *(float*)(lds + OFF_OB + (32 * ib + crow16(r, hi)) * OBS + (32 * vb + l31) * 4) = acc[r];
            }
            LBAR();
            }
            for (int rf_ = 0; rf_ < RU_FIN; ++rf_) {
            if (MODE == 0) {
                const int i = tid >> 3, part = tid & 7; const size_t row = (size_t)b * T_ + c * 64 + i;
                float o[16]; float sm = 0.f, sq = 0.f;
#pragma unroll
                for (int q4 = 0; q4 < 4; ++q4) { const f32x4 v = *(const f32x4*)(lds + OFF_OB + i * OBS + part * 64 + q4 * 16);
                    o[4 * q4] = v.x; o[4 * q4 + 1] = v.y; o[4 * q4 + 2] = v.z; o[4 * q4 + 3] = v.w; sm += (v.x + v.y) + (v.z + v.w); sq += (v.x * v.x + v.y * v.y) + (v.z * v.z + v.w * v.w); }
                sm += __shfl_xor(sm, 1); sq += __shfl_xor(sq, 1); sm += __shfl_xor(sm, 2); sq += __shfl_xor(sq, 2); sm += __shfl_xor(sm, 4); sq += __shfl_xor(sq, 4);
                const float mean = sm * (1.f / 128.f); const float rs = rsqrtf(fmaxf(sq * (1.f / 128.f) - mean * mean, 0.f) + EPS_);
                u32x4 w0, w1;
#pragma unroll
                for (int e = 0; e < 4; ++e) { w0[e] = pk2((o[2 * e] - mean) * rs * gw[2 * e] * siluf(bflo(rgA[e])), (o[2 * e + 1] - mean) * rs * gw[2 * e + 1] * siluf(bfhi(rgA[e])));
                    w1[e] = pk2((o[8 + 2 * e] - mean) * rs * gw[8 + 2 * e] * siluf(bflo(rgB[e])), (o[8 + 2 * e + 1] - mean) * rs * gw[8 + 2 * e + 1] * siluf(bfhi(rgB[e]))); }
                *(u32x4*)(Y + row * D_ + h * 128 + part * 16) = w0; *(u32x4*)(Y + row * D_ + h * 128 + part * 16 + 8) = w1;
            } else {
#pragma unroll
                for (int k = 0; k < 4; ++k) { const int idx = tid + 512 * k, i = idx >> 5, p = 2 * (idx & 31); const size_t row = (size_t)b * T_ + c * 64 + i;
                    const f32x2_t y = *(const f32x2_t*)(lds + OFF_OB + i * OBS + p * 4);
                    *(unsigned*)(TMP + row * 512 + h * 64 + p) = pk2(y.x * siluf(bflo(rg[k])), y.y * siluf(bfhi(rg[k]))); }
            }
            }
        }
    }
#undef SP_LOAD
    __syncthreads();
}

__device__ __forceinline__ void ssd_passA2(ArgsP a, int j, int bh, int c0, int c1, unsigned char* lds) {
    constexpr int RS = 144;
    constexpr int OFF_KOT = 0, OFF_VT = 18432, OFF_TAB = 36864;
    const int tid = tid_fresh(), lane = tid & 63, wave = tid >> 6, l31 = lane & 31, hi = lane >> 5;
    const int b = bh >> 3, h = bh & 7, g = h >> 2;
    const bf16* BIG = (const bf16*)(a->ws + WS_BIG); const float* GATE = (const float*)(a->ws + WS_GATE);
    bf16* DS = (bf16*)(a->ws + WS_ST + ST_DSSSD) + (size_t)bh * 64 * 4096;
    float* ALS = (float*)(a->ws + WS_ST + ST_ALSSD) + bh * 64;
    const float dtb = a->in[11][j * 8 + h], Aneg = -expf(a->in[12][j * 8 + h]);
    float* tab = (float*)(lds + OFF_TAB);
    const int st = tid >> 3, sc8 = lane & 7; const int tsw = (st ^ (sc8 << 3)) * 2;
    __syncthreads();
    {
        const float* cw = a->in[9] + j * 4 * 768; const float* cb = a->in[10] + j * 768;
        for (int i = tid; i < 2 * 8 * 5 * 8; i += 512) { const int e = i & 7, w = (i >> 3) % 5, c8 = (i / 40) & 7, which = i / 320;
            const int col = (which == 0 ? h * 64 : 512 + g * 64) + c8 * 8 + e;
            tab[i] = (w < 4) ? cw[w * 768 + col] : cb[col]; }
    }
    u32x4 rx[2][2][4]; float rgate[2];
#define A2_LOAD(c, q) do { _Pragma("unroll") for (int wh = 0; wh < 2; ++wh) { const int col = (wh == 0 ? h * 64 : 512 + g * 64) + sc8 * 8; \
            _Pragma("unroll") for (int w = 0; w < 4; ++w) { const int tt = (c) * 64 + st - 3 + w; \
                rx[q][wh][w] = (tt >= 0) ? *(const u32x4*)(BIG + BIGX((size_t)b * T_ + tt, 2048 + col)) : (u32x4){0u, 0u, 0u, 0u}; } } \
        rgate[q] = GATE[((size_t)b * T_ + (c) * 64 + lane) * 8 + h]; } while (0)
    A2_LOAD(c0, 0); A2_LOAD(c0 + 1, 1);
    __syncthreads();
    for (int c = c0; c < c1; c += 2) {
#pragma unroll
        for (int q = 0; q < 2; ++q) {
            const float dtv = softplusf(rgate[q] + dtb); float cumv = dtv * Aneg;
#pragma unroll
            for (int o = 1; o < 64; o <<= 1) { const float n = __shfl_up(cumv, o); if (lane >= o) cumv += n; }
            const float cum_t = __shfl(cumv, st), dt_t = __shfl(dtv, st), cum_last = __shfl(cumv, 63);
            if (wave == 0 && lane == 63) ALS[c + q] = __expf(cumv);
            float val[2][8];
#pragma unroll
            for (int wh = 0; wh < 2; ++wh) { const float* tb = tab + (wh * 8 + sc8) * 40;
#pragma unroll
                for (int e = 0; e < 8; ++e) val[wh][e] = tb[32 + e];
#pragma unroll
                for (int w = 0; w < 4; ++w)
#pragma unroll
                    for (int e = 0; e < 4; ++e) { val[wh][2 * e] += tb[w * 8 + 2 * e] * bflo(rx[q][wh][w][e]); val[wh][2 * e + 1] += tb[w * 8 + 2 * e + 1] * bfhi(rx[q][wh][w][e]); }
#pragma unroll
                for (int e = 0; e < 8; ++e) val[wh][e] = siluf(val[wh][e]); }
            const float eo = dt_t * __expf(cum_last - cum_t);
#pragma unroll
            for (int e = 0; e < 8; ++e) { *(bf16*)(lds + OFF_KOT + q * 9216 + (sc8 * 8 + e) * RS + tsw) = (bf16)f2bf(val[1][e] * eo); *(bf16*)(lds + OFF_VT + q * 9216 + (sc8 * 8 + e) * RS + tsw) = (bf16)f2bf(val[0][e]); }
        }
        LBAR();
        if (c + 2 < c1) { A2_LOAD(c + 2, 0); A2_LOAD(c + 3, 1); }
        {
            const int q = wave >> 2, sdb = wave & 1, svb = (wave >> 1) & 1; const int swz = (l31 >> 3) & 7;
            f32x16 sacc;
#pragma unroll
            for (int r = 0; r < 16; ++r) sacc[r] = 0.f;
#pragma unroll
            for (int s = 0; s < 4; ++s) { const bf16x8_t af = *(const bf16x8_t*)(lds + OFF_KOT + q * 9216 + (32 * sdb + l31) * RS + (((2 * s + hi) ^ swz ^ ((4 * sdb) & 7)) * 16)), bfr = *(const bf16x8_t*)(lds + OFF_VT + q * 9216 + (32 * svb + l31) * RS + (((2 * s + hi) ^ swz ^ ((4 * svb) & 7)) * 16));
                sacc = __builtin_amdgcn_mfma_f32_32x32x16_bf16(af, bfr, sacc, 0, 0, 0); }
            bf16* dp = DS + (size_t)(c + q) * 4096 + (32 * svb + l31) * 64 + 32 * sdb + 4 * hi;
#pragma unroll
            for (int g4 = 0; g4 < 4; ++g4) { u32x2 w; w.x = pk2(sacc[4 * g4], sacc[4 * g4 + 1]); w.y = pk2(sacc[4 * g4 + 2], sacc[4 * g4 + 3]); *(u32x2*)(dp + 8 * g4) = w; }
        }
        LBAR();
    }
#undef A2_LOAD
    __syncthreads();
}

template <int MODE>
__device__ __forceinline__ void scalar_scan(ArgsP a) {
    constexpr int E2 = (MODE == 0 ? 128 : 64) * 64 / 2;
    constexpr int NS = MODE == 0 ? 32 : 64;
    unsigned* DS = (unsigned*)(a->ws + WS_ST + (MODE == 0 ? ST_DSRET : ST_DSSSD));
    const float* ALS = (const float*)(a->ws + WS_ST + ST_ALSSD);
    for (int it = bid_fresh() * 512 + tid_fresh(); it < NS * E2; it += gdim_fresh() * 512) {
        const int s = it / E2, e = it % E2;
        unsigned* p = DS + (size_t)s * 64 * E2 + e;
        float al = 1.f; if (MODE == 0) { const int h = s & 3; const float gamma = 1.f - exp2f(-5.f - (float)h); al = exp2f(64.f * log2f(gamma)); }
        float r0 = 0.f, r1 = 0.f;
        unsigned wn[8]; float an[8];
#pragma unroll
        for (int k = 0; k < 8; ++k) { wn[k] = p[(size_t)k * E2]; an[k] = (MODE == 0) ? al : ALS[s * 64 + k]; }
        for (int c0 = 0; c0 < 64; c0 += 8) {
            unsigned w[8]; float av[8];
#pragma unroll
            for (int k = 0; k < 8; ++k) { w[k] = wn[k]; av[k] = an[k]; }
            if (c0 + 8 < 64) {
#pragma unroll
                for (int k = 0; k < 8; ++k) { wn[k] = p[(size_t)(c0 + 8 + k) * E2]; an[k] = (MODE == 0) ? al : ALS[s * 64 + c0 + 8 + k]; } }
#pragma unroll
            for (int k = 0; k < 8; ++k) { p[(size_t)(c0 + k) * E2] = pk2(r0, r1); r0 = av[k] * r0 + bflo(w[k]); r1 = av[k] * r1 + bfhi(w[k]); }
        }
    }
}

template <int PASS  >
__device__ __forceinline__ void hg_pass(ArgsP a, int j, int bh, int c0, int c1, unsigned char* lds) {
    constexpr int RS = 144, RW = 272;
    constexpr int OFF_QX = 0, OFF_KV = 17408, OFF_OB = 0  , OFF_QT = 43520, OFF_KOT = 60928, OFF_VT = 79360, OFF_P = 97792, OFF_ST = 107008, OFF_AL = 141824;
    constexpr int OBS = 528;
    const int tid = tid_fresh(), lane = tid & 63, wave = tid >> 6, l31 = lane & 31, hi = lane >> 5;
    const int b = bh >> 2, h = bh & 3;
    const bf16* BIG = (const bf16*)(a->ws + WS_BIG); bf16* Y = (bf16*)(a->ws + WS_UY);
    bf16* DS = (bf16*)(a->ws + WS_ST + ST_DSHG) + (size_t)bh * 64 * 16384;
    float* ALG = (float*)(a->ws + WS_ST + ST_ALHG) + (size_t)bh * 64 * 128;
    const float* nw = a->in[18] + j * 128;
    const int c8 = wave * 2 + hi, tseg = l31;
    float lbv[8];
#pragma unroll
    for (int e = 0; e < 8; ++e) { lbv[e] = 0.f; if (j == 1) { const float l0 = a->in[17][h * 128 + c8 * 8 + e], l1 = a->in[17][512 + h * 128 + c8 * 8 + e]; lbv[e] = 1.f / (1.f + expf(l0 - l1)); } }
    float gw[16];
#pragma unroll
    for (int e = 0; e < 16; ++e) gw[e] = (PASS == 1) ? nw[(tid & 7) * 16 + e] : 0.f;
    __syncthreads();
    if (PASS == 1) { for (int i = tid; i < 9216 / 4; i += 512) ((unsigned*)(lds + OFF_P))[i] = 0u; }
    u32x4 rz[2], rq[2], rv[2], rs[4];
#define HP_LOAD(c) do { _Pragma("unroll") for (int rr = 0; rr < 2; ++rr) { const size_t row = (size_t)b * T_ + (c) * 64 + 2 * tseg + rr; \
        if (PASS == 1) rq[rr] = *(const u32x4*)(BIG + BIGX(row, h * 128 + c8 * 8)); rz[rr] = *(const u32x4*)(BIG + BIGX(row, 512 + h * 128 + c8 * 8)); rv[rr] = *(const u32x4*)(BIG + BIGX(row, 1024 + h * 128 + c8 * 8)); } \
        if (PASS == 1) { const bf16* sp = DS + (size_t)(c) * 16384; _Pragma("unroll") for (int k = 0; k < 4; ++k) rs[k] = *(const u32x4*)(sp + (tid + 512 * k) * 8); } } while (0)
    HP_LOAD(c0);
    __syncthreads();
    for (int c = c0; c < c1; ++c) {
        {
            float lf[2][8], kk[2][8], qv[2][8], cum[2][8];
#pragma unroll
            for (int rr = 0; rr < 2; ++rr)
#pragma unroll
                for (int e = 0; e < 4; ++e) {
                    const float z0 = fmaxf(bflo(rz[rr][e]), -60.f), z1 = fmaxf(bfhi(rz[rr][e]), -60.f);
                    const float e0 = __builtin_amdgcn_exp2f(-1.4426950408889634f * z0), e1 = __builtin_amdgcn_exp2f(-1.4426950408889634f * z1);
                    const float s0 = __builtin_amdgcn_rcpf(1.f + e0), s1 = __builtin_amdgcn_rcpf(1.f + e1);
                    const float f0 = lbv[2 * e] + (1.f - lbv[2 * e]) * s0, f1 = lbv[2 * e + 1] + (1.f - lbv[2 * e + 1]) * s1;
                    lf[rr][2 * e] = __logf(f0); lf[rr][2 * e + 1] = __logf(f1);
                    kk[rr][2 * e] = (1.f - lbv[2 * e]) * (e0 * s0); kk[rr][2 * e + 1] = (1.f - lbv[2 * e + 1]) * (e1 * s1);
                    if (PASS == 1) { qv[rr][2 * e] = bflo(rq[rr][e]); qv[rr][2 * e + 1] = bfhi(rq[rr][e]); } }
            float ref1[8], clast[8];
#pragma unroll
            for (int e = 0; e < 8; ++e) {
                float s = lf[0][e] + lf[1][e];
#pragma unroll
                for (int o = 1; o < 32; o <<= 1) { const float n = __shfl_up(s, o, 32); if (tseg >= o) s += n; }
                cum[1][e] = s; cum[0][e] = s - lf[1][e];
                ref1[e] = __shfl(s, 15, 32); clast[e] = __shfl(s, 31, 32); }
            const bool blk1 = tseg >= 16;
            if (PASS == 1) {
#pragma unroll
                for (int rr = 0; rr < 2; ++rr) { const int t = 2 * tseg + rr;
                    float qx[8], qt[8], k0[8], k1[8];
#pragma unroll
                    for (int e = 0; e < 8; ++e) { const float cm = cum[rr][e]; const float rf = blk1 ? ref1[e] : 0.f;
                        qx[e] = qv[rr][e] * __expf(cm - rf); qt[e] = qv[rr][e] * __expf(cm);
                        k0[e] = kk[rr][e] * __expf(rf - cm); k1[e] = kk[rr][e] * __expf(ref1[e] - cm); }
                    u32x4 wqx, wqt, wk0, wk1;
#pragma unroll
                    for (int e = 0; e < 4; ++e) { wqx[e] = pk2(qx[2 * e], qx[2 * e + 1]); wqt[e] = pk2(qt[2 * e], qt[2 * e + 1]); wk0[e] = pk2(k0[2 * e], k0[2 * e + 1]); wk1[e] = pk2(k1[2 * e], k1[2 * e + 1]); }
                    *(u32x4*)(lds + OFF_QX + t * RW + c8 * 16) = wqx; *(u32x4*)(lds + OFF_QT + t * RW + c8 * 16) = wqt;
                    if (!blk1) { *(u32x4*)(lds + OFF_KV + t * RW + c8 * 16) = wk0; *(u32x4*)(lds + OFF_KV + 8704 + t * RW + c8 * 16) = wk1; }
                    else       { *(u32x4*)(lds + OFF_KV + 2 * 8704 + (t - 32) * RW + c8 * 16) = wk0; } }
#pragma unroll
                for (int k = 0; k < 4; ++k) { const int id = tid + 512 * k; *(u32x4*)(lds + OFF_ST + (id >> 4) * RW + (id & 15) * 16) = rs[k]; }
            } else {
#pragma unroll
                for (int e = 0; e < 8; ++e) { *(unsigned*)(lds + OFF_KOT + (c8 * 8 + e) * RS + tseg * 4) = pk2(kk[0][e] * __expf(clast[e] - cum[0][e]), kk[1][e] * __expf(clast[e] - cum[1][e])); }
                if (tseg == 31) {
#pragma unroll
                    for (int e = 0; e < 8; ++e) ALG[c * 128 + c8 * 8 + e] = __expf(clast[e]); }
            }
#pragma unroll
            for (int e = 0; e < 4; ++e) { *(unsigned*)(lds + OFF_VT + (c8 * 8 + 2 * e) * RS + tseg * 4) = (rv[0][e] & 0xffffu) | (rv[1][e] << 16);
                *(unsigned*)(lds + OFF_VT + (c8 * 8 + 2 * e + 1) * RS + tseg * 4) = (rv[0][e] >> 16) | (rv[1][e] & 0xffff0000u); }
        }
        LBAR();
        if (c + 1 < c1) HP_LOAD(c + 1);
        if (PASS == 0) {
            const int svb = wave >> 1;
#pragma unroll
            for (int t = 0; t < 2; ++t) { const int db = 2 * (wave & 1) + t;
                f32x16 sacc;
#pragma unroll
                for (int r = 0; r < 16; ++r) sacc[r] = 0.f;
#pragma unroll
                for (int s = 0; s < 4; ++s) { const bf16x8_t af = *(const bf16x8_t*)(lds + OFF_KOT + (32 * db + l31) * RS + (16 * s + 8 * hi) * 2), bfr = *(const bf16x8_t*)(lds + OFF_VT + (32 * svb + l31) * RS + (16 * s + 8 * hi) * 2);
                    sacc = __builtin_amdgcn_mfma_f32_32x32x16_bf16(af, bfr, sacc, 0, 0, 0); }
                bf16* dp = DS + (size_t)c * 16384 + (32 * svb + l31) * 128 + 32 * db + 4 * hi;
#pragma unroll
                for (int g4 = 0; g4 < 4; ++g4) { u32x2 w; w.x = pk2(sacc[4 * g4], sacc[4 * g4 + 1]); w.y = pk2(sacc[4 * g4 + 2], sacc[4 * g4 + 3]); *(u32x2*)(dp + 8 * g4) = w; } }
            LBAR();
        } else {
            u32x4 rgA, rgB;
            { const bf16* gp = BIG + BIGX((size_t)b * T_ + c * 64 + (tid >> 3), 1536 + h * 128 + (tid & 7) * 16); rgA = *(const u32x4*)gp; rgB = *(const u32x4*)(gp + 8); }
            if (wave < 3) {
                const int ib = (wave == 0) ? 0 : 1, jb = (wave == 2) ? 1 : 0;
                f32x16 acc;
#pragma unroll
                for (int r = 0; r < 16; ++r) acc[r] = 0.f;
#pragma unroll
                for (int s = 0; s < 8; ++s) { const bf16x8_t af = *(const bf16x8_t*)(lds + OFF_KV + wave * 8704 + l31 * RW + (16 * s + 8 * hi) * 2), bfr = *(const bf16x8_t*)(lds + OFF_QX + (32 * ib + l31) * RW + (16 * s + 8 * hi) * 2);
                    acc = __builtin_amdgcn_mfma_f32_32x32x16_bf16(af, bfr, acc, 0, 0, 0); }
                const int i = 32 * ib + l31;
#pragma unroll
                for (int g4 = 0; g4 < 4; ++g4) { const int j0 = 32 * jb + 8 * g4 + 4 * hi; float v[4];
#pragma unroll
                    for (int e = 0; e < 4; ++e) v[e] = (j0 + e <= i) ? acc[4 * g4 + e] : 0.f;
                    u32x2 w; w.x = pk2(v[0], v[1]); w.y = pk2(v[2], v[3]);
                    *(u32x2*)(lds + OFF_P + i * RS + j0 * 2) = w; }
            }
            LBAR();
            {
                const int ib = wave & 1, vb = wave >> 1;
                f32x16 acc;
#pragma unroll
                for (int r = 0; r < 16; ++r) acc[r] = 0.f;
#pragma unroll
                for (int s = 0; s < 4; ++s) { const bf16x8_t af = *(const bf16x8_t*)(lds + OFF_P + (32 * ib + l31) * RS + (16 * s + 8 * hi) * 2), bfr = *(const bf16x8_t*)(lds + OFF_VT + (32 * vb + l31) * RS + (16 * s + 8 * hi) * 2);
                    acc = __builtin_amdgcn_mfma_f32_32x32x16_bf16(af, bfr, acc, 0, 0, 0); }
#pragma unroll
                for (int s = 0; s < 8; ++s) { const bf16x8_t af = *(const bf16x8_t*)(lds + OFF_QT + (32 * ib + l31) * RW + (16 * s + 8 * hi) * 2), bfr = *(const bf16x8_t*)(lds + OFF_ST + (32 * vb + l31) * RW + (16 * s + 8 * hi) * 2);
                    acc = __builtin_amdgcn_mfma_f32_32x32x16_bf16(af, bfr, acc, 0, 0, 0); }
#pragma unroll
                for (int r = 0; r < 16; ++r) *(float*)(lds + OFF_OB + (32 * ib + crow16(r, hi)) * OBS + (32 * vb + l31) * 4) = acc[r];
            }
            LBAR();
            { const int i = tid >> 3, part = tid & 7; const size_t row = (size_t)b * T_ + c * 64 + i;
                float o[16]; float sq = 0.f;
#pragma unroll
                for (int q4 = 0; q4 < 4; ++q4) { const f32x4 v = *(const f32x4*)(lds + OFF_OB + i * OBS + part * 64 + q4 * 16);
                    o[4 * q4] = v.x; o[4 * q4 + 1] = v.y; o[4 * q4 + 2] = v.z; o[4 * q4 + 3] = v.w; sq += (v.x * v.x + v.y * v.y) + (v.z * v.z + v.w * v.w); }
                sq += __shfl_xor(sq, 1); sq += __shfl_xor(sq, 2); sq += __shfl_xor(sq, 4);
                const float rsn = rsqrtf(sq * (1.f / 128.f) + EPS_);
                u32x4 w0, w1;
#pragma unroll
                for (int e = 0; e < 4; ++e) { w0[e] = pk2(o[2 * e] * rsn * gw[2 * e] * siluf(bflo(rgA[e])), o[2 * e + 1] * rsn * gw[2 * e + 1] * siluf(bfhi(rgA[e])));
                    w1[e] = pk2(o[8 + 2 * e] * rsn * gw[8 + 2 * e] * siluf(bflo(rgB[e])), o[8 + 2 * e + 1] * rsn * gw[8 + 2 * e + 1] * siluf(bfhi(rgB[e]))); }
                *(u32x4*)(Y + row * D_ + h * 128 + part * 16) = w0; *(u32x4*)(Y + row * D_ + h * 128 + part * 16 + 8) = w1; }
            LBAR();
        }
    }
#undef HP_LOAD
    __syncthreads();
}

__device__ __forceinline__ void hg_scan(ArgsP a) {
    constexpr int E2 = 8192;
    unsigned* DS = (unsigned*)(a->ws + WS_ST + ST_DSHG);
    const float* ALG = (const float*)(a->ws + WS_ST + ST_ALHG);
    for (int it = bid_fresh() * 512 + tid_fresh(); it < 32 * E2; it += gdim_fresh() * 512) {
        const int s = it / E2, e = it % E2; const int d = (2 * e) & 127;
        unsigned* p = DS + (size_t)s * 64 * E2 + e;
        const float* al = ALG + (size_t)s * 64 * 128 + d;
        float r0 = 0.f, r1 = 0.f;
        unsigned wn[8]; f32x2_t an[8];
#pragma unroll
        for (int k = 0; k < 8; ++k) { wn[k] = p[(size_t)k * E2]; an[k] = *(const f32x2_t*)(al + k * 128); }
        for (int c0 = 0; c0 < 64; c0 += 8) {
            unsigned w[8]; f32x2_t av[8];
#pragma unroll
            for (int k = 0; k < 8; ++k) { w[k] = wn[k]; av[k] = an[k]; }
            if (c0 + 8 < 64) {
#pragma unroll
                for (int k = 0; k < 8; ++k) { wn[k] = p[(size_t)(c0 + 8 + k) * E2]; an[k] = *(const f32x2_t*)(al + (c0 + 8 + k) * 128); } }
#pragma unroll
            for (int k = 0; k < 8; ++k) { p[(size_t)(c0 + k) * E2] = pk2(r0, r1); r0 = av[k].x * r0 + bflo(w[k]); r1 = av[k].y * r1 + bfhi(w[k]); }
        }
    }
}

#ifndef REP_PROLOGUE
#define REP_PROLOGUE 1
#endif
#ifndef REP_NORM
#define REP_NORM 1
#endif
#ifndef REP_INPROJ
#define REP_INPROJ 1
#endif
#ifndef REP_EVENMIX
#define REP_EVENMIX 1
#endif
#ifndef REP_ODDMIX
#define REP_ODDMIX 1
#endif
#ifndef REP_SYNC
#define REP_SYNC 1
#endif
#ifndef REP_FOX
#define REP_FOX 1
#endif
#ifndef REP_UP
#define REP_UP 1
#endif
__global__ void __launch_bounds__(512, 2) fwd_kernel(Args a_unused) {
    extern __shared__ __attribute__((aligned(16))) unsigned char lds[];
    cg::grid_group grid = cg::this_grid();
    PG8_LAS unsigned char* lds3 = (PG8_LAS unsigned char*)lds;
    volatile int* s_nextp = (volatile int*)(lds + 141 * 1024);
    volatile LAS unsigned* xmisc = (volatile LAS unsigned*)((LAS unsigned char*)lds + 145920);
    if (tid_fresh() < 2) xmisc[tid_fresh()] = 0u;
    __syncthreads();
    { ArgsP a = fresh_args(); (void)xcd_barrier_post((unsigned*)(a->ws + WS_CTL) + 4096, xmisc); }
#define XSYNC() do { ArgsP a_ = fresh_args(); XcdBarrier xb_; xb_.bar = (unsigned*)(a_->ws + WS_CTL) + 4096; xb_.x = xb_xcc_id(); xb_.st = (volatile LAS unsigned*)((LAS unsigned char*)lds + 145920); xcd_barrier(xb_); } while (0)

    for (int rep = 0; rep < REP_PROLOGUE; ++rep) { { ArgsP a = fresh_args(); prologue(a, lds); }
    XSYNC(); }
    { ArgsP a = fresh_args(); if (a->ws == nullptr) grid.sync(); }

#pragma unroll 1
    for (int L = 0; L < 4; ++L) {
        const int j = L >> 1; const bool even = (L & 1) == 0;
        for (int rep = 0; rep < REP_NORM; ++rep) {
        { ArgsP a = fresh_args(); unsigned char* ws = a->ws;
          const float* Wg = even ? a->in[6] + (size_t)j * D_ * AB_LD : a->in[15] + (size_t)j * D_ * CD_LD; const int ldw = even ? AB_LD : CD_LD, goff = even ? AB_N : CD_N, ng = even ? 8 : 4;
          if (L == 0) norm_phase<false, true>(a->in[0], a->in[1] + L * D_, (bf16*)(ws + WS_UY), Wg, ldw, goff, ng, (float*)(ws + WS_GATE), (float*)(ws + WS_RSTD1), lds);
          else        norm_phase<true, false>(a->out, a->in[1] + L * D_, nullptr, Wg, ldw, goff, ng, (float*)(ws + WS_GATE), (float*)(ws + WS_RSTD1), lds); }
        XSYNC(); }
        for (int rep = 0; rep < REP_INPROJ; ++rep) {
        { const int bx = bid_fresh(); if (!even && bx < 32) { ArgsP a = fresh_args(); cumf_seq(a, j, bx, lds); } }
#ifndef NO_INPROJ
        if (even) { ArgsP a = fresh_args(); unsigned char* ws = a->ws;
            pg8::Gemm g{(L == 0) ? (const bf16*)(ws + WS_UY) : (const bf16*)a->out, (const bf16*)(ws + WS_WABIN) + (size_t)j * AB_N * D_, M_, AB_N, D_}; pg8::StaticOrder S; S.init(M_, AB_N, gdim_fresh(), bid_fresh());
            pg8::EpiBf16BlkR E{(bf16*)(ws + WS_BIG), M_, (const float*)(ws + WS_RSTD1)};
            pg8::gemm_phase<pg8::EpiBf16BlkR, pg8::StaticOrder, true, true>(lds3, g, S, E);
        } else { ArgsP a = fresh_args(); unsigned char* ws = a->ws;
            pg8::Gemm g{(const bf16*)a->out, (const bf16*)(ws + WS_WCDIN) + (size_t)j * CD_N * D_, M_, CD_N, D_}; pg8::StaticOrder S; S.init(M_, CD_N, gdim_fresh(), bid_fresh());
            pg8::EpiBf16BlkR E{(bf16*)(ws + WS_BIG), M_, (const float*)(ws + WS_RSTD1)};
            pg8::gemm_phase<pg8::EpiBf16BlkR, pg8::StaticOrder, true, true>(lds3, g, S, E);
        }
#endif
        XSYNC(); }
        if (even) {
          for (int rep = 0; rep < REP_EVENMIX; ++rep) {
            if (rep) XSYNC();
#define EVEN_PASS(PASS) do { ArgsP a = fresh_args(); const int G_ = gdim_fresh(), bx = bid_fresh(); const int perr = (2048 + G_ - 1) / G_, pers = (4096 + G_ - 1) / G_;     \
              { int u = bx * perr; const int end = min(u + perr, 2048); while (u < end) { const int bh = u >> 6, ce = min(end, (bh + 1) * 64); scalar_pass<0, PASS>(a, j, bh, u & 63, ce - bh * 64, lds); u = ce; } } \
              { int u = bx * pers; const int end = min(u + pers, 4096); while (u < end) { const int bh = u >> 6, ce = min(end, (bh + 1) * 64); int cb_ = u & 63; const int ce_ = ce - bh * 64; \
                  if (PASS == 0) { if ((ce_ - cb_) & 1) { scalar_pass<1, 0>(a, j, bh, cb_, cb_ + 1, lds); ++cb_; } if (cb_ < ce_) ssd_passA2(a, j, bh, cb_, ce_, lds); } \
                  else scalar_pass<1, 1>(a, j, bh, cb_, ce_, lds); u = ce; } } } while (0)
            EVEN_PASS(0);
            XSYNC();
            { ArgsP a = fresh_args(); scalar_scan<0>(a); scalar_scan<1>(a); }
            XSYNC();
            EVEN_PASS(1);
            XSYNC();
            { ArgsP a = fresh_args(); ssd_norm_phase(a, j); }
          }
        } else {
          for (int rep = 0; rep < REP_ODDMIX; ++rep) {
            if (rep) XSYNC();
#define HG_PASS(PASS) do { ArgsP a = fresh_args(); const int G_ = gdim_fresh(), bx = bid_fresh(); const int per = (2048 + G_ - 1) / G_; int u = bx * per; const int end = min(u + per, 2048); \
              while (u < end) { const int bh = u >> 6, ce = min(end, (bh + 1) * 64); hg_pass<PASS>(a, j, bh, u & 63, ce - bh * 64, lds); u = ce; } } while (0)
            if (rep == 0) { { ArgsP a = fresh_args(); fox_prep(a, j, lds); } }
            HG_PASS(0);
            XSYNC();
            { ArgsP a = fresh_args(); hg_scan(a); }
            for (int rf = 0; rf < REP_FOX; ++rf) { ArgsP a = fresh_args(); unsigned* ctl = (unsigned*)(a->ws + WS_CTL) + 64 * 8 * rf;
              for (;;) {
                __syncthreads();
                if (tid_fresh() == 0) *s_nextp = (int)atomicAdd(ctl + 64 * (1 + L + 4 * rep), 1u);
                __syncthreads();
                const int u = *s_nextp;
                if (u >= 512) break;
                fox_unit2(a, u & 31, 15 - (u >> 5), lds);
              } }
            XSYNC();
            HG_PASS(1);
          }
        }
        for (int rep = 0; rep < REP_SYNC; ++rep) XSYNC();
#ifndef NO_OUTPROJ
        { ArgsP a = fresh_args(); unsigned char* ws = a->ws;
            const bf16* Wt = even ? (const bf16*)(ws + WS_WABOUT) + (size_t)j * D_ * D_ : (const bf16*)(ws + WS_WCDOUT) + (size_t)j * D_ * D_;
            pg8::Gemm g{(const bf16*)(ws + WS_UY), Wt, M_, D_, D_}; pg8::StaticOrder S; S.init(M_, D_, gdim_fresh(), bid_fresh());
            if (L == 0) { pg8::EpiResidT<false, true> E{a->in[0], a->out, D_, (float*)(ws + WS_RSP)}; pg8::gemm_phase<pg8::EpiResidT<false, true>, pg8::StaticOrder, true, true>(lds3, g, S, E); }
            else { pg8::EpiResidT<true, true> E{a->out, (L == 3) ? (void*)(ws + WS_ST) : (void*)a->out, D_, (float*)(ws + WS_RSP)}; pg8::gemm_phase<pg8::EpiResidT<true, true>, pg8::StaticOrder, true, true>(lds3, g, S, E); }
        }
#endif
        XSYNC();
        { ArgsP a = fresh_args(); rstd_phase(a); }
        XSYNC();
        for (int rep = 0; rep < REP_UP; ++rep) {
#ifndef NO_UP
        { ArgsP a = fresh_args(); unsigned char* ws = a->ws;
            pg8::Gemm g{(L == 3) ? (const bf16*)(ws + WS_ST) : (const bf16*)a->out, (const bf16*)(ws + WS_WGU) + (size_t)L * 2 * FF_ * D_, M_, 2 * FF_, D_}; pg8::StaticOrder S; S.init(M_, 2 * FF_, gdim_fresh(), bid_fresh());
            pg8::EpiSwigluR E{(bf16*)(ws + WS_BIG), FF_, (const float*)(ws + WS_RSTD)};
            pg8::gemm_phase<pg8::EpiSwigluR, pg8::StaticOrder, true, true>(lds3, g, S, E);
        }
#endif
        XSYNC(); }
#ifndef NO_DOWN
        { ArgsP a = fresh_args(); unsigned char* ws = a->ws;
            pg8::Gemm g{(const bf16*)(ws + WS_BIG), (const bf16*)(ws + WS_WDN) + (size_t)L * D_ * FF_, M_, D_, FF_}; pg8::StaticOrder S; S.init(M_, D_, gdim_fresh(), bid_fresh());
            if (L == 3) { pg8::EpiResidT<true, false> E{ws + WS_ST, a->out, D_, nullptr}; pg8::gemm_phase<pg8::EpiResidT<true, false>, pg8::StaticOrder, true, true>(lds3, g, S, E); }
            else { pg8::EpiResidT<true, true> E{a->out, a->out, D_, nullptr}; pg8::gemm_phase<pg8::EpiResidT<true, true>, pg8::StaticOrder, true, true>(lds3, g, S, E); }
        }
#endif
        XSYNC();
    }
}

extern "C" void kernel_launch(void* const* d_in, const int* in_sizes, int n_in, void* d_out, int out_size, void* d_ws, size_t ws_size, hipStream_t stream) {
    static int grid = 0;
    if (grid == 0) {
        if (n_in != 22 || ws_size < WS_END) { fprintf(stderr, "kernel_launch: unexpected n_in %d / ws %zu\n", n_in, ws_size); grid = -1; return; }
        int dev = 0, cus = 0, per_cu = 0;
        (void)hipGetDevice(&dev); (void)hipDeviceGetAttribute(&cus, hipDeviceAttributeMultiprocessorCount, dev);
        (void)hipFuncSetAttribute((const void*)fwd_kernel, hipFuncAttributeMaxDynamicSharedMemorySize, LDS_BYTES);
        (void)hipOccupancyMaxActiveBlocksPerMultiprocessor(&per_cu, (const void*)fwd_kernel, 512, LDS_BYTES);
        (void)hipGetLastError();
        if (per_cu < 1) per_cu = 1;
        grid = cus * per_cu;
        fprintf(stderr, "kernel_launch: cus %d per_cu %d grid %d\n", cus, per_cu, grid);
    }
    if (grid < 0) return;
    (void)hipMemsetAsync((char*)d_ws + WS_CTL, 0, 65536, stream);
    Args a{};
    for (int i = 0; i < 22; ++i) a.in[i] = (const float*)d_in[i];
    a.out = (float*)d_out; a.ws = (unsigned char*)d_ws;
    void* args[] = {&a};
    hipError_t e = hipLaunchCooperativeKernel((const void*)fwd_kernel, dim3(grid), dim3(512), args, LDS_BYTES, stream);
    if (e != hipSuccess) fprintf(stderr, "cooperative launch failed: %s (grid %d)\n", hipGetErrorString(e), grid);
}
```
